# Optimizing an MI355X kernel written in HIP

```python
import jax, jax.numpy as jnp
from jax import lax
import numpy as np

D_MODEL = 1024
BATCH = 8
SEQ = 4096
DEPTH = 2

PLE_DIM = 256
EPS = 1e-6
N_EVEN = (DEPTH + 1) // 2
N_ODD = DEPTH // 2

A_WIDTH = D_MODEL // 2
A_HEADS = 4
A_DK = A_WIDTH // A_HEADS
A_DV = A_WIDTH // A_HEADS
A_CHUNK = 32
B_WIDTH = D_MODEL // 2
CONV_W = 3
AB_IN = 4 * A_WIDTH + 3 * B_WIDTH
AB_SPLITS = (A_WIDTH, 2 * A_WIDTH, 3 * A_WIDTH, 4 * A_WIDTH,
             4 * A_WIDTH + B_WIDTH, 4 * A_WIDTH + 2 * B_WIDTH)
C_HEAD_DIM = 64
C_Q_HEADS = D_MODEL // C_HEAD_DIM
C_KV_HEADS = 2
C_GROUP = C_Q_HEADS // C_KV_HEADS
WINDOW = 128
C_BLOCK = WINDOW
C_IN = (C_Q_HEADS + 2 * C_KV_HEADS) * C_HEAD_DIM
N_EXPERTS = 16
N_GROUPS = 4
EXPERTS_PER_GROUP = N_EXPERTS // N_GROUPS
TOP_K = 2
D_EXPERT = 512

kernel_name = "hybrid_hgrn2_shortconv_swa_sink_grouped_moe"


def rms_norm(x, g):
    x32 = x.astype(jnp.float32)
    y = x32 * lax.rsqrt(jnp.mean(x32 * x32, axis=-1, keepdims=True) + EPS)
    return (y * g.astype(jnp.float32)).astype(x.dtype)


def hgrn2_chunkwise(q, k, v, log_f):
    bsz, t, h, _ = q.shape
    n = t // A_CHUNK

    def to_chunks(a):
        return a.reshape(bsz, n, A_CHUNK, h, a.shape[-1]).transpose(1, 0, 3, 2, 4)

    q, k, v, log_f = map(to_chunks, (q, k, v, log_f))
    b = jnp.cumsum(log_f, axis=3)
    b_last = b[:, :, :, -1, :]
    q_dec = q * jnp.exp(b)
    k_inv = k * jnp.exp(-b)
    k_tail = k * jnp.exp(b_last[:, :, :, None, :] - b)
    causal = jnp.tril(jnp.ones((A_CHUNK, A_CHUNK), jnp.float32))
    scores = jnp.einsum('nbhid,nbhjd->nbhij', q_dec, k_inv) * causal
    o_intra = jnp.einsum('nbhij,nbhjv->nbhiv', scores, v)

    def step(state, xs):
        q_c, k_c, v_c, decay = xs
        o_c = jnp.einsum('bhid,bhdv->bhiv', q_c, state)
        state = state * decay[..., None] + jnp.einsum('bhjd,bhjv->bhdv', k_c, v_c)
        return state, o_c

    s0 = jnp.zeros((bsz, h, q.shape[-1], v.shape[-1]), jnp.float32)
    _, o_inter = lax.scan(step, s0, (q_dec, k_tail, v, jnp.exp(b_last)))
    o = o_intra + o_inter
    return o.transpose(1, 0, 3, 2, 4).reshape(bsz, t, h, v.shape[-1])


def causal_depthwise_conv(y, w):
    return lax.conv_general_dilated(
        y, w[:, None, :].astype(y.dtype), window_strides=(1,),
        padding=[(CONV_W - 1, 0)], dimension_numbers=('NWC', 'WIO', 'NWC'),
        feature_group_count=y.shape[-1])


def hgrn2_shortconv_mixer(u, w_in, lb, out_norm, conv_w, w_out):
    bsz, t, _ = u.shape
    z = u @ w_in
    q, f, inp, g, gate_b, gate_c, h_b = jnp.split(z, AB_SPLITS, axis=-1)

    def heads(a):
        return a.reshape(bsz, t, A_HEADS, -1)

    forget = lb + (1.0 - lb) * jax.nn.sigmoid(f.astype(jnp.float32))
    o_a = hgrn2_chunkwise(heads(jax.nn.silu(q.astype(jnp.float32))),
                          heads(1.0 - forget),
                          heads(inp.astype(jnp.float32)),
                          heads(jnp.log(forget)))
    o_a = rms_norm(o_a, out_norm) * jax.nn.sigmoid(heads(g.astype(jnp.float32)))
    o_a = o_a.reshape(bsz, t, A_WIDTH).astype(u.dtype)
    o_b = gate_b * causal_depthwise_conv(gate_c * h_b, conv_w)
    return jnp.concatenate([o_a, o_b], axis=-1) @ w_out


def swa_sink_attention(u, w_in, b_in, sinks, w_out, b_out):
    bsz, t, _ = u.shape
    nb = t // C_BLOCK
    z = u @ w_in + b_in
    q, k, v = jnp.split(z, [C_Q_HEADS * C_HEAD_DIM, (C_Q_HEADS + C_KV_HEADS) * C_HEAD_DIM], axis=-1)
    q = q.reshape(bsz, nb, C_BLOCK, C_KV_HEADS, C_GROUP, C_HEAD_DIM)
    k = k.reshape(bsz, nb, C_BLOCK, C_KV_HEADS, C_HEAD_DIM)
    v = v.reshape(bsz, nb, C_BLOCK, C_KV_HEADS, C_HEAD_DIM)

    def with_prev(a):
        prev = jnp.concatenate([jnp.zeros_like(a[:, :1]), a[:, :-1]], axis=1)
        return jnp.concatenate([prev, a], axis=2)

    kk, vv = with_prev(k), with_prev(v)
    scale = C_HEAD_DIM ** -0.5
    s = jnp.einsum('bnqkgd,bnskd->bkgnqs', q, kk).astype(jnp.float32) * scale
    qi = jnp.arange(C_BLOCK)[:, None] + C_BLOCK
    si = jnp.arange(2 * C_BLOCK)[None, :]
    rel = qi - si
    band = (rel >= 0) & (rel < WINDOW)
    real = (jnp.arange(nb)[:, None, None] > 0) | (si[None] >= C_BLOCK)
    mask = band[None] & real
    s = jnp.where(mask, s, -jnp.inf)
    sink = sinks.astype(jnp.float32).reshape(C_KV_HEADS, C_GROUP)[None, :, :, None, None, None]
    m = jnp.maximum(jnp.max(s, axis=-1, keepdims=True), sink)
    e = jnp.exp(s - m)
    probs = e / (jnp.sum(e, axis=-1, keepdims=True) + jnp.exp(sink - m))
    o = jnp.einsum('bkgnqs,bnskd->bnqkgd', probs.astype(vv.dtype), vv)
    return o.reshape(bsz, t, D_MODEL) @ w_out + b_out


def grouped_moe(v, w_router, w_gate, w_up, w_down):
    bsz, t, d = v.shape
    xt = v.reshape(-1, d)
    scores = jax.nn.softmax((xt @ w_router).astype(jnp.float32), axis=-1)
    grouped = scores.reshape(-1, N_GROUPS, EXPERTS_PER_GROUP)
    group_score = jnp.sum(lax.top_k(grouped, TOP_K)[0], axis=-1)
    sel = jnp.argmax(group_score, axis=-1)
    in_group = jnp.take_along_axis(grouped, sel[:, None, None], axis=1)[:, 0]
    vals, idx = lax.top_k(in_group, TOP_K)
    expert_ids = sel[:, None] * EXPERTS_PER_GROUP + idx
    weights = vals / jnp.sum(vals, axis=-1, keepdims=True)
    combine = jnp.einsum('nk,nke->ne', weights,
                         jax.nn.one_hot(expert_ids, N_EXPERTS, dtype=jnp.float32)).astype(v.dtype)
    y = jnp.zeros_like(xt)
    for e in range(N_EXPERTS):
        hidden = jax.nn.silu(xt @ w_gate[e]) * (xt @ w_up[e])
        y = y + combine[:, e:e + 1] * (hidden @ w_down[e])
    return y.reshape(bsz, t, d)


def setup_inputs(seed: int = 0) -> dict:
    key = jax.random.key(seed)
    ks = jax.random.split(key, 24)

    def nrm(k, shape, scale):
        return jax.random.normal(k, shape, jnp.float32) * scale

    def gain(k, shape):
        return 1.0 + 0.05 * jax.random.normal(k, shape, jnp.float32)

    out_scale = (2 * DEPTH) ** -0.5
    return {
        "x": nrm(ks[0], (BATCH, SEQ, D_MODEL), 1.0),
        "p": nrm(ks[1], (DEPTH, BATCH, SEQ, PLE_DIM), 1.0),
        "norm_mix": gain(ks[2], (DEPTH, D_MODEL)),
        "norm_ffn": gain(ks[3], (DEPTH, D_MODEL)),
        "norm_ple": gain(ks[4], (DEPTH, D_MODEL)),
        "norm_final": gain(ks[5], (D_MODEL,)),
        "w_in_ab": nrm(ks[6], (N_EVEN, D_MODEL, AB_IN), D_MODEL ** -0.5),
        "hgrn_lb_logits": nrm(ks[7], (DEPTH + 1, A_WIDTH), 0.1),
        "hgrn_out_norm": gain(ks[8], (N_EVEN, A_DV)),
        "conv_w": nrm(ks[9], (N_EVEN, CONV_W, B_WIDTH), CONV_W ** -0.5),
        "w_out_ab": nrm(ks[10], (N_EVEN, D_MODEL, D_MODEL), D_MODEL ** -0.5 * out_scale),
        "w_in_c": nrm(ks[11], (N_ODD, D_MODEL, C_IN), D_MODEL ** -0.5),
        "b_in_c": nrm(ks[12], (N_ODD, C_IN), 0.02),
        "sinks": nrm(ks[13], (N_ODD, C_Q_HEADS), 1.0),
        "w_out_c": nrm(ks[14], (N_ODD, D_MODEL, D_MODEL), D_MODEL ** -0.5 * out_scale),
        "b_out_c": nrm(ks[15], (N_ODD, D_MODEL), 0.02),
        "w_router": nrm(ks[16], (D_MODEL, N_EXPERTS), D_MODEL ** -0.5),
        "w_gate_e": nrm(ks[17], (DEPTH, N_EXPERTS, D_MODEL, D_EXPERT), D_MODEL ** -0.5),
        "w_up_e": nrm(ks[18], (DEPTH, N_EXPERTS, D_MODEL, D_EXPERT), D_MODEL ** -0.5),
        "w_down_e": nrm(ks[19], (DEPTH, N_EXPERTS, D_EXPERT, D_MODEL), D_EXPERT ** -0.5 * out_scale),
        "w_ple_gate": nrm(ks[20], (DEPTH, D_MODEL, D_MODEL), D_MODEL ** -0.5),
        "w_ple_proj": nrm(ks[21], (DEPTH, PLE_DIM, D_MODEL), PLE_DIM ** -0.5 * out_scale),
    }


def reference(x, p, norm_mix, norm_ffn, norm_ple, norm_final, w_in_ab, hgrn_lb_logits,
              hgrn_out_norm, conv_w, w_out_ab, w_in_c, b_in_c, sinks, w_out_c, b_out_c,
              w_router, w_gate_e, w_up_e, w_down_e, w_ple_gate, w_ple_proj):
    lower_bounds = jnp.cumsum(jax.nn.softmax(hgrn_lb_logits.astype(jnp.float32), axis=0), axis=0)
    h = x
    for i in range(DEPTH):
        u = rms_norm(h, norm_mix[i])
        j = i // 2
        if i % 2 == 0:
            mix = hgrn2_shortconv_mixer(u, w_in_ab[j], lower_bounds[i], hgrn_out_norm[j],
                                        conv_w[j], w_out_ab[j])
        else:
            mix = swa_sink_attention(u, w_in_c[j], b_in_c[j], sinks[j], w_out_c[j], b_out_c[j])
        h = h + mix
        h = h + grouped_moe(rms_norm(h, norm_ffn[i]), w_router, w_gate_e[i], w_up_e[i], w_down_e[i])
        ple_gate = jax.nn.sigmoid(rms_norm(h, norm_ple[i]) @ w_ple_gate[i])
        h = h + ple_gate * (p[i] @ w_ple_proj[i])
    return rms_norm(h, norm_final)
```

```cpp
#include <hip/hip_runtime.h>
#include <cstdio>
#include <cstdint>

#ifndef MK_PER_PHASE
#define MK_PER_PHASE 1
#endif

#define LAS __attribute__((address_space(3)))
#define GAS __attribute__((address_space(1)))
typedef unsigned short bf16_t;
typedef short bf16x8 __attribute__((ext_vector_type(8)));
typedef float f32x4 __attribute__((ext_vector_type(4)));
typedef float f32x2 __attribute__((ext_vector_type(2)));
typedef unsigned u32x4 __attribute__((ext_vector_type(4)));
typedef unsigned u32x2 __attribute__((ext_vector_type(2)));
typedef GAS unsigned gu32;

constexpr int NB = 8, SEQ = 4096, D = 1024, NT = NB * SEQ;
constexpr int PLE = 256;
constexpr int AW = 512, AH = 4, ADK = 128;
constexpr int ABIN = 3584, ZW = 3072;
constexpr int CIN = 1280, HD = 64, NQH = 16, NKVH = 2, WIN = 128;
constexpr int NE = 16, DE = 512;
constexpr int NCLS = 24, LCAP = NT;
constexpr int HIDROWS = NT + NCLS * 256;
constexpr float EPS = 1e-6f;

constexpr size_t MiB = 1u << 20;
constexpr size_t WS_CTL = 0, CTL_ZERO_BYTES = 1 * MiB;
constexpr size_t WS_WINAB = 1 * MiB;
constexpr size_t WS_WOUTAB = 8 * MiB;
constexpr size_t WS_WINC = 10 * MiB;
constexpr size_t WS_WOUTC = 13 * MiB;
constexpr size_t WS_WPG = 15 * MiB;
constexpr size_t WS_WPP = 19 * MiB;
constexpr size_t WS_W1 = 20 * MiB;
constexpr size_t WS_W2 = 84 * MiB;
constexpr size_t WS_PB = 116 * MiB;
constexpr size_t WS_XA = 148 * MiB;
constexpr size_t WS_Z = 212 * MiB;
constexpr size_t WS_XA2 = WS_Z;
constexpr size_t WS_HID = WS_Z + 64 * MiB;
constexpr size_t WS_QKV = WS_Z + 64 * MiB;
constexpr size_t WS_PP = 404 * MiB;
constexpr size_t WS_LIST = 468 * MiB;
constexpr size_t WS_WLIST = 471 * MiB;
constexpr size_t WS_SSA = 477 * MiB;
constexpr size_t WS_SSB = 479 * MiB;
constexpr size_t WS_LB = 481 * MiB;
constexpr size_t WS_END = 482 * MiB;
constexpr int CW_BAR = 4096;
constexpr int CW_CNT = 16384;

constexpr int RING_BYTES = 131072;
constexpr int LX_OFF = RING_BYTES;
constexpr int LX_BAR = LX_OFF + 0;
constexpr int LX_TB = LX_OFF + 64;
constexpr int LX_CNT = LX_OFF + 64 + 128;
constexpr int LX_CLS = LX_OFF + 512;
constexpr int LDS_BYTES = 147456;
constexpr int NWAVES = 8, NTHR = 512;

__device__ __forceinline__ unsigned f2bf(float f) { unsigned u = __builtin_bit_cast(unsigned, f); return (u + 0x7fffu + ((u >> 16) & 1u)) >> 16; }
__device__ __forceinline__ unsigned pk2(float lo, float hi) { return f2bf(lo) | (f2bf(hi) << 16); }
__device__ __forceinline__ float bflo(unsigned w) { return __builtin_bit_cast(float, w << 16); }
__device__ __forceinline__ float bfhi(unsigned w) { return __builtin_bit_cast(float, w & 0xffff0000u); }
__device__ __forceinline__ float bf1(bf16_t h) { return __builtin_bit_cast(float, (unsigned)h << 16); }
__device__ __forceinline__ float sigmoidf_(float x) { return __builtin_amdgcn_rcpf(1.f + __expf(-x)); }
__device__ __forceinline__ float siluf_(float x) { return x * sigmoidf_(x); }
__device__ __forceinline__ float wave_sum(float v) {
#pragma unroll
    for (int o = 1; o < 64; o <<= 1) v += __shfl_xor(v, o);
    return v;
}
__device__ __forceinline__ float wave_max(float v) {
#pragma unroll
    for (int o = 1; o < 64; o <<= 1) v = fmaxf(v, __shfl_xor(v, o));
    return v;
}
#define LDS_WAIT() asm volatile("s_waitcnt lgkmcnt(0)" ::: "memory")

namespace pg8 {
constexpr int BM = 256, BK = 64, HALF = 128, HTB = HALF * BK * 2, NXCD = 8, WGM = 8;
__host__ __device__ __forceinline__ int lds_byte(int r, int c) { const int st = (r >> 4) * 2 + (c >> 5), rr = r & 15, cc = c & 31, ob = rr * 64 + cc * 2; return st * 1024 + (ob ^ (((ob >> 9) & 1) << 5)); }
__host__ __device__ __forceinline__ void stage_rc(int b, int& R, int& C) { const int st = b / 1024, sb = b % 1024, swz = sb ^ (((sb >> 9) & 1) << 5); R = (st >> 1) * 16 + swz / 64; C = (st & 1) * 32 + (swz % 64) / 2; }
__host__ __device__ __forceinline__ int perm32(int rho) { const int n = rho >> 4, i = rho & 15; return 8 * (i >> 2) + 4 * n + (i & 3); }

struct Unit { int pm, pn; const char* pA; const char* pB; const char* pB2; const int* lst; int nv; int aux; };

struct StaticOrder {
    int nM, nN, nwg, G, c;
    __device__ void init(int M, int N, int G_, int c_) { nM = M / BM; nN = N / BM; nwg = nM * nN; G = G_; c = c_; }
    __device__ bool next(int i, int& pm, int& pn) const {
        const long L = (long)i * G + c; if (L >= nwg) return false;
        int wgid = (int)L; { const int q = nwg / NXCD, r = nwg % NXCD, xcd = wgid % NXCD, off = wgid / NXCD; wgid = (xcd < r ? xcd * (q + 1) : r * (q + 1) + (xcd - r) * q) + off; }
        const int nig = WGM * nN, gid = wgid / nig, fm = gid * WGM, gsz = (nM - fm) < WGM ? (nM - fm) : WGM;
        pm = fm + ((wgid % nig) % gsz); pn = (wgid % nig) / gsz; return true;
    }
};
struct DenseSched {
    StaticOrder so; const char* A; const char* B; size_t tA, tB;
    __device__ void init(const void* A_, const void* B_, int M, int N, int lda, int ldb, int G, int c) { so.init(M, N, G, c); A = (const char*)A_; B = (const char*)B_; tA = (size_t)BM * lda * 2; tB = (size_t)BM * ldb * 2; }
    __device__ __forceinline__ bool next(int i, Unit& u) const {
        int pm, pn; if (!so.next(i, pm, pn)) return false;
        u.pm = pm; u.pn = pn; u.pA = A + (size_t)pm * tA; u.pB = B + (size_t)pn * tB; u.pB2 = u.pB; u.lst = nullptr; u.nv = BM; u.aux = 0; return true;
    }
};

__device__ __forceinline__ unsigned cvt_pk_bf16(float lo, float hi) { unsigned r; asm volatile("v_cvt_pk_bf16_f32 %0, %1, %2" : "=v"(r) : "v"(lo), "v"(hi)); return r; }

template <class Epi, class Sched, bool GATHER, bool SPLITB>
__device__ __forceinline__ void gemm_phase(LAS unsigned char* lds, const int K, const int lda, const int ldb, const Sched& S, const Epi& E) {
    int tid = threadIdx.x; asm volatile("" : "+v"(tid));
    const int wid = __builtin_amdgcn_readfirstlane(tid >> 6), lane = tid & 63, wr = wid >> 2, wc = wid & 3, fr = lane & 15, fq = lane >> 4;
    int nt = K / BK; asm volatile("" : "+s"(nt));
    const int ntB = nt >> 1;
    unsigned voffA[2], voffB[2];
#pragma unroll
    for (int i = 0; i < 2; ++i) { int R, C; stage_rc(tid * 16 + i * 8192, R, C); const int Rb = (R & ~31) + perm32(R & 31); voffA[i] = (unsigned)(R * lda + C) * 2u; voffB[i] = (unsigned)(Rb * ldb + C) * 2u; }
    const size_t kstep = (size_t)(BK * 2);
    const size_t hstepB = (size_t)HALF * ldb * 2;
    const size_t hstepA = (size_t)HALF * lda * 2;
    const unsigned ldsw = (unsigned)wid * 1024u;
    const int aoff = lds_byte(wr * 64 + fr, fq * 8), boff = lds_byte(wc * 32 + fr, fq * 8);
#define PG8_SA(b, h) (((b) * 2 + (h)) * HTB)
#define PG8_SB(b, h) ((4 + (b) * 2 + (h)) * HTB)
#define PG8_STAGE(bufoff, gbase, voff) do { _Pragma("unroll") for (int _i = 0; _i < 2; ++_i) \
        __builtin_amdgcn_global_load_lds((const unsigned*)((const char*)(gbase) + (voff)[_i]), (LAS unsigned*)(lds + (bufoff) + ldsw + _i * 8192), 16, 0, 0); } while (0)
#define PG8_LDA(dst, b, h) do { _Pragma("unroll") for (int m = 0; m < 4; ++m) _Pragma("unroll") for (int k = 0; k < 2; ++k) dst[m][k] = *(const LAS bf16x8*)(lds + PG8_SA(b, h) + aoff + m * 2048 + k * 1024); } while (0)
#define PG8_LDB(dst, b, h) do { _Pragma("unroll") for (int n = 0; n < 2; ++n) _Pragma("unroll") for (int k = 0; k < 2; ++k) dst[n][k] = *(const LAS bf16x8*)(lds + PG8_SB(b, h) + boff + n * 2048 + k * 1024); } while (0)
#define PG8_MMA(ai, bj, At, Bt) do { __builtin_amdgcn_s_setprio(1); _Pragma("unroll") for (int m = 0; m < 4; ++m) _Pragma("unroll") for (int n = 0; n < 2; ++n) _Pragma("unroll") for (int k = 0; k < 2; ++k) \
        acc[ai][bj][m][n] = __builtin_amdgcn_mfma_f32_16x16x32_bf16(Bt[n][k], At[m][k], acc[ai][bj][m][n], 0, 0, 0); __builtin_amdgcn_s_setprio(0); } while (0)
#define PG8_WAIT_V(n) asm volatile("s_waitcnt vmcnt(" #n ")" ::: "memory")
#define PG8_WAIT_L(n) asm volatile("s_waitcnt lgkmcnt(" #n ")" ::: "memory")
#define PG8_BAR __builtin_amdgcn_s_barrier()
#define PG8_SCHED __builtin_amdgcn_sched_barrier(0)
#define PG8_GOFF(G, u) do { if constexpr (GATHER) { _Pragma("unroll") for (int _h = 0; _h < 2; ++_h) _Pragma("unroll") for (int _i = 0; _i < 2; ++_i) { \
        int _R, _C; stage_rc(tid * 16 + _i * 8192, _R, _C); int _ix = _h * HALF + _R; _ix = _ix < (u).nv ? _ix : (u).nv - 1; const int _tok = (u).lst[_ix]; G[_h][_i] = (unsigned)_tok * (unsigned)(lda * 2) + (unsigned)(_C * 2); } } } while (0)
#define PG8_STAGE_A(bufoff, gbase, half, G) do { if constexpr (GATHER) { PG8_STAGE(bufoff, gbase, G[half]); } else { PG8_STAGE(bufoff, (gbase) + (half) * hstepA, voffA); } } while (0)
#define PG8_BPTR(u, tt) ((SPLITB && (tt) >= ntB) ? (u).pB2 + (size_t)((tt) - ntB) * kstep : (u).pB + (size_t)(tt) * kstep)
    Unit cur; int ui = 0;
    if (!S.next(0, cur)) return;
    f32x4 acc[2][2][4][2];
#pragma unroll
    for (int a = 0; a < 2; ++a)
#pragma unroll
        for (int b = 0; b < 2; ++b)
#pragma unroll
            for (int m = 0; m < 4; ++m)
#pragma unroll
                for (int n = 0; n < 2; ++n) acc[a][b][m][n] = (f32x4){0.f, 0.f, 0.f, 0.f};
    bf16x8 At[4][2], B0[2][2], B1[2][2];
    unsigned cG[2][2];
    LAS u32x4* gstash = (LAS u32x4*)(lds + 135168) + tid;
    PG8_GOFF(cG, cur);
    const char* cA = cur.pA; const char* cB = cur.pB;
    PG8_STAGE(PG8_SB(0, 0), cB, voffB); PG8_STAGE(PG8_SB(0, 1), cB + hstepB, voffB); PG8_STAGE_A(PG8_SA(0, 0), cA, 0, cG); PG8_STAGE_A(PG8_SA(0, 1), cA, 1, cG);
    if (wr == 1) PG8_BAR;
    PG8_WAIT_V(2); PG8_BAR;
    PG8_STAGE(PG8_SB(1, 0), cB + kstep, voffB); PG8_STAGE_A(PG8_SA(1, 0), cA + kstep, 0, cG); PG8_STAGE(PG8_SB(1, 1), cB + hstepB + kstep, voffB);
    PG8_WAIT_V(6); PG8_BAR;
    for (;;) {
        Unit nxt; const bool has_next = S.next(ui + 1, nxt);
        if constexpr (GATHER) { unsigned nG[2][2];
            if (has_next) { PG8_GOFF(nG, nxt); } else {
#pragma unroll
            for (int h = 0; h < 2; ++h)
#pragma unroll
                for (int i = 0; i < 2; ++i) nG[h][i] = cG[h][i]; }
            *gstash = (u32x4){nG[0][0], nG[0][1], nG[1][0], nG[1][1]}; }
        const char* nA = has_next ? nxt.pA : cA; const char* nB = has_next ? nxt.pB : cB;
        for (int t = 0; t < nt; t += 2) {
            const bool last = (t == nt - 2);
            const char* a1 = cA + (size_t)(t + 1) * kstep;
            const char* a2 = last ? nA : cA + (size_t)(t + 2) * kstep; const char* a3 = a2 + kstep;
            const char* b2 = last ? nB : PG8_BPTR(cur, t + 2); const char* b3 = b2 + kstep;
            unsigned g2[2][2];
            if constexpr (GATHER) {
                if (last) { const u32x4 st = *gstash; g2[0][0] = st.x; g2[0][1] = st.y; g2[1][0] = st.z; g2[1][1] = st.w; }
                else {
#pragma unroll
                for (int h = 0; h < 2; ++h)
#pragma unroll
                    for (int i = 0; i < 2; ++i) g2[h][i] = cG[h][i]; } }
            PG8_LDB(B0, 0, 0); PG8_LDB(B1, 0, 1); PG8_SCHED; PG8_LDA(At, 0, 0); PG8_STAGE_A(PG8_SA(1, 1), a1, 1, cG);
            PG8_WAIT_V(8); PG8_WAIT_L(0); PG8_BAR; PG8_MMA(0, 0, At, B0); PG8_MMA(0, 1, At, B1); PG8_BAR; PG8_SCHED;
            PG8_LDA(At, 0, 1); PG8_STAGE(PG8_SB(0, 0), b2, voffB); PG8_STAGE(PG8_SB(0, 1), b2 + hstepB, voffB); PG8_STAGE_A(PG8_SA(0, 0), a2, 0, g2);
            PG8_WAIT_V(8); PG8_WAIT_L(0); PG8_BAR; PG8_MMA(1, 0, At, B0); PG8_MMA(1, 1, At, B1); PG8_BAR; PG8_SCHED;
            PG8_LDB(B0, 1, 0); PG8_LDB(B1, 1, 1); PG8_SCHED; PG8_LDA(At, 1, 0); PG8_STAGE_A(PG8_SA(0, 1), a2, 1, g2);
            PG8_WAIT_V(8); PG8_WAIT_L(0); PG8_BAR; PG8_MMA(0, 0, At, B0); PG8_MMA(0, 1, At, B1); PG8_BAR; PG8_SCHED;
            PG8_LDA(At, 1, 1); PG8_STAGE(PG8_SB(1, 0), b3, voffB); PG8_STAGE(PG8_SB(1, 1), b3 + hstepB, voffB); PG8_STAGE_A(PG8_SA(1, 0), a3, 0, g2);
            PG8_WAIT_V(8); PG8_WAIT_L(0); PG8_BAR; PG8_MMA(1, 0, At, B0); PG8_MMA(1, 1, At, B1); PG8_BAR; PG8_SCHED;
        }
        if (wr == 0) PG8_BAR;
        E(acc, cur, wr, wc, fr, fq);
        if (!has_next) break;
#pragma unroll
        for (int a = 0; a < 2; ++a)
#pragma unroll
            for (int b = 0; b < 2; ++b)
#pragma unroll
                for (int m = 0; m < 4; ++m)
#pragma unroll
                    for (int n = 0; n < 2; ++n) acc[a][b][m][n] = (f32x4){0.f, 0.f, 0.f, 0.f};
        ++ui; (void)S.next(ui, cur); cA = nA; cB = nB;
        if constexpr (GATHER) { const u32x4 st = *gstash; cG[0][0] = st.x; cG[0][1] = st.y; cG[1][0] = st.z; cG[1][1] = st.w; }
        if (wr == 1) PG8_BAR;
    }
    PG8_WAIT_V(0);
    PG8_BAR;
#undef PG8_SA
#undef PG8_SB
#undef PG8_STAGE
#undef PG8_LDA
#undef PG8_LDB
#undef PG8_MMA
#undef PG8_WAIT_V
#undef PG8_WAIT_L
#undef PG8_BAR
#undef PG8_SCHED
#undef PG8_GOFF
#undef PG8_STAGE_A
#undef PG8_BPTR
}

typedef const f32x4 (&AccRef)[2][2][4][2];
#define EPI_ROW(u, ai, m) ((u).pm * BM + (ai) * HALF + wr * 64 + (m) * 16 + fr)
#define EPI_COL(u, bj) ((u).pn * BM + (bj) * HALF + wc * 32 + fq * 8)
__device__ __forceinline__ u32x4 pack8(const f32x4& a, const f32x4& b) { u32x4 w; w.x = cvt_pk_bf16(a[0], a[1]); w.y = cvt_pk_bf16(a[2], a[3]); w.z = cvt_pk_bf16(b[0], b[1]); w.w = cvt_pk_bf16(b[2], b[3]); return w; }
__device__ __forceinline__ float sq8(const f32x4& a, const f32x4& b) { return (a[0] * a[0] + a[1] * a[1]) + (a[2] * a[2] + a[3] * a[3]) + (b[0] * b[0] + b[1] * b[1]) + (b[2] * b[2] + b[3] * b[3]); }
__device__ __forceinline__ void unpack8(const u32x4& w, f32x4& a, f32x4& b) { a = (f32x4){bflo(w.x), bfhi(w.x), bflo(w.y), bfhi(w.y)}; b = (f32x4){bflo(w.z), bfhi(w.z), bflo(w.w), bfhi(w.w)}; }

struct EpiBf16 {
    bf16_t* O; int ldc;
    __device__ __forceinline__ void operator()(AccRef acc, const Unit& u, int wr, int wc, int fr, int fq) const {
#pragma unroll
        for (int ai = 0; ai < 2; ++ai)
#pragma unroll
            for (int m = 0; m < 4; ++m) { bf16_t* rowp = O + (size_t)EPI_ROW(u, ai, m) * ldc;
#pragma unroll
                for (int bj = 0; bj < 2; ++bj) *(u32x4*)(rowp + EPI_COL(u, bj)) = pack8(acc[ai][bj][m][0], acc[ai][bj][m][1]); }
    }
};
struct EpiInAb {
    bf16_t* Z;
    __device__ __forceinline__ void operator()(AccRef acc, const Unit& u, int wr, int wc, int fr, int fq) const {
        if (u.pn >= 10) {
#pragma unroll
            for (int ai = 0; ai < 2; ++ai)
#pragma unroll
                for (int m = 0; m < 4; ++m) { bf16_t* rowp = Z + (size_t)EPI_ROW(u, ai, m) * ZW;
                    const f32x4 a = acc[ai][0][m][0] * acc[ai][1][m][0], b = acc[ai][0][m][1] * acc[ai][1][m][1];
                    *(u32x4*)(rowp + 2560 + (u.pn - 10) * HALF + wc * 32 + fq * 8) = pack8(a, b); }
        } else if (u.pn < 2) {
#pragma unroll
            for (int ai = 0; ai < 2; ++ai)
#pragma unroll
                for (int m = 0; m < 4; ++m) { bf16_t* rowp = Z + (size_t)EPI_ROW(u, ai, m) * ZW;
#pragma unroll
                    for (int bj = 0; bj < 2; ++bj) { f32x4 a = acc[ai][bj][m][0], b = acc[ai][bj][m][1];
#pragma unroll
                        for (int j = 0; j < 4; ++j) { a[j] = siluf_(a[j]); b[j] = siluf_(b[j]); }
                        *(u32x4*)(rowp + EPI_COL(u, bj)) = pack8(a, b); }
                    asm volatile("" ::: "memory"); }
        } else {
#pragma unroll
            for (int ai = 0; ai < 2; ++ai)
#pragma unroll
                for (int m = 0; m < 4; ++m) { bf16_t* rowp = Z + (size_t)EPI_ROW(u, ai, m) * ZW;
#pragma unroll
                    for (int bj = 0; bj < 2; ++bj) *(u32x4*)(rowp + EPI_COL(u, bj)) = pack8(acc[ai][bj][m][0], acc[ai][bj][m][1]); }
        }
    }
};
struct EpiRes {
    const float* X; float* O; const float* bias;
    __device__ __forceinline__ void operator()(AccRef acc, const Unit& u, int wr, int wc, int fr, int fq) const {
#pragma unroll
        for (int ai = 0; ai < 2; ++ai)
#pragma unroll
            for (int m = 0; m < 4; ++m) { const size_t ro = (size_t)EPI_ROW(u, ai, m) * D;
#pragma unroll
                for (int bj = 0; bj < 2; ++bj) { const int c = EPI_COL(u, bj);
                    f32x4 x0 = *(const f32x4*)(X + ro + c), x1 = *(const f32x4*)(X + ro + c + 4);
                    if (bias) { x0 += *(const f32x4*)(bias + c); x1 += *(const f32x4*)(bias + c + 4); }
                    *(f32x4*)(O + ro + c) = x0 + acc[ai][bj][m][0]; *(f32x4*)(O + ro + c + 4) = x1 + acc[ai][bj][m][1]; }
                asm volatile("" ::: "memory"); }
    }
};
__device__ __forceinline__ float rstd16(const float* ss, int row) {
    const f32x4* p = (const f32x4*)(ss + (size_t)row * 16); const f32x4 a = p[0], b = p[1], c = p[2], d = p[3];
    const float s = ((a[0] + a[1]) + (a[2] + a[3])) + ((b[0] + b[1]) + (b[2] + b[3])) + ((c[0] + c[1]) + (c[2] + c[3])) + ((d[0] + d[1]) + (d[2] + d[3]));
    return __builtin_amdgcn_rsqf(s * (1.f / D) + EPS);
}
struct EpiQkv {
    bf16_t* O; const float* bias; const float* ss;
    __device__ __forceinline__ void operator()(AccRef acc, const Unit& u, int wr, int wc, int fr, int fq) const {
#pragma unroll
        for (int ai = 0; ai < 2; ++ai)
#pragma unroll
            for (int m = 0; m < 4; ++m) { const int row = EPI_ROW(u, ai, m); const float rs = rstd16(ss, row); bf16_t* rowp = O + (size_t)row * CIN;
#pragma unroll
                for (int bj = 0; bj < 2; ++bj) { const int c = EPI_COL(u, bj);
                    const f32x4 a = acc[ai][bj][m][0] * rs + *(const f32x4*)(bias + c), b = acc[ai][bj][m][1] * rs + *(const f32x4*)(bias + c + 4);
                    *(u32x4*)(rowp + c) = pack8(a, b); }
                asm volatile("" ::: "memory"); }
    }
};
struct EpiG1 {
    bf16_t* HID; const f32x2* wl;
    __device__ __forceinline__ void operator()(AccRef acc, const Unit& u, int wr, int wc, int fr, int fq) const {
#pragma unroll
        for (int ai = 0; ai < 2; ++ai)
#pragma unroll
            for (int m = 0; m < 4; ++m) { const int rit = ai * HALF + wr * 64 + m * 16 + fr;
                const f32x2 w2 = wl[(size_t)u.aux + rit]; const float w = (u.pn < 4) ? w2.x : w2.y;
                bf16_t* rowp = HID + (size_t)(u.pm * BM + rit) * 1024 + (u.pn >> 2) * 512 + (u.pn & 3) * HALF + wc * 32 + fq * 8;
                f32x4 a, b;
#pragma unroll
                for (int j = 0; j < 4; ++j) { a[j] = siluf_(acc[ai][0][m][0][j]) * acc[ai][1][m][0][j] * w; b[j] = siluf_(acc[ai][0][m][1][j]) * acc[ai][1][m][1][j] * w; }
                *(u32x4*)rowp = pack8(a, b);
                asm volatile("" ::: "memory"); }
    }
};
struct EpiG2 {
    float* H; bf16_t* HB; float* SS;
    __device__ __forceinline__ void operator()(AccRef acc, const Unit& u, int wr, int wc, int fr, int fq) const {
#pragma unroll
        for (int ai = 0; ai < 2; ++ai)
#pragma unroll
            for (int m = 0; m < 4; ++m) { const int rit = ai * HALF + wr * 64 + m * 16 + fr; const bool ok = rit < u.nv;
                const int tok = u.lst[ok ? rit : 0]; float part = 0.f;
                if (ok) { const size_t ro = (size_t)tok * D;
#pragma unroll
                    for (int bj = 0; bj < 2; ++bj) { const int c = EPI_COL(u, bj);
                        const f32x4 h0 = *(const f32x4*)(H + ro + c) + acc[ai][bj][m][0], h1 = *(const f32x4*)(H + ro + c + 4) + acc[ai][bj][m][1];
                        *(f32x4*)(H + ro + c) = h0; *(f32x4*)(H + ro + c + 4) = h1; *(u32x4*)(HB + ro + c) = pack8(h0, h1); part += sq8(h0, h1); } }
                part += __shfl_xor(part, 16); part += __shfl_xor(part, 32);
                if (ok && fq == 0) SS[(size_t)tok * 16 + u.pn * 4 + wc] = part;
                asm volatile("" ::: "memory"); }
    }
};
struct EpiPle {
    float* H; bf16_t* HB; const bf16_t* PP; const float* ssi; float* sso;
    __device__ __forceinline__ void operator()(AccRef acc, const Unit& u, int wr, int wc, int fr, int fq) const {
#pragma unroll
        for (int ai = 0; ai < 2; ++ai)
#pragma unroll
            for (int m = 0; m < 4; ++m) { const int row = EPI_ROW(u, ai, m); const float rs = rstd16(ssi, row); const size_t ro = (size_t)row * D; float part = 0.f;
#pragma unroll
                for (int bj = 0; bj < 2; ++bj) { const int c = EPI_COL(u, bj);
                    f32x4 p0, p1; unpack8(*(const u32x4*)(PP + ro + c), p0, p1);
                    f32x4 h0 = *(const f32x4*)(H + ro + c), h1 = *(const f32x4*)(H + ro + c + 4);
#pragma unroll
                    for (int j = 0; j < 4; ++j) { h0[j] += sigmoidf_(acc[ai][bj][m][0][j] * rs) * p0[j]; h1[j] += sigmoidf_(acc[ai][bj][m][1][j] * rs) * p1[j]; }
                    *(f32x4*)(H + ro + c) = h0; *(f32x4*)(H + ro + c + 4) = h1; *(u32x4*)(HB + ro + c) = pack8(h0, h1); part += sq8(h0, h1); }
                part += __shfl_xor(part, 16); part += __shfl_xor(part, 32);
                if (fq == 0) sso[(size_t)row * 16 + u.pn * 4 + wc] = part;
                asm volatile("" ::: "memory"); }
    }
};
}

#define XB_TMO      128
#define XB_XCNT(j)  (256  + 64 * (j))
#define XB_XSUB(j)  (1280 + 64 * (j))
#define XB_XGEN(j)  (2304 + 64 * (j))
#define XB_TOP      3328
#define XB_TOPGEN   3392
#define XCD_BAR_WORDS 3456
#define XB_SPIN_CAP (1u << 18)
__device__ __forceinline__ unsigned xb_ld(unsigned* p)              { return __hip_atomic_load(p, __ATOMIC_RELAXED, __HIP_MEMORY_SCOPE_AGENT); }
__device__ __forceinline__ unsigned xb_add(unsigned* p, unsigned v) { return __hip_atomic_fetch_add(p, v, __ATOMIC_RELAXED, __HIP_MEMORY_SCOPE_AGENT); }
__device__ __forceinline__ unsigned xb_xcc_id() { return (unsigned)__builtin_amdgcn_s_getreg((3 << 11) | 20) & 0xFu; }
#define XB_SPIN(cond, bar) do { unsigned _sp = 0; while (cond) { __builtin_amdgcn_s_sleep(1); \
    if ((++_sp & 255u) == 0u) { if (xb_ld(&(bar)[XB_TMO])) break; if (_sp > XB_SPIN_CAP) { atomicAdd(&(bar)[XB_TMO], 1u); break; } } } } while (0)
struct XcdBarrier { unsigned* bar; unsigned x; volatile LAS unsigned* st; };
__device__ __forceinline__ XcdBarrier xcd_barrier_post(unsigned* bar, volatile LAS unsigned* st) {
    XcdBarrier b; b.bar = bar; b.x = xb_xcc_id(); b.st = st;
    if (threadIdx.x == 0) (void)xb_add(&bar[XB_XCNT(b.x)], 1u);
    return b;
}
__device__ __forceinline__ void xcd_barrier_complete(unsigned* bar, unsigned x, unsigned& nloc, unsigned& nx) {
    const unsigned G = gridDim.x * gridDim.y * gridDim.z;
    unsigned sum, cnt, mine, sp = 0u;
    for (;;) {
        sum = 0u; cnt = 0u; mine = 0u;
#pragma unroll
        for (unsigned j = 0; j < 16; ++j) { const unsigned c = xb_ld(&bar[XB_XCNT(j)]); sum += c; cnt += (c > 0u) ? 1u : 0u; mine = (j == x) ? c : mine; }
        if (sum == G) break;
        __builtin_amdgcn_s_sleep(1);
        if ((++sp & 255u) == 0u) { if (xb_ld(&bar[XB_TMO])) break; if (sp > XB_SPIN_CAP) { atomicAdd(&bar[XB_TMO], 1u); break; } }
    }
    nloc = mine > 0u ? mine : 1u; nx = cnt > 0u ? cnt : 1u;
}
__device__ __forceinline__ void xcd_barrier(const XcdBarrier& b) {
    asm volatile("s_waitcnt vmcnt(0)" ::: "memory");
    __syncthreads();
    if (threadIdx.x == 0) {
        unsigned* bar = b.bar;
        __builtin_amdgcn_s_waitcnt(0);
        unsigned nloc = b.st[0], nx = b.st[1];
        if (nloc == 0u) { xcd_barrier_complete(bar, b.x, nloc, nx); b.st[0] = nloc; b.st[1] = nx; }
        const unsigned old = xb_add(&bar[XB_XSUB(b.x)], 1u);
        const unsigned gen = old / nloc;
        if (old + 1u == (gen + 1u) * nloc) {
            __builtin_amdgcn_fence(__ATOMIC_RELEASE, "agent");
            asm volatile("s_waitcnt vmcnt(0)" ::: "memory");
            const unsigned og = xb_add(&bar[XB_TOP], 1u);
            const unsigned tg = og / nx;
            if (og + 1u == (tg + 1u) * nx) xb_add(&bar[XB_TOPGEN], 1u);
            else XB_SPIN(xb_ld(&bar[XB_TOPGEN]) == tg, bar);
            __builtin_amdgcn_fence(__ATOMIC_ACQUIRE, "agent");
            xb_add(&bar[XB_XGEN(b.x)], 1u);
            asm volatile("s_waitcnt vmcnt(0)" ::: "memory");
        } else {
            XB_SPIN(xb_ld(&bar[XB_XGEN(b.x)]) == gen, bar);
            __builtin_amdgcn_fence(__ATOMIC_ACQUIRE, "agent");
            asm volatile("s_waitcnt vmcnt(0)" ::: "memory");
        }
    }
    __syncthreads();
}

struct Args {
    const float* x; const float* p; const float* norm_mix; const float* norm_ffn; const float* norm_ple; const float* norm_final;
    const float* w_in_ab; const float* lb_logits; const float* hgrn_out_norm; const float* conv_w; const float* w_out_ab;
    const float* w_in_c; const float* b_in_c; const float* sinks; const float* w_out_c; const float* b_out_c;
    const float* w_router; const float* w_gate_e; const float* w_up_e; const float* w_down_e; const float* w_ple_gate; const float* w_ple_proj;
    float* out; unsigned char* ws; int ph_lo, ph_hi;
};
struct Frame { LAS unsigned char* lds; int tid, lane, wave, vcu, G; };

__device__ __forceinline__ void transpose_item(const float* W, int N, int src_n0, int k0, bf16_t* dst  , int ldk, const float* gs, LAS float* scr, int lane) {
#pragma unroll 8
    for (int i = 0; i < 32; ++i) { const int kk = 2 * i + (lane >> 5); scr[kk * 33 + (lane & 31)] = W[(size_t)(k0 + kk) * N + src_n0 + (lane & 31)]; }
    LDS_WAIT(); asm volatile("" ::: "memory");
    const int c = lane & 7;
    float g8[8];
#pragma unroll
    for (int q = 0; q < 8; ++q) g8[q] = gs ? gs[k0 + 8 * c + q] : 1.f;
#pragma unroll
    for (int j = 0; j < 4; ++j) { const int n = (lane >> 3) + 8 * j; const LAS float* s = scr + (8 * c) * 33 + n;
        u32x4 o; o.x = pk2(s[0 * 33] * g8[0], s[1 * 33] * g8[1]); o.y = pk2(s[2 * 33] * g8[2], s[3 * 33] * g8[3]); o.z = pk2(s[4 * 33] * g8[4], s[5 * 33] * g8[5]); o.w = pk2(s[6 * 33] * g8[6], s[7 * 33] * g8[7]);
        *(u32x4*)(dst + (size_t)n * ldk + k0 + 8 * c) = o; }
    LDS_WAIT(); asm volatile("" ::: "memory");
}
__device__ __forceinline__ void phase_prep(const Frame& F, const Args& a) {
    unsigned char* ws = a.ws;
    LAS float* scr = (LAS float*)(F.lds + F.wave * 16384);
    const int gw = F.vcu * NWAVES + F.wave, NGW = F.G * NWAVES;
    constexpr int I_INAB = 16 * (ABIN / 32), I_SQ = 16 * 32, I_INC = 16 * (CIN / 32), I_PP = 4 * 32, I_W1 = 16 * 32, I_W2 = 8 * 32;
    constexpr int T0 = I_INAB, T1 = T0 + I_SQ, T2 = T1 + I_INC, T3 = T2 + I_SQ, T4 = T3 + 2 * I_SQ, T5 = T4 + 2 * I_PP, T6 = T5 + 32 * I_W1, T7 = T6 + 32 * I_W2;
    for (int it = gw; it < T7; it += NGW) {
        if (it < T0) { const int kb = it / (ABIN / 32), nb = it % (ABIN / 32), n0 = nb * 32; int src;
            if (n0 < 2560) src = n0; else { const int q = (n0 - 2560) >> 8, r = (n0 - 2560) & 255; src = (r < 128) ? 2560 + q * 128 + r : 3072 + q * 128 + (r - 128); }
            transpose_item(a.w_in_ab, ABIN, src, kb * 64, (bf16_t*)(ws + WS_WINAB) + (size_t)n0 * D, D, a.norm_mix, scr, F.lane); }
        else if (it < T1) { const int r = it - T0, kb = r / 32, nb = r % 32; transpose_item(a.w_out_ab, D, nb * 32, kb * 64, (bf16_t*)(ws + WS_WOUTAB) + (size_t)nb * 32 * D, D, nullptr, scr, F.lane); }
        else if (it < T2) { const int r = it - T1, kb = r / (CIN / 32), nb = r % (CIN / 32); transpose_item(a.w_in_c, CIN, nb * 32, kb * 64, (bf16_t*)(ws + WS_WINC) + (size_t)nb * 32 * D, D, a.norm_mix + D, scr, F.lane); }
        else if (it < T3) { const int r = it - T2, kb = r / 32, nb = r % 32; transpose_item(a.w_out_c, D, nb * 32, kb * 64, (bf16_t*)(ws + WS_WOUTC) + (size_t)nb * 32 * D, D, nullptr, scr, F.lane); }
        else if (it < T4) { const int r = it - T3, l = r / I_SQ, q = r % I_SQ, kb = q / 32, nb = q % 32;
            transpose_item(a.w_ple_gate + (size_t)l * D * D, D, nb * 32, kb * 64, (bf16_t*)(ws + WS_WPG) + (size_t)l * D * D + (size_t)nb * 32 * D, D, a.norm_ple + l * D, scr, F.lane); }
        else if (it < T5) { const int r = it - T4, l = r / I_PP, q = r % I_PP, kb = q / 32, nb = q % 32;
            transpose_item(a.w_ple_proj + (size_t)l * PLE * D, D, nb * 32, kb * 64, (bf16_t*)(ws + WS_WPP) + (size_t)l * D * PLE + (size_t)nb * 32 * PLE, PLE, nullptr, scr, F.lane); }
        else if (it < T6) { const int r = it - T5, le = r / I_W1, q = r % I_W1, kb = q / 32, nb = q % 32, n0 = nb * 32, uq = n0 >> 8, rr = n0 & 255;
            const float* src = (rr < 128) ? a.w_gate_e + (size_t)le * D * DE : a.w_up_e + (size_t)le * D * DE; const int sn = uq * 128 + (rr & 127);
            transpose_item(src, DE, sn, kb * 64, (bf16_t*)(ws + WS_W1) + (size_t)le * D * D + (size_t)n0 * D, D, nullptr, scr, F.lane); }
        else { const int r = it - T6, le = r / I_W2, q = r % I_W2, kb = q / 32, nb = q % 32;
            transpose_item(a.w_down_e + (size_t)le * DE * D, D, nb * 32, kb * 64, (bf16_t*)(ws + WS_W2) + (size_t)le * D * DE + (size_t)nb * 32 * DE, DE, nullptr, scr, F.lane); }
    }
    const int gt = F.vcu * NTHR + F.tid, NGT = F.G * NTHR;
    if (gt < AW) { const float l0 = a.lb_logits[gt], l1 = a.lb_logits[AW + gt], l2 = a.lb_logits[2 * AW + gt]; const float mx = fmaxf(l0, fmaxf(l1, l2));
        const float e0 = __expf(l0 - mx), e1 = __expf(l1 - mx), e2 = __expf(l2 - mx); ((float*)(ws + WS_LB))[gt] = e0 / (e0 + e1 + e2); }
    { const f32x4* src = (const f32x4*)a.p; u32x4* dst = (u32x4*)(ws + WS_PB); const int n8 = 2 * NT * PLE / 8;
        for (int i = gt; i < n8; i += NGT) { const f32x4 v0 = src[2 * i], v1 = src[2 * i + 1]; u32x4 o; o.x = pk2(v0[0], v0[1]); o.y = pk2(v0[2], v0[3]); o.z = pk2(v1[0], v1[1]); o.w = pk2(v1[2], v1[3]); dst[i] = o; } }
    for (int m = gw; m < NT; m += NGW) { const f32x4* xr = (const f32x4*)(a.x + (size_t)m * D) + F.lane; f32x4 v[4]; float s = 0.f;
#pragma unroll
        for (int j = 0; j < 4; ++j) { v[j] = xr[64 * j]; s += (v[j][0] * v[j][0] + v[j][1] * v[j][1]) + (v[j][2] * v[j][2] + v[j][3] * v[j][3]); }
        const float rs = __builtin_amdgcn_rsqf(wave_sum(s) * (1.f / D) + EPS);
        u32x2* o8 = (u32x2*)((bf16_t*)(ws + WS_XA) + (size_t)m * D) + F.lane;
#pragma unroll
        for (int j = 0; j < 4; ++j) { u32x2 o; o.x = pk2(v[j][0] * rs, v[j][1] * rs); o.y = pk2(v[j][2] * rs, v[j][3] * rs); o8[64 * j] = o; } }
}

__device__ __forceinline__ void phase_hgrn_conv(const Frame& F, const Args& a) {
    unsigned char* ws = a.ws; const bf16_t* Z = (const bf16_t*)(ws + WS_Z); bf16_t* XA = (bf16_t*)(ws + WS_XA); const float* lbv = (const float*)(ws + WS_LB);
    LAS float* FG = (LAS float*)F.lds; LAS float* KK = FG + 4096; LAS float* QQ = KK + 4096; LAS float* VV = QQ + 4096; LAS float* OB = VV + 4096;
    const int tid = F.tid, lane = F.lane, w = F.wave;
    for (int it = F.vcu; it < NB * AH; it += F.G) {
        const int b = it >> 2, h = it & 3; const size_t row0 = (size_t)b * SEQ;
        const int vi = lane & 15, dq = lane >> 4, v = 16 * w + vi;
        float s[32];
#pragma unroll
        for (int i = 0; i < 32; ++i) s[i] = 0.f;
        const int ltt = tid >> 4, ldd = (tid & 15) * 8;
        float lb8[8], gn8[8];
#pragma unroll
        for (int j = 0; j < 8; ++j) { lb8[j] = lbv[h * ADK + ldd + j]; gn8[j] = a.hgrn_out_norm[ldd + j]; }
        for (int c = 0; c < SEQ / 32; ++c) {
            { const bf16_t* zr = Z + (row0 + c * 32 + ltt) * ZW + h * ADK + ldd;
                const u32x4 wq = *(const u32x4*)zr, wf = *(const u32x4*)(zr + 512), wv = *(const u32x4*)(zr + 1024);
                f32x4 q0, q1, f0, f1, v0, v1; pg8::unpack8(wq, q0, q1); pg8::unpack8(wf, f0, f1); pg8::unpack8(wv, v0, v1);
                f32x4 g0, g1, k0, k1;
#pragma unroll
                for (int j = 0; j < 4; ++j) { g0[j] = lb8[j] + (1.f - lb8[j]) * sigmoidf_(f0[j]); g1[j] = lb8[4 + j] + (1.f - lb8[4 + j]) * sigmoidf_(f1[j]); k0[j] = 1.f - g0[j]; k1[j] = 1.f - g1[j]; }
                const int o = ltt * 128 + ldd;
                *(LAS f32x4*)(FG + o) = g0; *(LAS f32x4*)(FG + o + 4) = g1; *(LAS f32x4*)(KK + o) = k0; *(LAS f32x4*)(KK + o + 4) = k1;
                *(LAS f32x4*)(QQ + o) = q0; *(LAS f32x4*)(QQ + o + 4) = q1; *(LAS f32x4*)(VV + o) = v0; *(LAS f32x4*)(VV + o + 4) = v1; }
            __syncthreads();
            for (int tt = 0; tt < 32; ++tt) {
                const float vt = VV[tt * 128 + v]; float acc = 0.f;
                const LAS f32x4* fg = (const LAS f32x4*)(FG + tt * 128 + dq * 32); const LAS f32x4* kk = (const LAS f32x4*)(KK + tt * 128 + dq * 32); const LAS f32x4* qq = (const LAS f32x4*)(QQ + tt * 128 + dq * 32);
#pragma unroll
                for (int d4 = 0; d4 < 8; ++d4) { const f32x4 f4 = fg[d4], k4 = kk[d4], q4 = qq[d4];
#pragma unroll
                    for (int j = 0; j < 4; ++j) { s[d4 * 4 + j] = f4[j] * s[d4 * 4 + j] + k4[j] * vt; acc += s[d4 * 4 + j] * q4[j]; } }
                acc += __shfl_xor(acc, 16); acc += __shfl_xor(acc, 32);
                if (dq == 0) OB[tt * 128 + v] = acc;
            }
            __syncthreads();
            { const f32x4 o0 = *(const LAS f32x4*)(OB + ltt * 128 + ldd), o1 = *(const LAS f32x4*)(OB + ltt * 128 + ldd + 4);
                float ss = pg8::sq8(o0, o1); ss += __shfl_xor(ss, 1); ss += __shfl_xor(ss, 2); ss += __shfl_xor(ss, 4); ss += __shfl_xor(ss, 8);
                const float rs = __builtin_amdgcn_rsqf(ss * (1.f / 128.f) + EPS);
                const size_t row = row0 + c * 32 + ltt; f32x4 g0, g1; pg8::unpack8(*(const u32x4*)(Z + row * ZW + 1536 + h * ADK + ldd), g0, g1);
                f32x4 r0, r1;
#pragma unroll
                for (int j = 0; j < 4; ++j) { r0[j] = o0[j] * rs * gn8[j] * sigmoidf_(g0[j]); r1[j] = o1[j] * rs * gn8[4 + j] * sigmoidf_(g1[j]); }
                u32x4 o; o.x = pk2(r0[0], r0[1]); o.y = pk2(r0[2], r0[3]); o.z = pk2(r1[0], r1[1]); o.w = pk2(r1[2], r1[3]);
                *(u32x4*)(XA + row * D + h * ADK + ldd) = o; }
        }
        __syncthreads();
    }
    const int gt = F.vcu * NTHR + tid, NGT = F.G * NTHR;
    for (int i = gt; i < NT * (512 / 8); i += NGT) {
        const int row = i >> 6, c0 = (i & 63) * 8, t = row & (SEQ - 1);
        const bf16_t* zr = Z + (size_t)row * ZW;
        f32x4 y0a, y0b, y1a = (f32x4){0.f, 0.f, 0.f, 0.f}, y1b = y1a, y2a = y1a, y2b = y1a, ga, gb;
        pg8::unpack8(*(const u32x4*)(zr + 2560 + c0), y0a, y0b); pg8::unpack8(*(const u32x4*)(zr + 2048 + c0), ga, gb);
        if (t >= 1) pg8::unpack8(*(const u32x4*)(zr - ZW + 2560 + c0), y1a, y1b);
        if (t >= 2) pg8::unpack8(*(const u32x4*)(zr - 2 * ZW + 2560 + c0), y2a, y2b);
        const f32x4 w0a = *(const f32x4*)(a.conv_w + c0), w0b = *(const f32x4*)(a.conv_w + c0 + 4), w1a = *(const f32x4*)(a.conv_w + 512 + c0), w1b = *(const f32x4*)(a.conv_w + 512 + c0 + 4),
                    w2a = *(const f32x4*)(a.conv_w + 1024 + c0), w2b = *(const f32x4*)(a.conv_w + 1024 + c0 + 4);
        const f32x4 ra = ga * (w0a * y2a + w1a * y1a + w2a * y0a), rb = gb * (w0b * y2b + w1b * y1b + w2b * y0b);
        u32x4 o; o.x = pk2(ra[0], ra[1]); o.y = pk2(ra[2], ra[3]); o.z = pk2(rb[0], rb[1]); o.w = pk2(rb[2], rb[3]);
        *(u32x4*)(XA + (size_t)row * D + 512 + c0) = o;
    }
}

__device__ __forceinline__ void phase_attn(const Frame& F, const Args& a) {
    const bf16_t* QKV = (const bf16_t*)(a.ws + WS_QKV); bf16_t* XA = (bf16_t*)(a.ws + WS_XA);
    const int gw = F.vcu * NWAVES + F.wave, NGW = F.G * NWAVES, lane = F.lane;
    for (int task = gw; task < NT * NQH; task += NGW) {
        const int m = task >> 4, hq = task & 15, kv = hq >> 3, t = m & (SEQ - 1);
        const bf16_t* qp = QKV + (size_t)m * CIN + hq * HD;
        float q[64];
#pragma unroll
        for (int i = 0; i < 8; ++i) { f32x4 x0, x1; pg8::unpack8(*(const u32x4*)(qp + 8 * i), x0, x1);
#pragma unroll
            for (int j = 0; j < 4; ++j) { q[8 * i + j] = x0[j]; q[8 * i + 4 + j] = x1[j]; } }
        float sc[2];
#pragma unroll
        for (int r = 0; r < 2; ++r) { const int j = lane + 64 * r, tk = t - 127 + j; float s = -INFINITY;
            if (tk >= 0) { const bf16_t* kp = QKV + (size_t)(m - 127 + j) * CIN + 1024 + kv * HD; float d = 0.f;
#pragma unroll
                for (int i = 0; i < 8; ++i) { f32x4 x0, x1; pg8::unpack8(*(const u32x4*)(kp + 8 * i), x0, x1);
#pragma unroll
                    for (int jj = 0; jj < 4; ++jj) d += q[8 * i + jj] * x0[jj] + q[8 * i + 4 + jj] * x1[jj]; }
                s = d * 0.125f; }
            sc[r] = s; }
        const float sink = a.sinks[hq];
        const float mx = fmaxf(wave_max(fmaxf(sc[0], sc[1])), sink);
        const float e0 = __expf(sc[0] - mx), e1 = __expf(sc[1] - mx);
        const float den = wave_sum(e0 + e1) + __expf(sink - mx);
        const float inv = 1.f / den; const float p0 = e0 * inv, p1 = e1 * inv;
        float o = 0.f;
        const int j0 = (t >= 127) ? 0 : 127 - t;
        for (int j = j0; j < 128; ++j) { const float pj = __shfl(j < 64 ? p0 : p1, j & 63); o += pj * bf1(QKV[(size_t)(m - 127 + j) * CIN + 1152 + kv * HD + lane]); }
        XA[(size_t)m * D + hq * HD + lane] = (bf16_t)f2bf(o);
    }
}

__device__ __forceinline__ void phase_route(const Frame& F, const Args& a, int l) {
    unsigned char* ws = a.ws; const float* H = a.out; bf16_t* XA = (bf16_t*)(ws + WS_XA);
    gu32* cnt = (gu32*)(ws + WS_CTL) + CW_CNT + l * 32; int* list = (int*)(ws + WS_LIST); f32x2* wlist = (f32x2*)(ws + WS_WLIST);
    LAS float* WR = (LAS float*)F.lds;
    for (int i = F.tid; i < D * NE; i += NTHR) { const int k = i >> 4, e = i & 15; const int ln = (k & 255) >> 2, j = k >> 8, ii = k & 3, r = (j * 4 + ii) * 64 + ln;
        WR[r * 16 + (((e >> 2) + (ln >> 2)) & 3) * 4 + (e & 3)] = a.w_router[i]; }
    __syncthreads();
    const float* g = a.norm_ffn + l * D;
    const int gw = F.vcu * NWAVES + F.wave, NGW = F.G * NWAVES, lane = F.lane;
    f32x4 gv[4];
#pragma unroll
    for (int j = 0; j < 4; ++j) gv[j] = *((const f32x4*)g + lane + 64 * j);
    for (int m = gw; m < NT; m += NGW) {
        const f32x4* xr = (const f32x4*)(H + (size_t)m * D) + lane; f32x4 v[4]; float s = 0.f;
#pragma unroll
        for (int j = 0; j < 4; ++j) { v[j] = xr[64 * j]; s += (v[j][0] * v[j][0] + v[j][1] * v[j][1]) + (v[j][2] * v[j][2] + v[j][3] * v[j][3]); }
        const float rs = __builtin_amdgcn_rsqf(wave_sum(s) * (1.f / D) + EPS);
        u32x2* o8 = (u32x2*)(XA + (size_t)m * D) + lane;
        float lg[16];
#pragma unroll
        for (int e = 0; e < 16; ++e) lg[e] = 0.f;
#pragma unroll
        for (int j = 0; j < 4; ++j) { v[j] = v[j] * rs * gv[j]; u32x2 o; o.x = pk2(v[j][0], v[j][1]); o.y = pk2(v[j][2], v[j][3]); o8[64 * j] = o;
#pragma unroll
            for (int i = 0; i < 4; ++i) { const LAS f32x4* wr4 = (const LAS f32x4*)(WR + ((j * 4 + i) * 64 + lane) * 16);
#pragma unroll
                for (int qd = 0; qd < 4; ++qd) { const f32x4 w4 = wr4[(qd + (lane >> 2)) & 3];
#pragma unroll
                    for (int e = 0; e < 4; ++e) lg[qd * 4 + e] += v[j][i] * w4[e]; }
                asm volatile("" ::: "memory"); } }
#pragma unroll
        for (int e = 0; e < 16; ++e) lg[e] = wave_sum(lg[e]);
        float mx = lg[0];
#pragma unroll
        for (int e = 1; e < 16; ++e) mx = fmaxf(mx, lg[e]);
        float ex[16];
#pragma unroll
        for (int e = 0; e < 16; ++e) ex[e] = __expf(lg[e] - mx);
        float gs[4], gv1[4], gv2[4]; int gi1[4], gi2[4];
#pragma unroll
        for (int gq = 0; gq < 4; ++gq) { float m1 = ex[4 * gq]; int i1 = 0;
#pragma unroll
            for (int i = 1; i < 4; ++i) if (ex[4 * gq + i] > m1) { m1 = ex[4 * gq + i]; i1 = i; }
            float m2 = -1.f; int i2 = 0;
#pragma unroll
            for (int i = 0; i < 4; ++i) if (i != i1 && ex[4 * gq + i] > m2) { m2 = ex[4 * gq + i]; i2 = i; }
            gs[gq] = m1 + m2; gv1[gq] = m1; gv2[gq] = m2; gi1[gq] = i1; gi2[gq] = i2; }
        int sel = 0; float best = gs[0], v1 = gv1[0], v2 = gv2[0]; int i1 = gi1[0], i2 = gi2[0];
#pragma unroll
        for (int gq = 1; gq < 4; ++gq) if (gs[gq] > best) { best = gs[gq]; sel = gq; v1 = gv1[gq]; v2 = gv2[gq]; i1 = gi1[gq]; i2 = gi2[gq]; }
        const float wsum = 1.f / (v1 + v2); const float w1 = v1 * wsum, w2 = v2 * wsum;
        const int ea = i1 < i2 ? i1 : i2, eb = i1 < i2 ? i2 : i1; const float wa = i1 < i2 ? w1 : w2, wb = i1 < i2 ? w2 : w1;
        const int pr = (ea == 0) ? eb - 1 : ((ea == 1) ? eb + 1 : 5); const int c = sel * 6 + pr;
        if (lane == 0) { const unsigned pos = __hip_atomic_fetch_add(cnt + c, 1u, __ATOMIC_RELAXED, __HIP_MEMORY_SCOPE_AGENT);
            list[(size_t)c * LCAP + pos] = m; wlist[(size_t)c * LCAP + pos] = (f32x2){wa, wb}; }
    }
}

constexpr int LX_UT = LX_OFF + 2048;
template <int NP>
__device__ __forceinline__ void moe_tables(const Frame& F, unsigned char* ws, int l) {
    const gu32* cnt = (const gu32*)(ws + WS_CTL) + CW_CNT + l * 32;
    volatile LAS int* TB = (volatile LAS int*)(F.lds + LX_TB); volatile LAS int* CN = (volatile LAS int*)(F.lds + LX_CNT); volatile LAS int* CL = (volatile LAS int*)(F.lds + LX_CLS);
    volatile LAS unsigned long long* UT = (volatile LAS unsigned long long*)(F.lds + LX_UT);
    __syncthreads();
    if (F.tid < NCLS) CN[F.tid] = (int)__hip_atomic_load(cnt + F.tid, __ATOMIC_RELAXED, __HIP_MEMORY_SCOPE_AGENT);
    __syncthreads();
    if (F.tid == 0) { int tb = 0;
#pragma unroll 1
        for (int c = 0; c < NCLS; ++c) { TB[c] = tb; const int n = (CN[c] + 255) >> 8;
#pragma unroll 1
            for (int i = 0; i < n; ++i) CL[tb + i] = c;
            tb += n; }
        TB[NCLS] = tb; }
    __syncthreads();
    if (F.tid < 8) { const int i = F.tid; const int L = i * F.G + F.vcu; const int TT = TB[NCLS];
        unsigned long long w0 = ~0ull, w1 = 0, w2 = 0, w3 = 0, w4 = 0;
        if (L < TT * NP) { const int tau = L / NP, pn = L % NP; const int c = CL[tau]; const int ti = tau - TB[c], rem = CN[c] - ti * 256;
            const int g = c / 6, pr = c % 6; const int ea = pr < 3 ? 0 : (pr < 5 ? 1 : 2), eb = pr < 3 ? pr + 1 : (pr < 5 ? pr - 1 : 3);
            const int nv = rem < 256 ? rem : 256, aux = c * LCAP + ti * 256;
            const char *pA, *pB, *pB2;
            if (NP == 8) { const int e = g * 4 + (pn < 4 ? ea : eb); pA = (const char*)(ws + WS_XA); pB = (const char*)(ws + WS_W1) + ((size_t)(l * NE + e) * D * D + (size_t)(pn & 3) * 256 * D) * 2; pB2 = pB; }
            else { pA = (const char*)(ws + WS_HID) + (size_t)tau * 256 * 1024 * 2; pB = (const char*)(ws + WS_W2) + ((size_t)(l * NE + g * 4 + ea) * D * DE + (size_t)pn * 256 * DE) * 2;
                pB2 = (const char*)(ws + WS_W2) + ((size_t)(l * NE + g * 4 + eb) * D * DE + (size_t)pn * 256 * DE) * 2; }
            w0 = (unsigned long long)(unsigned)tau | ((unsigned long long)(unsigned)pn << 32); w1 = (unsigned long long)pA; w2 = (unsigned long long)pB; w3 = (unsigned long long)pB2;
            w4 = (unsigned long long)(unsigned)nv | ((unsigned long long)(unsigned)aux << 32); }
        UT[i * 8 + 0] = w0; UT[i * 8 + 1] = w1; UT[i * 8 + 2] = w2; UT[i * 8 + 3] = w3; UT[i * 8 + 4] = w4; }
    __syncthreads();
}
__device__ __forceinline__ unsigned long long rfl64(unsigned long long v) { const unsigned lo = __builtin_amdgcn_readfirstlane((unsigned)v), hi = __builtin_amdgcn_readfirstlane((unsigned)(v >> 32)); return ((unsigned long long)hi << 32) | lo; }
struct MoeSched {
    const LAS unsigned long long* UT; const int* list;
    __device__ __forceinline__ bool next(int i, pg8::Unit& u) const {
        if (i >= 8) return false;
        const unsigned long long w0 = rfl64(UT[i * 8 + 0]); if ((int)(unsigned)w0 < 0) return false;
        const unsigned long long w1 = rfl64(UT[i * 8 + 1]), w2 = rfl64(UT[i * 8 + 2]), w3 = rfl64(UT[i * 8 + 3]), w4 = rfl64(UT[i * 8 + 4]);
        u.pm = (int)(unsigned)w0; u.pn = (int)(unsigned)(w0 >> 32); u.pA = (const char*)w1; u.pB = (const char*)w2; u.pB2 = (const char*)w3; u.nv = (int)(unsigned)w4; u.aux = (int)(unsigned)(w4 >> 32); u.lst = list + u.aux;
        return true;
    }
};

__device__ __forceinline__ void phase_final(const Frame& F, const Args& a) {
    const int gw = F.vcu * NWAVES + F.wave, NGW = F.G * NWAVES, lane = F.lane;
    f32x4 gv[4];
#pragma unroll
    for (int j = 0; j < 4; ++j) gv[j] = *((const f32x4*)a.norm_final + lane + 64 * j);
    for (int m = gw; m < NT; m += NGW) { f32x4* xr = (f32x4*)(a.out + (size_t)m * D) + lane; f32x4 v[4]; float s = 0.f;
#pragma unroll
        for (int j = 0; j < 4; ++j) { v[j] = xr[64 * j]; s += (v[j][0] * v[j][0] + v[j][1] * v[j][1]) + (v[j][2] * v[j][2] + v[j][3] * v[j][3]); }
        const float rs = __builtin_amdgcn_rsqf(wave_sum(s) * (1.f / D) + EPS);
#pragma unroll
        for (int j = 0; j < 4; ++j) xr[64 * j] = v[j] * rs * gv[j]; }
}

constexpr int N_PHASES = 16;
#if defined(__HIP_DEVICE_COMPILE__)
#define LOAD_ARGS(a) Args a; { const __attribute__((address_space(4))) char* _kp = (const __attribute__((address_space(4))) char*)__builtin_amdgcn_kernarg_segment_ptr(); asm volatile("" : "+s"(_kp)); a = *(const Args*)(const char*)_kp; } unsigned char* ws = a.ws
#else
#define LOAD_ARGS(a) Args a = args; unsigned char* ws = a.ws
#endif
__global__ void __launch_bounds__(NTHR, 2) mega_fwd(Args args) {
    extern __shared__ __attribute__((aligned(16))) unsigned char lds_raw[];
    Frame F; F.lds = (LAS unsigned char*)lds_raw; F.tid = threadIdx.x; F.lane = F.tid & 63; F.wave = __builtin_amdgcn_readfirstlane(F.tid >> 6);
    F.G = gridDim.x; { const int bx = blockIdx.x; F.vcu = (F.G % 8 == 0) ? (bx % 8) * (F.G / 8) + bx / 8 : bx; }
    for (int u = F.tid; u < (LDS_BYTES - LX_OFF) / 4; u += NTHR) ((LAS unsigned*)(F.lds + LX_OFF))[u] = 0u;
    __syncthreads();
#if !MK_PER_PHASE
    XcdBarrier bar = xcd_barrier_post((unsigned*)((gu32*)(args.ws + WS_CTL) + CW_BAR), (volatile LAS unsigned*)(F.lds + LX_BAR));
#define GRID_BAR() xcd_barrier(bar)
#else
#define GRID_BAR() do { } while (0)
#endif
    const int lo = args.ph_lo, hi = args.ph_hi;
#define SITE_FRAME(Fp) Frame Fp = F; { int _t = threadIdx.x; asm volatile("" : "+v"(_t)); unsigned _z = 0; asm volatile("" : "+s"(_z)); Fp.tid = _t; Fp.lane = _t & 63; Fp.wave = __builtin_amdgcn_readfirstlane(_t >> 6); Fp.lds = F.lds + _z; }
#ifndef PHMASK
#define PHMASK 0xFFFF
#endif
#define IN(k) (((PHMASK >> (k)) & 1) && lo <= (k) && (k) < hi)
#define BOTH(k) (IN(k) && IN((k) + 1))
    const int bx = (int)blockIdx.x;

    if (IN(0)) { LOAD_ARGS(a); (void)ws; SITE_FRAME(Fp); phase_prep(Fp, a); if (BOTH(0)) GRID_BAR(); }

    for (int l = 0; l < 2; ++l) {
        const int pb = 1 + 7 * l;
        if (IN(pb + 0)) { LOAD_ARGS(a); SITE_FRAME(Fp);
#ifndef NO_S1A
            if (l == 0) { pg8::DenseSched S; S.init(ws + WS_XA, ws + WS_WINAB, NT, ABIN, D, D, Fp.G, bx); pg8::EpiInAb E{(bf16_t*)(ws + WS_Z)};
                pg8::gemm_phase<pg8::EpiInAb, pg8::DenseSched, false, false>(Fp.lds, D, D, D, S, E); }
#endif
#ifndef NO_S1B
            if (l == 1) { pg8::DenseSched S; S.init(ws + WS_XA, ws + WS_WINC, NT, CIN, D, D, Fp.G, bx); pg8::EpiQkv E{(bf16_t*)(ws + WS_QKV), a.b_in_c, (const float*)(ws + WS_SSB)};
                pg8::gemm_phase<pg8::EpiQkv, pg8::DenseSched, false, false>(Fp.lds, D, D, D, S, E); }
#endif
#ifndef NO_S1C
            { pg8::DenseSched S; S.init(ws + WS_PB + (size_t)l * NT * PLE * 2, ws + WS_WPP + (size_t)l * D * PLE * 2, NT, D, PLE, PLE, Fp.G, bx); pg8::EpiBf16 E{(bf16_t*)(ws + WS_PP), D};
                pg8::gemm_phase<pg8::EpiBf16, pg8::DenseSched, false, false>(Fp.lds, PLE, PLE, PLE, S, E); }
#endif
            if (BOTH(pb + 0)) GRID_BAR();
        }
        if (IN(pb + 1)) { LOAD_ARGS(a); (void)ws; SITE_FRAME(Fp); if (l == 0) phase_hgrn_conv(Fp, a); else phase_attn(Fp, a); if (BOTH(pb + 1)) GRID_BAR(); }
        if (IN(pb + 2)) { LOAD_ARGS(a); SITE_FRAME(Fp);
            pg8::DenseSched S; S.init(ws + WS_XA, ws + (l == 0 ? WS_WOUTAB : WS_WOUTC), NT, D, D, D, Fp.G, bx);
            pg8::EpiRes E{l == 0 ? a.x : a.out, a.out, l == 0 ? nullptr : a.b_out_c};
            pg8::gemm_phase<pg8::EpiRes, pg8::DenseSched, false, false>(Fp.lds, D, D, D, S, E);
            if (BOTH(pb + 2)) GRID_BAR();
        }
        if (IN(pb + 3)) { LOAD_ARGS(a); (void)ws; SITE_FRAME(Fp); phase_route(Fp, a, l); if (BOTH(pb + 3)) GRID_BAR(); }
        if (IN(pb + 4)) { LOAD_ARGS(a); SITE_FRAME(Fp); moe_tables<8>(Fp, ws, l);
            MoeSched S{(const LAS unsigned long long*)(Fp.lds + LX_UT), (const int*)(ws + WS_LIST)};
            pg8::EpiG1 E{(bf16_t*)(ws + WS_HID), (const f32x2*)(ws + WS_WLIST)};
            pg8::gemm_phase<pg8::EpiG1, MoeSched, true, false>(Fp.lds, D, D, D, S, E);
            if (BOTH(pb + 4)) GRID_BAR(); }
        if (IN(pb + 5)) { LOAD_ARGS(a); SITE_FRAME(Fp); moe_tables<4>(Fp, ws, l);
            MoeSched S{(const LAS unsigned long long*)(Fp.lds + LX_UT), (const int*)(ws + WS_LIST)};
            pg8::EpiG2 E{a.out, (bf16_t*)(ws + WS_XA2), (float*)(ws + WS_SSA)};
            pg8::gemm_phase<pg8::EpiG2, MoeSched, false, true>(Fp.lds, 1024, 1024, DE, S, E);
            if (BOTH(pb + 5)) GRID_BAR(); }
        if (IN(pb + 6)) { LOAD_ARGS(a); SITE_FRAME(Fp);
            pg8::DenseSched S; S.init(ws + WS_XA2, ws + WS_WPG + (size_t)l * D * D * 2, NT, D, D, D, Fp.G, bx);
            pg8::EpiPle E{a.out, (bf16_t*)(ws + WS_XA), (const bf16_t*)(ws + WS_PP), (const float*)(ws + WS_SSA), (float*)(ws + WS_SSB)};
            pg8::gemm_phase<pg8::EpiPle, pg8::DenseSched, false, false>(Fp.lds, D, D, D, S, E);
            if (BOTH(pb + 6)) GRID_BAR();
        }
    }
    if (IN(15)) { LOAD_ARGS(a); (void)ws; SITE_FRAME(Fp); phase_final(Fp, a); }
#undef IN
#undef BOTH
}

extern "C" void kernel_launch(void* const* d_in, const int* in_sizes, int n_in, void* d_out, int out_size, void* d_ws, size_t ws_size, hipStream_t stream) {
    static int grid = 0;
    if (grid == 0) {
        if (n_in != 22 || out_size != NT * D || ws_size < WS_END) { fprintf(stderr, "kernel_launch: unexpected shapes (n_in %d, out %d, ws %zu)\n", n_in, out_size, ws_size); grid = -1; return; }
        int dev = 0, cus = 0, per_cu = 0;
        if (hipGetDevice(&dev) != hipSuccess || hipDeviceGetAttribute(&cus, hipDeviceAttributeMultiprocessorCount, dev) != hipSuccess) { grid = -1; return; }
        if (hipFuncSetAttribute((const void*)mega_fwd, hipFuncAttributeMaxDynamicSharedMemorySize, LDS_BYTES) != hipSuccess) { fprintf(stderr, "kernel_launch: hipFuncSetAttribute failed\n"); grid = -1; return; }
        if (hipOccupancyMaxActiveBlocksPerMultiprocessor(&per_cu, (const void*)mega_fwd, NTHR, LDS_BYTES) != hipSuccess || per_cu < 1) fprintf(stderr, "kernel_launch: occupancy query says %d\n", per_cu);
        (void)hipGetLastError();
        grid = cus;
    }
    if (grid < 0) return;
    (void)hipMemsetAsync((char*)d_ws + WS_CTL, 0, CTL_ZERO_BYTES, stream);
    Args a{};
    a.x = (const float*)d_in[0]; a.p = (const float*)d_in[1]; a.norm_mix = (const float*)d_in[2]; a.norm_ffn = (const float*)d_in[3]; a.norm_ple = (const float*)d_in[4]; a.norm_final = (const float*)d_in[5];
    a.w_in_ab = (const float*)d_in[6]; a.lb_logits = (const float*)d_in[7]; a.hgrn_out_norm = (const float*)d_in[8]; a.conv_w = (const float*)d_in[9]; a.w_out_ab = (const float*)d_in[10];
    a.w_in_c = (const float*)d_in[11]; a.b_in_c = (const float*)d_in[12]; a.sinks = (const float*)d_in[13]; a.w_out_c = (const float*)d_in[14]; a.b_out_c = (const float*)d_in[15];
    a.w_router = (const float*)d_in[16]; a.w_gate_e = (const float*)d_in[17]; a.w_up_e = (const float*)d_in[18]; a.w_down_e = (const float*)d_in[19]; a.w_ple_gate = (const float*)d_in[20]; a.w_ple_proj = (const float*)d_in[21];
    a.out = (float*)d_out; a.ws = (unsigned char*)d_ws;
#if MK_PER_PHASE
    for (int ph = 0; ph < N_PHASES; ++ph) { a.ph_lo = ph; a.ph_hi = ph + 1; hipLaunchKernelGGL(mega_fwd, dim3(grid), dim3(NTHR), LDS_BYTES, stream, a); }
#else
    a.ph_lo = 0; a.ph_hi = N_PHASES; hipLaunchKernelGGL(mega_fwd, dim3(grid), dim3(NTHR), LDS_BYTES, stream, a);
#endif
}
```

```cpp
#include <hip/hip_runtime.h>
#include <cstdio>
#include <cstdint>

#ifndef MK_PER_PHASE
#define MK_PER_PHASE 0
#endif

#define LAS __attribute__((address_space(3)))
#define GAS __attribute__((address_space(1)))
typedef unsigned short bf16_t;
typedef short bf16x8 __attribute__((ext_vector_type(8)));
typedef float f32x4 __attribute__((ext_vector_type(4)));
typedef float f32x2 __attribute__((ext_vector_type(2)));
typedef unsigned u32x4 __attribute__((ext_vector_type(4)));
typedef unsigned u32x2 __attribute__((ext_vector_type(2)));
typedef GAS unsigned gu32;

constexpr int NB = 8, SEQ = 4096, D = 1024, NT = NB * SEQ;
constexpr int PLE = 256;
constexpr int AW = 512, AH = 4, ADK = 128;
constexpr int ABIN = 3584, ZW = 3072;
constexpr int CIN = 1280, HD = 64, NQH = 16, NKVH = 2, WIN = 128;
constexpr int NE = 16, DE = 512;
constexpr int NCLS = 24, LCAP = NT;
constexpr int HIDROWS = NT + NCLS * 256;
constexpr float EPS = 1e-6f;

constexpr size_t MiB = 1u << 20;
constexpr size_t WS_CTL = 0, CTL_ZERO_BYTES = 1 * MiB;
constexpr size_t WS_WINAB = 1 * MiB;
constexpr size_t WS_WOUTAB = 8 * MiB;
constexpr size_t WS_WINC = 10 * MiB;
constexpr size_t WS_WOUTC = 13 * MiB;
constexpr size_t WS_WPG = 15 * MiB;
constexpr size_t WS_WPP = 19 * MiB;
constexpr size_t WS_W1 = 20 * MiB;
constexpr size_t WS_W2 = 84 * MiB;
constexpr size_t WS_PB = 116 * MiB;
constexpr size_t WS_XA = 148 * MiB;
constexpr size_t WS_Z = 212 * MiB;
constexpr size_t WS_XA2 = WS_Z;
constexpr size_t WS_HID = WS_Z + 64 * MiB;
constexpr size_t WS_QKV = WS_Z + 64 * MiB;
constexpr size_t WS_PP = 404 * MiB;
constexpr size_t WS_LIST = 468 * MiB;
constexpr size_t WS_WLIST = 471 * MiB;
constexpr size_t WS_SSA = 477 * MiB;
constexpr size_t WS_SSB = 479 * MiB;
constexpr size_t WS_LB = 481 * MiB;
constexpr size_t WS_END = 482 * MiB;
constexpr int CW_BAR = 4096;
constexpr int CW_CNT = 16384;

constexpr int RING_BYTES = 131072;
constexpr int LX_OFF = RING_BYTES;
constexpr int LX_BAR = LX_OFF + 0;
constexpr int LX_TB = LX_OFF + 64;
constexpr int LX_CNT = LX_OFF + 64 + 128;
constexpr int LX_CLS = LX_OFF + 512;
constexpr int LDS_BYTES = 147456;
constexpr int NWAVES = 8, NTHR = 512;

__device__ __forceinline__ unsigned f2bf(float f) { unsigned u = __builtin_bit_cast(unsigned, f); return (u + 0x7fffu + ((u >> 16) & 1u)) >> 16; }
__device__ __forceinline__ unsigned pk2(float lo, float hi) { return f2bf(lo) | (f2bf(hi) << 16); }
__device__ __forceinline__ float bflo(unsigned w) { return __builtin_bit_cast(float, w << 16); }
__device__ __forceinline__ float bfhi(unsigned w) { return __builtin_bit_cast(float, w & 0xffff0000u); }
__device__ __forceinline__ float bf1(bf16_t h) { return __builtin_bit_cast(float, (unsigned)h << 16); }
__device__ __forceinline__ float sigmoidf_(float x) { return __builtin_amdgcn_rcpf(1.f + __expf(-x)); }
__device__ __forceinline__ float siluf_(float x) { return x * sigmoidf_(x); }
__device__ __forceinline__ float wave_sum(float v) {
#pragma unroll
    for (int o = 1; o < 64; o <<= 1) v += __shfl_xor(v, o);
    return v;
}
__device__ __forceinline__ float wave_max(float v) {
#pragma unroll
    for (int o = 1; o < 64; o <<= 1) v = fmaxf(v, __shfl_xor(v, o));
    return v;
}
#define LDS_WAIT() asm volatile("s_waitcnt lgkmcnt(0)" ::: "memory")

namespace pg8 {
constexpr int BM = 256, BK = 64, HALF = 128, HTB = HALF * BK * 2, NXCD = 8, WGM = 8;
__host__ __device__ __forceinline__ int lds_byte(int r, int c) { const int st = (r >> 4) * 2 + (c >> 5), rr = r & 15, cc = c & 31, ob = rr * 64 + cc * 2; return st * 1024 + (ob ^ (((ob >> 9) & 1) << 5)); }
__host__ __device__ __forceinline__ void stage_rc(int b, int& R, int& C) { const int st = b / 1024, sb = b % 1024, swz = sb ^ (((sb >> 9) & 1) << 5); R = (st >> 1) * 16 + swz / 64; C = (st & 1) * 32 + (swz % 64) / 2; }
__host__ __device__ __forceinline__ int perm32(int rho) { const int n = rho >> 4, i = rho & 15; return 8 * (i >> 2) + 4 * n + (i & 3); }

struct Unit { int pm, pn; const char* pA; const char* pB; const char* pB2; const int* lst; int nv; int aux; };

struct StaticOrder {
    int nM, nN, nwg, G, c;
    __device__ void init(int M, int N, int G_, int c_) { nM = M / BM; nN = N / BM; nwg = nM * nN; G = G_; c = c_; }
    __device__ bool next(int i, int& pm, int& pn) const {
        const long L = (long)i * G + c; if (L >= nwg) return false;
        int wgid = (int)L; { const int q = nwg / NXCD, r = nwg % NXCD, xcd = wgid % NXCD, off = wgid / NXCD; wgid = (xcd < r ? xcd * (q + 1) : r * (q + 1) + (xcd - r) * q) + off; }
        const int nig = WGM * nN, gid = wgid / nig, fm = gid * WGM, gsz = (nM - fm) < WGM ? (nM - fm) : WGM;
        pm = fm + ((wgid % nig) % gsz); pn = (wgid % nig) / gsz; return true;
    }
};
struct DenseSched {
    StaticOrder so; const char* A; const char* B; size_t tA, tB;
    __device__ void init(const void* A_, const void* B_, int M, int N, int lda, int ldb, int G, int c) { so.init(M, N, G, c); A = (const char*)A_; B = (const char*)B_; tA = (size_t)BM * lda * 2; tB = (size_t)BM * ldb * 2; }
    __device__ __forceinline__ bool next(int i, Unit& u) const {
        int pm, pn; if (!so.next(i, pm, pn)) return false;
        u.pm = pm; u.pn = pn; u.pA = A + (size_t)pm * tA; u.pB = B + (size_t)pn * tB; u.pB2 = u.pB; u.lst = nullptr; u.nv = BM; u.aux = 0; return true;
    }
};

__device__ __forceinline__ unsigned cvt_pk_bf16(float lo, float hi) { unsigned r; asm volatile("v_cvt_pk_bf16_f32 %0, %1, %2" : "=v"(r) : "v"(lo), "v"(hi)); return r; }

template <class Epi, class Sched, bool GATHER, bool SPLITB>
__device__ __forceinline__ void gemm_phase(LAS unsigned char* lds, const int K, const int lda, const int ldb, const Sched& S, const Epi& E) {
    int tid = threadIdx.x; asm volatile("" : "+v"(tid));
    const int wid = __builtin_amdgcn_readfirstlane(tid >> 6), lane = tid & 63, wr = wid >> 2, wc = wid & 3, fr = lane & 15, fq = lane >> 4;
    int nt = K / BK; asm volatile("" : "+s"(nt));
    const int ntB = nt >> 1;
    unsigned voffA[2], voffB[2];
#pragma unroll
    for (int i = 0; i < 2; ++i) { int R, C; stage_rc(tid * 16 + i * 8192, R, C); const int Rb = (R & ~31) + perm32(R & 31); voffA[i] = (unsigned)(R * lda + C) * 2u; voffB[i] = (unsigned)(Rb * ldb + C) * 2u; }
    const size_t kstep = (size_t)(BK * 2);
    const size_t hstepB = (size_t)HALF * ldb * 2;
    const size_t hstepA = (size_t)HALF * lda * 2;
    const unsigned ldsw = (unsigned)wid * 1024u;
    const int aoff = lds_byte(wr * 64 + fr, fq * 8), boff = lds_byte(wc * 32 + fr, fq * 8);
#define PG8_SA(b, h) (((b) * 2 + (h)) * HTB)
#define PG8_SB(b, h) ((4 + (b) * 2 + (h)) * HTB)
#define PG8_STAGE(bufoff, gbase, voff) do { _Pragma("unroll") for (int _i = 0; _i < 2; ++_i) \
        __builtin_amdgcn_global_load_lds((const unsigned*)((const char*)(gbase) + (voff)[_i]), (LAS unsigned*)(lds + (bufoff) + ldsw + _i * 8192), 16, 0, 0); } while (0)
#define PG8_LDA(dst, b, h) do { _Pragma("unroll") for (int m = 0; m < 4; ++m) _Pragma("unroll") for (int k = 0; k < 2; ++k) dst[m][k] = *(const LAS bf16x8*)(lds + PG8_SA(b, h) + aoff + m * 2048 + k * 1024); } while (0)
#define PG8_LDB(dst, b, h) do { _Pragma("unroll") for (int n = 0; n < 2; ++n) _Pragma("unroll") for (int k = 0; k < 2; ++k) dst[n][k] = *(const LAS bf16x8*)(lds + PG8_SB(b, h) + boff + n * 2048 + k * 1024); } while (0)
#define PG8_MMA(ai, bj, At, Bt) do { __builtin_amdgcn_s_setprio(1); _Pragma("unroll") for (int m = 0; m < 4; ++m) _Pragma("unroll") for (int n = 0; n < 2; ++n) _Pragma("unroll") for (int k = 0; k < 2; ++k) \
        acc[ai][bj][m][n] = __builtin_amdgcn_mfma_f32_16x16x32_bf16(Bt[n][k], At[m][k], acc[ai][bj][m][n], 0, 0, 0); __builtin_amdgcn_s_setprio(0); } while (0)
#define PG8_WAIT_V(n) asm volatile("s_waitcnt vmcnt(" #n ")" ::: "memory")
#define PG8_WAIT_L(n) asm volatile("s_waitcnt lgkmcnt(" #n ")" ::: "memory")
#define PG8_BAR __builtin_amdgcn_s_barrier()
#define PG8_SCHED __builtin_amdgcn_sched_barrier(0)
#define PG8_GOFF(G, u) do { if constexpr (GATHER) { _Pragma("unroll") for (int _h = 0; _h < 2; ++_h) _Pragma("unroll") for (int _i = 0; _i < 2; ++_i) { \
        int _R, _C; stage_rc(tid * 16 + _i * 8192, _R, _C); int _ix = _h * HALF + _R; _ix = _ix < (u).nv ? _ix : (u).nv - 1; const int _tok = (u).lst[_ix]; G[_h][_i] = (unsigned)_tok * (unsigned)(lda * 2) + (unsigned)(_C * 2); } } } while (0)
#define PG8_STAGE_A(bufoff, gbase, half, G) do { if constexpr (GATHER) { PG8_STAGE(bufoff, gbase, G[half]); } else { PG8_STAGE(bufoff, (gbase) + (half) * hstepA, voffA); } } while (0)
#define PG8_BPTR(u, tt) ((SPLITB && (tt) >= ntB) ? (u).pB2 + (size_t)((tt) - ntB) * kstep : (u).pB + (size_t)(tt) * kstep)
    Unit cur; int ui = 0;
    if (!S.next(0, cur)) return;
    f32x4 acc[2][2][4][2];
#pragma unroll
    for (int a = 0; a < 2; ++a)
#pragma unroll
        for (int b = 0; b < 2; ++b)
#pragma unroll
            for (int m = 0; m < 4; ++m)
#pragma unroll
                for (int n = 0; n < 2; ++n) acc[a][b][m][n] = (f32x4){0.f, 0.f, 0.f, 0.f};
    bf16x8 At[4][2], B0[2][2], B1[2][2];
    unsigned cG[2][2];
    LAS u32x4* gstash = (LAS u32x4*)(lds + 135168) + tid;
    PG8_GOFF(cG, cur);
    const char* cA = cur.pA; const char* cB = cur.pB;
    PG8_STAGE(PG8_SB(0, 0), cB, voffB); PG8_STAGE(PG8_SB(0, 1), cB + hstepB, voffB); PG8_STAGE_A(PG8_SA(0, 0), cA, 0, cG); PG8_STAGE_A(PG8_SA(0, 1), cA, 1, cG);
    if (wr == 1) PG8_BAR;
    PG8_WAIT_V(2); PG8_BAR;
    PG8_STAGE(PG8_SB(1, 0), cB + kstep, voffB); PG8_STAGE_A(PG8_SA(1, 0), cA + kstep, 0, cG); PG8_STAGE(PG8_SB(1, 1), cB + hstepB + kstep, voffB);
    PG8_WAIT_V(6); PG8_BAR;
    for (;;) {
        Unit nxt; const bool has_next = S.next(ui + 1, nxt);
        if constexpr (GATHER) { unsigned nG[2][2];
            if (has_next) { PG8_GOFF(nG, nxt); } else {
#pragma unroll
            for (int h = 0; h < 2; ++h)
#pragma unroll
                for (int i = 0; i < 2; ++i) nG[h][i] = cG[h][i]; }
            *gstash = (u32x4){nG[0][0], nG[0][1], nG[1][0], nG[1][1]}; }
        const char* nA = has_next ? nxt.pA : cA; const char* nB = has_next ? nxt.pB : cB;
        for (int t = 0; t < nt; t += 2) {
            const bool last = (t == nt - 2);
            const char* a1 = cA + (size_t)(t + 1) * kstep;
            const char* a2 = last ? nA : cA + (size_t)(t + 2) * kstep; const char* a3 = a2 + kstep;
            const char* b2 = last ? nB : PG8_BPTR(cur, t + 2); const char* b3 = b2 + kstep;
            unsigned g2[2][2];
            if constexpr (GATHER) {
                if (last) { const u32x4 st = *gstash; g2[0][0] = st.x; g2[0][1] = st.y; g2[1][0] = st.z; g2[1][1] = st.w; }
                else {
#pragma unroll
                for (int h = 0; h < 2; ++h)
#pragma unroll
                    for (int i = 0; i < 2; ++i) g2[h][i] = cG[h][i]; } }
            PG8_LDB(B0, 0, 0); PG8_LDB(B1, 0, 1); PG8_SCHED; PG8_LDA(At, 0, 0); PG8_STAGE_A(PG8_SA(1, 1), a1, 1, cG);
            PG8_WAIT_V(8); PG8_WAIT_L(0); PG8_BAR; PG8_MMA(0, 0, At, B0); PG8_MMA(0, 1, At, B1); PG8_BAR; PG8_SCHED;
            PG8_LDA(At, 0, 1); PG8_STAGE(PG8_SB(0, 0), b2, voffB); PG8_STAGE(PG8_SB(0, 1), b2 + hstepB, voffB); PG8_STAGE_A(PG8_SA(0, 0), a2, 0, g2);
            PG8_WAIT_V(8); PG8_WAIT_L(0); PG8_BAR; PG8_MMA(1, 0, At, B0); PG8_MMA(1, 1, At, B1); PG8_BAR; PG8_SCHED;
            PG8_LDB(B0, 1, 0); PG8_LDB(B1, 1, 1); PG8_SCHED; PG8_LDA(At, 1, 0); PG8_STAGE_A(PG8_SA(0, 1), a2, 1, g2);
            PG8_WAIT_V(8); PG8_WAIT_L(0); PG8_BAR; PG8_MMA(0, 0, At, B0); PG8_MMA(0, 1, At, B1); PG8_BAR; PG8_SCHED;
            PG8_LDA(At, 1, 1); PG8_STAGE(PG8_SB(1, 0), b3, voffB); PG8_STAGE(PG8_SB(1, 1), b3 + hstepB, voffB); PG8_STAGE_A(PG8_SA(1, 0), a3, 0, g2);
            PG8_WAIT_V(8); PG8_WAIT_L(0); PG8_BAR; PG8_MMA(1, 0, At, B0); PG8_MMA(1, 1, At, B1); PG8_BAR; PG8_SCHED;
        }
        if (wr == 0) PG8_BAR;
        E(acc, cur, wr, wc, fr, fq);
        if (!has_next) break;
#pragma unroll
        for (int a = 0; a < 2; ++a)
#pragma unroll
            for (int b = 0; b < 2; ++b)
#pragma unroll
                for (int m = 0; m < 4; ++m)
#pragma unroll
                    for (int n = 0; n < 2; ++n) acc[a][b][m][n] = (f32x4){0.f, 0.f, 0.f, 0.f};
        ++ui; (void)S.next(ui, cur); cA = nA; cB = nB;
        if constexpr (GATHER) { const u32x4 st = *gstash; cG[0][0] = st.x; cG[0][1] = st.y; cG[1][0] = st.z; cG[1][1] = st.w; }
        if (wr == 1) PG8_BAR;
    }
    PG8_WAIT_V(0);
    PG8_BAR;
#undef PG8_SA
#undef PG8_SB
#undef PG8_STAGE
#undef PG8_LDA
#undef PG8_LDB
#undef PG8_MMA
#undef PG8_WAIT_V
#undef PG8_WAIT_L
#undef PG8_BAR
#undef PG8_SCHED
#undef PG8_GOFF
#undef PG8_STAGE_A
#undef PG8_BPTR
}

typedef const f32x4 (&AccRef)[2][2][4][2];
#define EPI_ROW(u, ai, m) ((u).pm * BM + (ai) * HALF + wr * 64 + (m) * 16 + fr)
#define EPI_COL(u, bj) ((u).pn * BM + (bj) * HALF + wc * 32 + fq * 8)
__device__ __forceinline__ u32x4 pack8(const f32x4& a, const f32x4& b) { u32x4 w; w.x = cvt_pk_bf16(a[0], a[1]); w.y = cvt_pk_bf16(a[2], a[3]); w.z = cvt_pk_bf16(b[0], b[1]); w.w = cvt_pk_bf16(b[2], b[3]); return w; }
__device__ __forceinline__ float sq8(const f32x4& a, const f32x4& b) { return (a[0] * a[0] + a[1] * a[1]) + (a[2] * a[2] + a[3] * a[3]) + (b[0] * b[0] + b[1] * b[1]) + (b[2] * b[2] + b[3] * b[3]); }
__device__ __forceinline__ void unpack8(const u32x4& w, f32x4& a, f32x4& b) { a = (f32x4){bflo(w.x), bfhi(w.x), bflo(w.y), bfhi(w.y)}; b = (f32x4){bflo(w.z), bfhi(w.z), bflo(w.w), bfhi(w.w)}; }

struct EpiBf16 {
    bf16_t* O; int ldc;
    __device__ __forceinline__ void operator()(AccRef acc, const Unit& u, int wr, int wc, int fr, int fq) const {
#pragma unroll
        for (int ai = 0; ai < 2; ++ai)
#pragma unroll
            for (int m = 0; m < 4; ++m) { bf16_t* rowp = O + (size_t)EPI_ROW(u, ai, m) * ldc;
#pragma unroll
                for (int bj = 0; bj < 2; ++bj) *(u32x4*)(rowp + EPI_COL(u, bj)) = pack8(acc[ai][bj][m][0], acc[ai][bj][m][1]); }
    }
};
struct EpiInAb {
    bf16_t* Z;
    __device__ __forceinline__ void operator()(AccRef acc, const Unit& u, int wr, int wc, int fr, int fq) const {
        if (u.pn >= 10) {
#pragma unroll
            for (int ai = 0; ai < 2; ++ai)
#pragma unroll
                for (int m = 0; m < 4; ++m) { bf16_t* rowp = Z + (size_t)EPI_ROW(u, ai, m) * ZW;
                    const f32x4 a = acc[ai][0][m][0] * acc[ai][1][m][0], b = acc[ai][0][m][1] * acc[ai][1][m][1];
                    *(u32x4*)(rowp + 2560 + (u.pn - 10) * HALF + wc * 32 + fq * 8) = pack8(a, b); }
        } else if (u.pn < 2) {
#pragma unroll
            for (int ai = 0; ai < 2; ++ai)
#pragma unroll
                for (int m = 0; m < 4; ++m) { bf16_t* rowp = Z + (size_t)EPI_ROW(u, ai, m) * ZW;
#pragma unroll
                    for (int bj = 0; bj < 2; ++bj) { f32x4 a = acc[ai][bj][m][0], b = acc[ai][bj][m][1];
#pragma unroll
                        for (int j = 0; j < 4; ++j) { a[j] = siluf_(a[j]); b[j] = siluf_(b[j]); }
                        *(u32x4*)(rowp + EPI_COL(u, bj)) = pack8(a, b); }
                    asm volatile("" ::: "memory"); }
        } else {
#pragma unroll
            for (int ai = 0; ai < 2; ++ai)
#pragma unroll
                for (int m = 0; m < 4; ++m) { bf16_t* rowp = Z + (size_t)EPI_ROW(u, ai, m) * ZW;
#pragma unroll
                    for (int bj = 0; bj < 2; ++bj) *(u32x4*)(rowp + EPI_COL(u, bj)) = pack8(acc[ai][bj][m][0], acc[ai][bj][m][1]); }
        }
    }
};
struct EpiRes {
    const float* X; float* O; const float* bias;
    __device__ __forceinline__ void operator()(AccRef acc, const Unit& u, int wr, int wc, int fr, int fq) const {
#pragma unroll
        for (int ai = 0; ai < 2; ++ai)
#pragma unroll
            for (int m = 0; m < 4; ++m) { const size_t ro = (size_t)EPI_ROW(u, ai, m) * D;
#pragma unroll
                for (int bj = 0; bj < 2; ++bj) { const int c = EPI_COL(u, bj);
                    f32x4 x0 = *(const f32x4*)(X + ro + c), x1 = *(const f32x4*)(X + ro + c + 4);
                    if (bias) { x0 += *(const f32x4*)(bias + c); x1 += *(const f32x4*)(bias + c + 4); }
                    *(f32x4*)(O + ro + c) = x0 + acc[ai][bj][m][0]; *(f32x4*)(O + ro + c + 4) = x1 + acc[ai][bj][m][1]; }
                asm volatile("" ::: "memory"); }
    }
};
__device__ __forceinline__ float rstd16(const float* ss, int row) {
    const f32x4* p = (const f32x4*)(ss + (size_t)row * 16); const f32x4 a = p[0], b = p[1], c = p[2], d = p[3];
    const float s = ((a[0] + a[1]) + (a[2] + a[3])) + ((b[0] + b[1]) + (b[2] + b[3])) + ((c[0] + c[1]) + (c[2] + c[3])) + ((d[0] + d[1]) + (d[2] + d[3]));
    return __builtin_amdgcn_rsqf(s * (1.f / D) + EPS);
}
struct EpiQkv {
    bf16_t* O; const float* bias; const float* ss;
    __device__ __forceinline__ void operator()(AccRef acc, const Unit& u, int wr, int wc, int fr, int fq) const {
#pragma unroll
        for (int ai = 0; ai < 2; ++ai)
#pragma unroll
            for (int m = 0; m < 4; ++m) { const int row = EPI_ROW(u, ai, m); const float rs = rstd16(ss, row); bf16_t* rowp = O + (size_t)row * CIN;
#pragma unroll
                for (int bj = 0; bj < 2; ++bj) { const int c = EPI_COL(u, bj);
                    const f32x4 a = acc[ai][bj][m][0] * rs + *(const f32x4*)(bias + c), b = acc[ai][bj][m][1] * rs + *(const f32x4*)(bias + c + 4);
                    *(u32x4*)(rowp + c) = pack8(a, b); }
                asm volatile("" ::: "memory"); }
    }
};
struct EpiG1 {
    bf16_t* HID; const f32x2* wl;
    __device__ __forceinline__ void operator()(AccRef acc, const Unit& u, int wr, int wc, int fr, int fq) const {
#pragma unroll
        for (int ai = 0; ai < 2; ++ai)
#pragma unroll
            for (int m = 0; m < 4; ++m) { const int rit = ai * HALF + wr * 64 + m * 16 + fr;
                const f32x2 w2 = wl[(size_t)u.aux + rit]; const float w = (u.pn < 4) ? w2.x : w2.y;
                bf16_t* rowp = HID + (size_t)(u.pm * BM + rit) * 1024 + (u.pn >> 2) * 512 + (u.pn & 3) * HALF + wc * 32 + fq * 8;
                f32x4 a, b;
#pragma unroll
                for (int j = 0; j < 4; ++j) { a[j] = siluf_(acc[ai][0][m][0][j]) * acc[ai][1][m][0][j] * w; b[j] = siluf_(acc[ai][0][m][1][j]) * acc[ai][1][m][1][j] * w; }
                *(u32x4*)rowp = pack8(a, b);
                asm volatile("" ::: "memory"); }
    }
};
struct EpiG2 {
    float* H; bf16_t* HB; float* SS;
    __device__ __forceinline__ void operator()(AccRef acc, const Unit& u, int wr, int wc, int fr, int fq) const {
#pragma unroll
        for (int ai = 0; ai < 2; ++ai)
#pragma unroll
            for (int m = 0; m < 4; ++m) { const int rit = ai * HALF + wr * 64 + m * 16 + fr; const bool ok = rit < u.nv;
                const int tok = u.lst[ok ? rit : 0]; float part = 0.f;
                if (ok) { const size_t ro = (size_t)tok * D;
#pragma unroll
                    for (int bj = 0; bj < 2; ++bj) { const int c = EPI_COL(u, bj);
                        const f32x4 h0 = *(const f32x4*)(H + ro + c) + acc[ai][bj][m][0], h1 = *(const f32x4*)(H + ro + c + 4) + acc[ai][bj][m][1];
                        *(f32x4*)(H + ro + c) = h0; *(f32x4*)(H + ro + c + 4) = h1; *(u32x4*)(HB + ro + c) = pack8(h0, h1); part += sq8(h0, h1); } }
                part += __shfl_xor(part, 16); part += __shfl_xor(part, 32);
                if (ok && fq == 0) SS[(size_t)tok * 16 + u.pn * 4 + wc] = part;
                asm volatile("" ::: "memory"); }
    }
};
struct EpiPle {
    float* H; bf16_t* HB; const bf16_t* PP; const float* ssi; float* sso;
    __device__ __forceinline__ void operator()(AccRef acc, const Unit& u, int wr, int wc, int fr, int fq) const {
#pragma unroll
        for (int ai = 0; ai < 2; ++ai)
#pragma unroll
            for (int m = 0; m < 4; ++m) { const int row = EPI_ROW(u, ai, m); const float rs = rstd16(ssi, row); const size_t ro = (size_t)row * D; float part = 0.f;
#pragma unroll
                for (int bj = 0; bj < 2; ++bj) { const int c = EPI_COL(u, bj);
                    f32x4 p0, p1; unpack8(*(const u32x4*)(PP + ro + c), p0, p1);
                    f32x4 h0 = *(const f32x4*)(H + ro + c), h1 = *(const f32x4*)(H + ro + c + 4);
#pragma unroll
                    for (int j = 0; j < 4; ++j) { h0[j] += sigmoidf_(acc[ai][bj][m][0][j] * rs) * p0[j]; h1[j] += sigmoidf_(acc[ai][bj][m][1][j] * rs) * p1[j]; }
                    *(f32x4*)(H + ro + c) = h0; *(f32x4*)(H + ro + c + 4) = h1; *(u32x4*)(HB + ro + c) = pack8(h0, h1); part += sq8(h0, h1); }
                part += __shfl_xor(part, 16); part += __shfl_xor(part, 32);
                if (fq == 0) sso[(size_t)row * 16 + u.pn * 4 + wc] = part;
                asm volatile("" ::: "memory"); }
    }
};
}

#define XB_TMO      128
#define XB_XCNT(j)  (256  + 64 * (j))
#define XB_XSUB(j)  (1280 + 64 * (j))
#define XB_XGEN(j)  (2304 + 64 * (j))
#define XB_TOP      3328
#define XB_TOPGEN   3392
#define XCD_BAR_WORDS 3456
#define XB_SPIN_CAP (1u << 18)
__device__ __forceinline__ unsigned xb_ld(unsigned* p)              { return __hip_atomic_load(p, __ATOMIC_RELAXED, __HIP_MEMORY_SCOPE_AGENT); }
__device__ __forceinline__ unsigned xb_add(unsigned* p, unsigned v) { return __hip_atomic_fetch_add(p, v, __ATOMIC_RELAXED, __HIP_MEMORY_SCOPE_AGENT); }
__device__ __forceinline__ unsigned xb_xcc_id() { return (unsigned)__builtin_amdgcn_s_getreg((3 << 11) | 20) & 0xFu; }
#define XB_SPIN(cond, bar) do { unsigned _sp = 0; while (cond) { __builtin_amdgcn_s_sleep(1); \
    if ((++_sp & 255u) == 0u) { if (xb_ld(&(bar)[XB_TMO])) break; if (_sp > XB_SPIN_CAP) { atomicAdd(&(bar)[XB_TMO], 1u); break; } } } } while (0)
struct XcdBarrier { unsigned* bar; unsigned x; volatile LAS unsigned* st; };
__device__ __forceinline__ XcdBarrier xcd_barrier_post(unsigned* bar, volatile LAS unsigned* st) {
    XcdBarrier b; b.bar = bar; b.x = xb_xcc_id(); b.st = st;
    if (threadIdx.x == 0) (void)xb_add(&bar[XB_XCNT(b.x)], 1u);
    return b;
}
__device__ __forceinline__ void xcd_barrier_complete(unsigned* bar, unsigned x, unsigned& nloc, unsigned& nx) {
    const unsigned G = gridDim.x * gridDim.y * gridDim.z;
    unsigned sum, cnt, mine, sp = 0u;
    for (;;) {
        sum = 0u; cnt = 0u; mine = 0u;
#pragma unroll
        for (unsigned j = 0; j < 16; ++j) { const unsigned c = xb_ld(&bar[XB_XCNT(j)]); sum += c; cnt += (c > 0u) ? 1u : 0u; mine = (j == x) ? c : mine; }
        if (sum == G) break;
        __builtin_amdgcn_s_sleep(1);
        if ((++sp & 255u) == 0u) { if (xb_ld(&bar[XB_TMO])) break; if (sp > XB_SPIN_CAP) { atomicAdd(&bar[XB_TMO], 1u); break; } }
    }
    nloc = mine > 0u ? mine : 1u; nx = cnt > 0u ? cnt : 1u;
}
__device__ __forceinline__ void xcd_barrier(const XcdBarrier& b) {
    asm volatile("s_waitcnt vmcnt(0)" ::: "memory");
    __syncthreads();
    if (threadIdx.x == 0) {
        unsigned* bar = b.bar;
        __builtin_amdgcn_s_waitcnt(0);
        unsigned nloc = b.st[0], nx = b.st[1];
        if (nloc == 0u) { xcd_barrier_complete(bar, b.x, nloc, nx); b.st[0] = nloc; b.st[1] = nx; }
        const unsigned old = xb_add(&bar[XB_XSUB(b.x)], 1u);
        const unsigned gen = old / nloc;
        if (old + 1u == (gen + 1u) * nloc) {
            __builtin_amdgcn_fence(__ATOMIC_RELEASE, "agent");
            asm volatile("s_waitcnt vmcnt(0)" ::: "memory");
            const unsigned og = xb_add(&bar[XB_TOP], 1u);
            const unsigned tg = og / nx;
            if (og + 1u == (tg + 1u) * nx) xb_add(&bar[XB_TOPGEN], 1u);
            else XB_SPIN(xb_ld(&bar[XB_TOPGEN]) == tg, bar);
            __builtin_amdgcn_fence(__ATOMIC_ACQUIRE, "agent");
            xb_add(&bar[XB_XGEN(b.x)], 1u);
            asm volatile("s_waitcnt vmcnt(0)" ::: "memory");
        } else {
            XB_SPIN(xb_ld(&bar[XB_XGEN(b.x)]) == gen, bar);
            __builtin_amdgcn_fence(__ATOMIC_ACQUIRE, "agent");
            asm volatile("s_waitcnt vmcnt(0)" ::: "memory");
        }
    }
    __syncthreads();
}

struct Args {
    const float* x; const float* p; const float* norm_mix; const float* norm_ffn; const float* norm_ple; const float* norm_final;
    const float* w_in_ab; const float* lb_logits; const float* hgrn_out_norm; const float* conv_w; const float* w_out_ab;
    const float* w_in_c; const float* b_in_c; const float* sinks; const float* w_out_c; const float* b_out_c;
    const float* w_router; const float* w_gate_e; const float* w_up_e; const float* w_down_e; const float* w_ple_gate; const float* w_ple_proj;
    float* out; unsigned char* ws; int ph_lo, ph_hi;
};
struct Frame { LAS unsigned char* lds; int tid, lane, wave, vcu, G; };

__device__ __forceinline__ void transpose_item(const float* W, int N, int src_n0, int k0, bf16_t* dst  , int ldk, const float* gs, LAS float* scr, int lane) {
#pragma unroll 8
    for (int i = 0; i < 32; ++i) { const int kk = 2 * i + (lane >> 5); scr[kk * 33 + (lane & 31)] = W[(size_t)(k0 + kk) * N + src_n0 + (lane & 31)]; }
    LDS_WAIT(); asm volatile("" ::: "memory");
    const int c = lane & 7;
    float g8[8];
#pragma unroll
    for (int q = 0; q < 8; ++q) g8[q] = gs ? gs[k0 + 8 * c + q] : 1.f;
#pragma unroll
    for (int j = 0; j < 4; ++j) { const int n = (lane >> 3) + 8 * j; const LAS float* s = scr + (8 * c) * 33 + n;
        u32x4 o; o.x = pk2(s[0 * 33] * g8[0], s[1 * 33] * g8[1]); o.y = pk2(s[2 * 33] * g8[2], s[3 * 33] * g8[3]); o.z = pk2(s[4 * 33] * g8[4], s[5 * 33] * g8[5]); o.w = pk2(s[6 * 33] * g8[6], s[7 * 33] * g8[7]);
        *(u32x4*)(dst + (size_t)n * ldk + k0 + 8 * c) = o; }
    LDS_WAIT(); asm volatile("" ::: "memory");
}
__device__ __forceinline__ void phase_prep(const Frame& F, const Args& a) {
    unsigned char* ws = a.ws;
    LAS float* scr = (LAS float*)(F.lds + F.wave * 16384);
    const int gw = F.vcu * NWAVES + F.wave, NGW = F.G * NWAVES;
    constexpr int I_INAB = 16 * (ABIN / 32), I_SQ = 16 * 32, I_INC = 16 * (CIN / 32), I_PP = 4 * 32, I_W1 = 16 * 32, I_W2 = 8 * 32;
    constexpr int T0 = I_INAB, T1 = T0 + I_SQ, T2 = T1 + I_INC, T3 = T2 + I_SQ, T4 = T3 + 2 * I_SQ, T5 = T4 + 2 * I_PP, T6 = T5 + 32 * I_W1, T7 = T6 + 32 * I_W2;
    for (int it = gw; it < T7; it += NGW) {
        if (it < T0) { const int kb = it / (ABIN / 32), nb = it % (ABIN / 32), n0 = nb * 32; int src;
            if (n0 < 2560) src = n0; else { const int q = (n0 - 2560) >> 8, r = (n0 - 2560) & 255; src = (r < 128) ? 2560 + q * 128 + r : 3072 + q * 128 + (r - 128); }
            transpose_item(a.w_in_ab, ABIN, src, kb * 64, (bf16_t*)(ws + WS_WINAB) + (size_t)n0 * D, D, a.norm_mix, scr, F.lane); }
        else if (it < T1) { const int r = it - T0, kb = r / 32, nb = r % 32; transpose_item(a.w_out_ab, D, nb * 32, kb * 64, (bf16_t*)(ws + WS_WOUTAB) + (size_t)nb * 32 * D, D, nullptr, scr, F.lane); }
        else if (it < T2) { const int r = it - T1, kb = r / (CIN / 32), nb = r % (CIN / 32); transpose_item(a.w_in_c, CIN, nb * 32, kb * 64, (bf16_t*)(ws + WS_WINC) + (size_t)nb * 32 * D, D, a.norm_mix + D, scr, F.lane); }
        else if (it < T3) { const int r = it - T2, kb = r / 32, nb = r % 32; transpose_item(a.w_out_c, D, nb * 32, kb * 64, (bf16_t*)(ws + WS_WOUTC) + (size_t)nb * 32 * D, D, nullptr, scr, F.lane); }
        else if (it < T4) { const int r = it - T3, l = r / I_SQ, q = r % I_SQ, kb = q / 32, nb = q % 32;
            transpose_item(a.w_ple_gate + (size_t)l * D * D, D, nb * 32, kb * 64, (bf16_t*)(ws + WS_WPG) + (size_t)l * D * D + (size_t)nb * 32 * D, D, a.norm_ple + l * D, scr, F.lane); }
        else if (it < T5) { const int r = it - T4, l = r / I_PP, q = r % I_PP, kb = q / 32, nb = q % 32;
            transpose_item(a.w_ple_proj + (size_t)l * PLE * D, D, nb * 32, kb * 64, (bf16_t*)(ws + WS_WPP) + (size_t)l * D * PLE + (size_t)nb * 32 * PLE, PLE, nullptr, scr, F.lane); }
        else if (it < T6) { const int r = it - T5, le = r / I_W1, q = r % I_W1, kb = q / 32, nb = q % 32, n0 = nb * 32, uq = n0 >> 8, rr = n0 & 255;
            const float* src = (rr < 128) ? a.w_gate_e + (size_t)le * D * DE : a.w_up_e + (size_t)le * D * DE; const int sn = uq * 128 + (rr & 127);
            transpose_item(src, DE, sn, kb * 64, (bf16_t*)(ws + WS_W1) + (size_t)le * D * D + (size_t)n0 * D, D, nullptr, scr, F.lane); }
        else { const int r = it - T6, le = r / I_W2, q = r % I_W2, kb = q / 32, nb = q % 32;
            transpose_item(a.w_down_e + (size_t)le * DE * D, D, nb * 32, kb * 64, (bf16_t*)(ws + WS_W2) + (size_t)le * D * DE + (size_t)nb * 32 * DE, DE, nullptr, scr, F.lane); }
    }
    const int gt = F.vcu * NTHR + F.tid, NGT = F.G * NTHR;
    if (gt < AW) { const float l0 = a.lb_logits[gt], l1 = a.lb_logits[AW + gt], l2 = a.lb_logits[2 * AW + gt]; const float mx = fmaxf(l0, fmaxf(l1, l2));
        const float e0 = __expf(l0 - mx), e1 = __expf(l1 - mx), e2 = __expf(l2 - mx); ((float*)(ws + WS_LB))[gt] = e0 / (e0 + e1 + e2); }
    { const f32x4* src = (const f32x4*)a.p; u32x4* dst = (u32x4*)(ws + WS_PB); const int n8 = 2 * NT * PLE / 8;
        for (int i = gt; i < n8; i += NGT) { const f32x4 v0 = src[2 * i], v1 = src[2 * i + 1]; u32x4 o; o.x = pk2(v0[0], v0[1]); o.y = pk2(v0[2], v0[3]); o.z = pk2(v1[0], v1[1]); o.w = pk2(v1[2], v1[3]); dst[i] = o; } }
    for (int m = gw; m < NT; m += NGW) { const f32x4* xr = (const f32x4*)(a.x + (size_t)m * D) + F.lane; f32x4 v[4]; float s = 0.f;
#pragma unroll
        for (int j = 0; j < 4; ++j) { v[j] = xr[64 * j]; s += (v[j][0] * v[j][0] + v[j][1] * v[j][1]) + (v[j][2] * v[j][2] + v[j][3] * v[j][3]); }
        const float rs = __builtin_amdgcn_rsqf(wave_sum(s) * (1.f / D) + EPS);
        u32x2* o8 = (u32x2*)((bf16_t*)(ws + WS_XA) + (size_t)m * D) + F.lane;
#pragma unroll
        for (int j = 0; j < 4; ++j) { u32x2 o; o.x = pk2(v[j][0] * rs, v[j][1] * rs); o.y = pk2(v[j][2] * rs, v[j][3] * rs); o8[64 * j] = o; } }
}

__device__ __forceinline__ void phase_hgrn_conv(const Frame& F, const Args& a) {
    unsigned char* ws = a.ws; const bf16_t* Z = (const bf16_t*)(ws + WS_Z); bf16_t* XA = (bf16_t*)(ws + WS_XA); const float* lbv = (const float*)(ws + WS_LB);
    LAS float* FG = (LAS float*)F.lds; LAS float* KK = FG + 4096; LAS float* QQ = KK + 4096; LAS float* VV = QQ + 4096; LAS float* OB = VV + 4096;
    const int tid = F.tid, lane = F.lane, w = F.wave;
    for (int it = F.vcu; it < NB * AH; it += F.G) {
        const int b = it >> 2, h = it & 3; const size_t row0 = (size_t)b * SEQ;
        const int vi = lane & 15, dq = lane >> 4, v = 16 * w + vi;
        float s[32];
#pragma unroll
        for (int i = 0; i < 32; ++i) s[i] = 0.f;
        const int ltt = tid >> 4, ldd = (tid & 15) * 8;
        float lb8[8], gn8[8];
#pragma unroll
        for (int j = 0; j < 8; ++j) { lb8[j] = lbv[h * ADK + ldd + j]; gn8[j] = a.hgrn_out_norm[ldd + j]; }
        for (int c = 0; c < SEQ / 32; ++c) {
            { const bf16_t* zr = Z + (row0 + c * 32 + ltt) * ZW + h * ADK + ldd;
                const u32x4 wq = *(const u32x4*)zr, wf = *(const u32x4*)(zr + 512), wv = *(const u32x4*)(zr + 1024);
                f32x4 q0, q1, f0, f1, v0, v1; pg8::unpack8(wq, q0, q1); pg8::unpack8(wf, f0, f1); pg8::unpack8(wv, v0, v1);
                f32x4 g0, g1, k0, k1;
#pragma unroll
                for (int j = 0; j < 4; ++j) { g0[j] = lb8[j] + (1.f - lb8[j]) * sigmoidf_(f0[j]); g1[j] = lb8[4 + j] + (1.f - lb8[4 + j]) * sigmoidf_(f1[j]); k0[j] = 1.f - g0[j]; k1[j] = 1.f - g1[j]; }
                const int o = ltt * 128 + ldd;
                *(LAS f32x4*)(FG + o) = g0; *(LAS f32x4*)(FG + o + 4) = g1; *(LAS f32x4*)(KK + o) = k0; *(LAS f32x4*)(KK + o + 4) = k1;
                *(LAS f32x4*)(QQ + o) = q0; *(LAS f32x4*)(QQ + o + 4) = q1; *(LAS f32x4*)(VV + o) = v0; *(LAS f32x4*)(VV + o + 4) = v1; }
            __syncthreads();
            for (int tt = 0; tt < 32; ++tt) {
                const float vt = VV[tt * 128 + v]; float acc = 0.f;
                const LAS f32x4* fg = (const LAS f32x4*)(FG + tt * 128 + dq * 32); const LAS f32x4* kk = (const LAS f32x4*)(KK + tt * 128 + dq * 32); const LAS f32x4* qq = (const LAS f32x4*)(QQ + tt * 128 + dq * 32);
#pragma unroll
                for (int d4 = 0; d4 < 8; ++d4) { const f32x4 f4 = fg[d4], k4 = kk[d4], q4 = qq[d4];
#pragma unroll
                    for (int j = 0; j < 4; ++j) { s[d4 * 4 + j] = f4[j] * s[d4 * 4 + j] + k4[j] * vt; acc += s[d4 * 4 + j] * q4[j]; } }
                acc += __shfl_xor(acc, 16); acc += __shfl_xor(acc, 32);
                if (dq == 0) OB[tt * 128 + v] = acc;
            }
            __syncthreads();
            { const f32x4 o0 = *(const LAS f32x4*)(OB + ltt * 128 + ldd), o1 = *(const LAS f32x4*)(OB + ltt * 128 + ldd + 4);
                float ss = pg8::sq8(o0, o1); ss += __shfl_xor(ss, 1); ss += __shfl_xor(ss, 2); ss += __shfl_xor(ss, 4); ss += __shfl_xor(ss, 8);
                const float rs = __builtin_amdgcn_rsqf(ss * (1.f / 128.f) + EPS);
                const size_t row = row0 + c * 32 + ltt; f32x4 g0, g1; pg8::unpack8(*(const u32x4*)(Z + row * ZW + 1536 + h * ADK + ldd), g0, g1);
                f32x4 r0, r1;
#pragma unroll
                for (int j = 0; j < 4; ++j) { r0[j] = o0[j] * rs * gn8[j] * sigmoidf_(g0[j]); r1[j] = o1[j] * rs * gn8[4 + j] * sigmoidf_(g1[j]); }
                u32x4 o; o.x = pk2(r0[0], r0[1]); o.y = pk2(r0[2], r0[3]); o.z = pk2(r1[0], r1[1]); o.w = pk2(r1[2], r1[3]);
                *(u32x4*)(XA + row * D + h * ADK + ldd) = o; }
        }
        __syncthreads();
    }
    const int gt = F.vcu * NTHR + tid, NGT = F.G * NTHR;
    for (int i = gt; i < NT * (512 / 8); i += NGT) {
        const int row = i >> 6, c0 = (i & 63) * 8, t = row & (SEQ - 1);
        const bf16_t* zr = Z + (size_t)row * ZW;
        f32x4 y0a, y0b, y1a = (f32x4){0.f, 0.f, 0.f, 0.f}, y1b = y1a, y2a = y1a, y2b = y1a, ga, gb;
        pg8::unpack8(*(const u32x4*)(zr + 2560 + c0), y0a, y0b); pg8::unpack8(*(const u32x4*)(zr + 2048 + c0), ga, gb);
        if (t >= 1) pg8::unpack8(*(const u32x4*)(zr - ZW + 2560 + c0), y1a, y1b);
        if (t >= 2) pg8::unpack8(*(const u32x4*)(zr - 2 * ZW + 2560 + c0), y2a, y2b);
        const f32x4 w0a = *(const f32x4*)(a.conv_w + c0), w0b = *(const f32x4*)(a.conv_w + c0 + 4), w1a = *(const f32x4*)(a.conv_w + 512 + c0), w1b = *(const f32x4*)(a.conv_w + 512 + c0 + 4),
                    w2a = *(const f32x4*)(a.conv_w + 1024 + c0), w2b = *(const f32x4*)(a.conv_w + 1024 + c0 + 4);
        const f32x4 ra = ga * (w0a * y2a + w1a * y1a + w2a * y0a), rb = gb * (w0b * y2b + w1b * y1b + w2b * y0b);
        u32x4 o; o.x = pk2(ra[0], ra[1]); o.y = pk2(ra[2], ra[3]); o.z = pk2(rb[0], rb[1]); o.w = pk2(rb[2], rb[3]);
        *(u32x4*)(XA + (size_t)row * D + 512 + c0) = o;
    }
}

__device__ __forceinline__ void phase_attn(const Frame& F, const Args& a) {
    const bf16_t* QKV = (const bf16_t*)(a.ws + WS_QKV); bf16_t* XA = (bf16_t*)(a.ws + WS_XA);
    const int gw = F.vcu * NWAVES + F.wave, NGW = F.G * NWAVES, lane = F.lane;
    for (int task = gw; task < NT * NQH; task += NGW) {
        const int m = task >> 4, hq = task & 15, kv = hq >> 3, t = m & (SEQ - 1);
        const bf16_t* qp = QKV + (size_t)m * CIN + hq * HD;
        float q[64];
#pragma unroll
        for (int i = 0; i < 8; ++i) { f32x4 x0, x1; pg8::unpack8(*(const u32x4*)(qp + 8 * i), x0, x1);
#pragma unroll
            for (int j = 0; j < 4; ++j) { q[8 * i + j] = x0[j]; q[8 * i + 4 + j] = x1[j]; } }
        float sc[2];
#pragma unroll
        for (int r = 0; r < 2; ++r) { const int j = lane + 64 * r, tk = t - 127 + j; float s = -INFINITY;
            if (tk >= 0) { const bf16_t* kp = QKV + (size_t)(m - 127 + j) * CIN + 1024 + kv * HD; float d = 0.f;
#pragma unroll
                for (int i = 0; i < 8; ++i) { f32x4 x0, x1; pg8::unpack8(*(const u32x4*)(kp + 8 * i), x0, x1);
#pragma unroll
                    for (int jj = 0; jj < 4; ++jj) d += q[8 * i + jj] * x0[jj] + q[8 * i + 4 + jj] * x1[jj]; }
                s = d * 0.125f; }
            sc[r] = s; }
        const float sink = a.sinks[hq];
        const float mx = fmaxf(wave_max(fmaxf(sc[0], sc[1])), sink);
        const float e0 = __expf(sc[0] - mx), e1 = __expf(sc[1] - mx);
        const float den = wave_sum(e0 + e1) + __expf(sink - mx);
        const float inv = 1.f / den; const float p0 = e0 * inv, p1 = e1 * inv;
        float o = 0.f;
        const int j0 = (t >= 127) ? 0 : 127 - t;
        for (int j = j0; j < 128; ++j) { const float pj = __shfl(j < 64 ? p0 : p1, j & 63); o += pj * bf1(QKV[(size_t)(m - 127 + j) * CIN + 1152 + kv * HD + lane]); }
        XA[(size_t)m * D + hq * HD + lane] = (bf16_t)f2bf(o);
    }
}

__device__ __forceinline__ void phase_route(const Frame& F, const Args& a, int l) {
    unsigned char* ws = a.ws; const float* H = a.out; bf16_t* XA = (bf16_t*)(ws + WS_XA);
    gu32* cnt = (gu32*)(ws + WS_CTL) + CW_CNT + l * 32; int* list = (int*)(ws + WS_LIST); f32x2* wlist = (f32x2*)(ws + WS_WLIST);
    LAS float* WR = (LAS float*)F.lds;
    for (int i = F.tid; i < D * NE; i += NTHR) { const int k = i >> 4, e = i & 15; const int ln = (k & 255) >> 2, j = k >> 8, ii = k & 3, r = (j * 4 + ii) * 64 + ln;
        WR[r * 16 + (((e >> 2) + (ln >> 2)) & 3) * 4 + (e & 3)] = a.w_router[i]; }
    __syncthreads();
    const float* g = a.norm_ffn + l * D;
    const int gw = F.vcu * NWAVES + F.wave, NGW = F.G * NWAVES, lane = F.lane;
    f32x4 gv[4];
#pragma unroll
    for (int j = 0; j < 4; ++j) gv[j] = *((const f32x4*)g + lane + 64 * j);
    for (int m = gw; m < NT; m += NGW) {
        const f32x4* xr = (const f32x4*)(H + (size_t)m * D) + lane; f32x4 v[4]; float s = 0.f;
#pragma unroll
        for (int j = 0; j < 4; ++j) { v[j] = xr[64 * j]; s += (v[j][0] * v[j][0] + v[j][1] * v[j][1]) + (v[j][2] * v[j][2] + v[j][3] * v[j][3]); }
        const float rs = __builtin_amdgcn_rsqf(wave_sum(s) * (1.f / D) + EPS);
        u32x2* o8 = (u32x2*)(XA + (size_t)m * D) + lane;
        float lg[16];
#pragma unroll
        for (int e = 0; e < 16; ++e) lg[e] = 0.f;
#pragma unroll
        for (int j = 0; j < 4; ++j) { v[j] = v[j] * rs * gv[j]; u32x2 o; o.x = pk2(v[j][0], v[j][1]); o.y = pk2(v[j][2], v[j][3]); o8[64 * j] = o;
#pragma unroll
            for (int i = 0; i < 4; ++i) { const LAS f32x4* wr4 = (const LAS f32x4*)(WR + ((j * 4 + i) * 64 + lane) * 16);
#pragma unroll
                for (int qd = 0; qd < 4; ++qd) { const f32x4 w4 = wr4[(qd + (lane >> 2)) & 3];
#pragma unroll
                    for (int e = 0; e < 4; ++e) lg[qd * 4 + e] += v[j][i] * w4[e]; }
                asm volatile("" ::: "memory"); } }
#pragma unroll
        for (int e = 0; e < 16; ++e) lg[e] = wave_sum(lg[e]);
        float mx = lg[0];
#pragma unroll
        for (int e = 1; e < 16; ++e) mx = fmaxf(mx, lg[e]);
        float ex[16];
#pragma unroll
        for (int e = 0; e < 16; ++e) ex[e] = __expf(lg[e] - mx);
        float gs[4], gv1[4], gv2[4]; int gi1[4], gi2[4];
#pragma unroll
        for (int gq = 0; gq < 4; ++gq) { float m1 = ex[4 * gq]; int i1 = 0;
#pragma unroll
            for (int i = 1; i < 4; ++i) if (ex[4 * gq + i] > m1) { m1 = ex[4 * gq + i]; i1 = i; }
            float m2 = -1.f; int i2 = 0;
#pragma unroll
            for (int i = 0; i < 4; ++i) if (i != i1 && ex[4 * gq + i] > m2) { m2 = ex[4 * gq + i]; i2 = i; }
            gs[gq] = m1 + m2; gv1[gq] = m1; gv2[gq] = m2; gi1[gq] = i1; gi2[gq] = i2; }
        int sel = 0; float best = gs[0], v1 = gv1[0], v2 = gv2[0]; int i1 = gi1[0], i2 = gi2[0];
#pragma unroll
        for (int gq = 1; gq < 4; ++gq) if (gs[gq] > best) { best = gs[gq]; sel = gq; v1 = gv1[gq]; v2 = gv2[gq]; i1 = gi1[gq]; i2 = gi2[gq]; }
        const float wsum = 1.f / (v1 + v2); const float w1 = v1 * wsum, w2 = v2 * wsum;
        const int ea = i1 < i2 ? i1 : i2, eb = i1 < i2 ? i2 : i1; const float wa = i1 < i2 ? w1 : w2, wb = i1 < i2 ? w2 : w1;
        const int pr = (ea == 0) ? eb - 1 : ((ea == 1) ? eb + 1 : 5); const int c = sel * 6 + pr;
        if (lane == 0) { const unsigned pos = __hip_atomic_fetch_add(cnt + c, 1u, __ATOMIC_RELAXED, __HIP_MEMORY_SCOPE_AGENT);
            list[(size_t)c * LCAP + pos] = m; wlist[(size_t)c * LCAP + pos] = (f32x2){wa, wb}; }
    }
}

constexpr int LX_UT = LX_OFF + 2048;
template <int NP>
__device__ __forceinline__ void moe_tables(const Frame& F, unsigned char* ws, int l) {
    const gu32* cnt = (const gu32*)(ws + WS_CTL) + CW_CNT + l * 32;
    volatile LAS int* TB = (volatile LAS int*)(F.lds + LX_TB); volatile LAS int* CN = (volatile LAS int*)(F.lds + LX_CNT); volatile LAS int* CL = (volatile LAS int*)(F.lds + LX_CLS);
    volatile LAS unsigned long long* UT = (volatile LAS unsigned long long*)(F.lds + LX_UT);
    __syncthreads();
    if (F.tid < NCLS) CN[F.tid] = (int)__hip_atomic_load(cnt + F.tid, __ATOMIC_RELAXED, __HIP_MEMORY_SCOPE_AGENT);
    __syncthreads();
    if (F.tid == 0) { int tb = 0;
#pragma unroll 1
        for (int c = 0; c < NCLS; ++c) { TB[c] = tb; const int n = (CN[c] + 255) >> 8;
#pragma unroll 1
            for (int i = 0; i < n; ++i) CL[tb + i] = c;
            tb += n; }
        TB[NCLS] = tb; }
    __syncthreads();
    if (F.tid < 8) { const int i = F.tid; const int L = i * F.G + F.vcu; const int TT = TB[NCLS];
        unsigned long long w0 = ~0ull, w1 = 0, w2 = 0, w3 = 0, w4 = 0;
        if (L < TT * NP) { const int tau = L / NP, pn = L % NP; const int c = CL[tau]; const int ti = tau - TB[c], rem = CN[c] - ti * 256;
            const int g = c / 6, pr = c % 6; const int ea = pr < 3 ? 0 : (pr < 5 ? 1 : 2), eb = pr < 3 ? pr + 1 : (pr < 5 ? pr - 1 : 3);
            const int nv = rem < 256 ? rem : 256, aux = c * LCAP + ti * 256;
            const char *pA, *pB, *pB2;
            if (NP == 8) { const int e = g * 4 + (pn < 4 ? ea : eb); pA = (const char*)(ws + WS_XA); pB = (const char*)(ws + WS_W1) + ((size_t)(l * NE + e) * D * D + (size_t)(pn & 3) * 256 * D) * 2; pB2 = pB; }
            else { pA = (const char*)(ws + WS_HID) + (size_t)tau * 256 * 1024 * 2; pB = (const char*)(ws + WS_W2) + ((size_t)(l * NE + g * 4 + ea) * D * DE + (size_t)pn * 256 * DE) * 2;
                pB2 = (const char*)(ws + WS_W2) + ((size_t)(l * NE + g * 4 + eb) * D * DE + (size_t)pn * 256 * DE) * 2; }
            w0 = (unsigned long long)(unsigned)tau | ((unsigned long long)(unsigned)pn << 32); w1 = (unsigned long long)pA; w2 = (unsigned long long)pB; w3 = (unsigned long long)pB2;
            w4 = (unsigned long long)(unsigned)nv | ((unsigned long long)(unsigned)aux << 32); }
        UT[i * 8 + 0] = w0; UT[i * 8 + 1] = w1; UT[i * 8 + 2] = w2; UT[i * 8 + 3] = w3; UT[i * 8 + 4] = w4; }
    __syncthreads();
}
__device__ __forceinline__ unsigned long long rfl64(unsigned long long v) { const unsigned lo = __builtin_amdgcn_readfirstlane((unsigned)v), hi = __builtin_amdgcn_readfirstlane((unsigned)(v >> 32)); return ((unsigned long long)hi << 32) | lo; }
struct MoeSched {
    const LAS unsigned long long* UT; const int* list;
    __device__ __forceinline__ bool next(int i, pg8::Unit& u) const {
        if (i >= 8) return false;
        const unsigned long long w0 = rfl64(UT[i * 8 + 0]); if ((int)(unsigned)w0 < 0) return false;
        const unsigned long long w1 = rfl64(UT[i * 8 + 1]), w2 = rfl64(UT[i * 8 + 2]), w3 = rfl64(UT[i * 8 + 3]), w4 = rfl64(UT[i * 8 + 4]);
        u.pm = (int)(unsigned)w0; u.pn = (int)(unsigned)(w0 >> 32); u.pA = (const char*)w1; u.pB = (const char*)w2; u.pB2 = (const char*)w3; u.nv = (int)(unsigned)w4; u.aux = (int)(unsigned)(w4 >> 32); u.lst = list + u.aux;
        return true;
    }
};

__device__ __forceinline__ void phase_final(const Frame& F, const Args& a) {
    const int gw = F.vcu * NWAVES + F.wave, NGW = F.G * NWAVES, lane = F.lane;
    f32x4 gv[4];
#pragma unroll
    for (int j = 0; j < 4; ++j) gv[j] = *((const f32x4*)a.norm_final + lane + 64 * j);
    for (int m = gw; m < NT; m += NGW) { f32x4* xr = (f32x4*)(a.out + (size_t)m * D) + lane; f32x4 v[4]; float s = 0.f;
#pragma unroll
        for (int j = 0; j < 4; ++j) { v[j] = xr[64 * j]; s += (v[j][0] * v[j][0] + v[j][1] * v[j][1]) + (v[j][2] * v[j][2] + v[j][3] * v[j][3]); }
        const float rs = __builtin_amdgcn_rsqf(wave_sum(s) * (1.f / D) + EPS);
#pragma unroll
        for (int j = 0; j < 4; ++j) xr[64 * j] = v[j] * rs * gv[j]; }
}

constexpr int N_PHASES = 16;
#if defined(__HIP_DEVICE_COMPILE__)
#define LOAD_ARGS(a) Args a; { const __attribute__((address_space(4))) char* _kp = (const __attribute__((address_space(4))) char*)__builtin_amdgcn_kernarg_segment_ptr(); asm volatile("" : "+s"(_kp)); a = *(const Args*)(const char*)_kp; } unsigned char* ws = a.ws
#else
#define LOAD_ARGS(a) Args a = args; unsigned char* ws = a.ws
#endif
__global__ void __launch_bounds__(NTHR, 2) mega_fwd(Args args) {
    extern __shared__ __attribute__((aligned(16))) unsigned char lds_raw[];
    Frame F; F.lds = (LAS unsigned char*)lds_raw; F.tid = threadIdx.x; F.lane = F.tid & 63; F.wave = __builtin_amdgcn_readfirstlane(F.tid >> 6);
    F.G = gridDim.x; { const int bx = blockIdx.x; F.vcu = (F.G % 8 == 0) ? (bx % 8) * (F.G / 8) + bx / 8 : bx; }
    for (int u = F.tid; u < (LDS_BYTES - LX_OFF) / 4; u += NTHR) ((LAS unsigned*)(F.lds + LX_OFF))[u] = 0u;
    __syncthreads();
#if !MK_PER_PHASE
    XcdBarrier bar = xcd_barrier_post((unsigned*)((gu32*)(args.ws + WS_CTL) + CW_BAR), (volatile LAS unsigned*)(F.lds + LX_BAR));
#define GRID_BAR() xcd_barrier(bar)
#else
#define GRID_BAR() do { } while (0)
#endif
    const int lo = args.ph_lo, hi = args.ph_hi;
#define SITE_FRAME(Fp) Frame Fp = F; { int _t = threadIdx.x; asm volatile("" : "+v"(_t)); unsigned _z = 0; asm volatile("" : "+s"(_z)); Fp.tid = _t; Fp.lane = _t & 63; Fp.wave = __builtin_amdgcn_readfirstlane(_t >> 6); Fp.lds = F.lds + _z; }
#ifndef PHMASK
#define PHMASK 0xFFFF
#endif
#define IN(k) (((PHMASK >> (k)) & 1) && lo <= (k) && (k) < hi)
#define BOTH(k) (IN(k) && IN((k) + 1))
    const int bx = (int)blockIdx.x;

    if (IN(0)) { LOAD_ARGS(a); (void)ws; SITE_FRAME(Fp); phase_prep(Fp, a); if (BOTH(0)) GRID_BAR(); }

    for (int l = 0; l < 2; ++l) {
        const int pb = 1 + 7 * l;
        if (IN(pb + 0)) { LOAD_ARGS(a); SITE_FRAME(Fp);
#ifndef NO_S1A
            if (l == 0) { pg8::DenseSched S; S.init(ws + WS_XA, ws + WS_WINAB, NT, ABIN, D, D, Fp.G, bx); pg8::EpiInAb E{(bf16_t*)(ws + WS_Z)};
                pg8::gemm_phase<pg8::EpiInAb, pg8::DenseSched, false, false>(Fp.lds, D, D, D, S, E); }
#endif
#ifndef NO_S1B
            if (l == 1) { pg8::DenseSched S; S.init(ws + WS_XA, ws + WS_WINC, NT, CIN, D, D, Fp.G, bx); pg8::EpiQkv E{(bf16_t*)(ws + WS_QKV), a.b_in_c, (const float*)(ws + WS_SSB)};
                pg8::gemm_phase<pg8::EpiQkv, pg8::DenseSched, false, false>(Fp.lds, D, D, D, S, E); }
#endif
#ifndef NO_S1C
            { pg8::DenseSched S; S.init(ws + WS_PB + (size_t)l * NT * PLE * 2, ws + WS_WPP + (size_t)l * D * PLE * 2, NT, D, PLE, PLE, Fp.G, bx); pg8::EpiBf16 E{(bf16_t*)(ws + WS_PP), D};
                pg8::gemm_phase<pg8::EpiBf16, pg8::DenseSched, false, false>(Fp.lds, PLE, PLE, PLE, S, E); }
#endif
            if (BOTH(pb + 0)) GRID_BAR();
        }
        if (IN(pb + 1)) { LOAD_ARGS(a); (void)ws; SITE_FRAME(Fp); if (l == 0) phase_hgrn_conv(Fp, a); else phase_attn(Fp, a); if (BOTH(pb + 1)) GRID_BAR(); }
        if (IN(pb + 2)) { LOAD_ARGS(a); SITE_FRAME(Fp);
            pg8::DenseSched S; S.init(ws + WS_XA, ws + (l == 0 ? WS_WOUTAB : WS_WOUTC), NT, D, D, D, Fp.G, bx);
            pg8::EpiRes E{l == 0 ? a.x : a.out, a.out, l == 0 ? nullptr : a.b_out_c};
            pg8::gemm_phase<pg8::EpiRes, pg8::DenseSched, false, false>(Fp.lds, D, D, D, S, E);
            if (BOTH(pb + 2)) GRID_BAR();
        }
        if (IN(pb + 3)) { LOAD_ARGS(a); (void)ws; SITE_FRAME(Fp); phase_route(Fp, a, l); if (BOTH(pb + 3)) GRID_BAR(); }
        if (IN(pb + 4)) { LOAD_ARGS(a); SITE_FRAME(Fp); moe_tables<8>(Fp, ws, l);
            MoeSched S{(const LAS unsigned long long*)(Fp.lds + LX_UT), (const int*)(ws + WS_LIST)};
            pg8::EpiG1 E{(bf16_t*)(ws + WS_HID), (const f32x2*)(ws + WS_WLIST)};
            pg8::gemm_phase<pg8::EpiG1, MoeSched, true, false>(Fp.lds, D, D, D, S, E);
            if (BOTH(pb + 4)) GRID_BAR(); }
        if (IN(pb + 5)) { LOAD_ARGS(a); SITE_FRAME(Fp); moe_tables<4>(Fp, ws, l);
            MoeSched S{(const LAS unsigned long long*)(Fp.lds + LX_UT), (const int*)(ws + WS_LIST)};
            pg8::EpiG2 E{a.out, (bf16_t*)(ws + WS_XA2), (float*)(ws + WS_SSA)};
            pg8::gemm_phase<pg8::EpiG2, MoeSched, false, true>(Fp.lds, 1024, 1024, DE, S, E);
            if (BOTH(pb + 5)) GRID_BAR(); }
        if (IN(pb + 6)) { LOAD_ARGS(a); SITE_FRAME(Fp);
            pg8::DenseSched S; S.init(ws + WS_XA2, ws + WS_WPG + (size_t)l * D * D * 2, NT, D, D, D, Fp.G, bx);
            pg8::EpiPle E{a.out, (bf16_t*)(ws + WS_XA), (const bf16_t*)(ws + WS_PP), (const float*)(ws + WS_SSA), (float*)(ws + WS_SSB)};
            pg8::gemm_phase<pg8::EpiPle, pg8::DenseSched, false, false>(Fp.lds, D, D, D, S, E);
            if (BOTH(pb + 6)) GRID_BAR();
        }
    }
    if (IN(15)) { LOAD_ARGS(a); (void)ws; SITE_FRAME(Fp); phase_final(Fp, a); }
#undef IN
#undef BOTH
}

extern "C" void kernel_launch(void* const* d_in, const int* in_sizes, int n_in, void* d_out, int out_size, void* d_ws, size_t ws_size, hipStream_t stream) {
    static int grid = 0;
    if (grid == 0) {
        if (n_in != 22 || out_size != NT * D || ws_size < WS_END) { fprintf(stderr, "kernel_launch: unexpected shapes (n_in %d, out %d, ws %zu)\n", n_in, out_size, ws_size); grid = -1; return; }
        int dev = 0, cus = 0, per_cu = 0;
        if (hipGetDevice(&dev) != hipSuccess || hipDeviceGetAttribute(&cus, hipDeviceAttributeMultiprocessorCount, dev) != hipSuccess) { grid = -1; return; }
        if (hipFuncSetAttribute((const void*)mega_fwd, hipFuncAttributeMaxDynamicSharedMemorySize, LDS_BYTES) != hipSuccess) { fprintf(stderr, "kernel_launch: hipFuncSetAttribute failed\n"); grid = -1; return; }
        if (hipOccupancyMaxActiveBlocksPerMultiprocessor(&per_cu, (const void*)mega_fwd, NTHR, LDS_BYTES) != hipSuccess || per_cu < 1) fprintf(stderr, "kernel_launch: occupancy query says %d\n", per_cu);
        (void)hipGetLastError();
        grid = cus;
    }
    if (grid < 0) return;
    (void)hipMemsetAsync((char*)d_ws + WS_CTL, 0, CTL_ZERO_BYTES, stream);
    Args a{};
    a.x = (const float*)d_in[0]; a.p = (const float*)d_in[1]; a.norm_mix = (const float*)d_in[2]; a.norm_ffn = (const float*)d_in[3]; a.norm_ple = (const float*)d_in[4]; a.norm_final = (const float*)d_in[5];
    a.w_in_ab = (const float*)d_in[6]; a.lb_logits = (const float*)d_in[7]; a.hgrn_out_norm = (const float*)d_in[8]; a.conv_w = (const float*)d_in[9]; a.w_out_ab = (const float*)d_in[10];
    a.w_in_c = (const float*)d_in[11]; a.b_in_c = (const float*)d_in[12]; a.sinks = (const float*)d_in[13]; a.w_out_c = (const float*)d_in[14]; a.b_out_c = (const float*)d_in[15];
    a.w_router = (const float*)d_in[16]; a.w_gate_e = (const float*)d_in[17]; a.w_up_e = (const float*)d_in[18]; a.w_down_e = (const float*)d_in[19]; a.w_ple_gate = (const float*)d_in[20]; a.w_ple_proj = (const float*)d_in[21];
    a.out = (float*)d_out; a.ws = (unsigned char*)d_ws;
#if MK_PER_PHASE
    for (int ph = 0; ph < N_PHASES; ++ph) { a.ph_lo = ph; a.ph_hi = ph + 1; hipLaunchKernelGGL(mega_fwd, dim3(grid), dim3(NTHR), LDS_BYTES, stream, a); }
#else
    a.ph_lo = 0; a.ph_hi = N_PHASES; hipLaunchKernelGGL(mega_fwd, dim3(grid), dim3(NTHR), LDS_BYTES, stream, a);
#endif
}
```

```cpp
#include <hip/hip_runtime.h>
#include <cstdio>
#include <cstdint>

#ifndef MK_PER_PHASE
#define MK_PER_PHASE 0
#endif

#define LAS __attribute__((address_space(3)))
#define GAS __attribute__((address_space(1)))
typedef unsigned short bf16_t;
typedef short bf16x8 __attribute__((ext_vector_type(8)));
typedef float f32x4 __attribute__((ext_vector_type(4)));
typedef float f32x2 __attribute__((ext_vector_type(2)));
typedef unsigned u32x4 __attribute__((ext_vector_type(4)));
typedef unsigned u32x2 __attribute__((ext_vector_type(2)));
typedef GAS unsigned gu32;

constexpr int NB = 8, SEQ = 4096, D = 1024, NT = NB * SEQ;
constexpr int PLE = 256;
constexpr int AW = 512, AH = 4, ADK = 128;
constexpr int ABIN = 3584, ZW = 3072;
constexpr int CIN = 1280, HD = 64, NQH = 16, NKVH = 2, WIN = 128;
constexpr int NE = 16, DE = 512;
constexpr int NCLS = 24, LCAP = NT;
constexpr int HIDROWS = NT + NCLS * 256;
constexpr float EPS = 1e-6f;

constexpr size_t MiB = 1u << 20;
constexpr size_t WS_CTL = 0, CTL_ZERO_BYTES = 1 * MiB;
constexpr size_t WS_WINAB = 1 * MiB;
constexpr size_t WS_WOUTAB = 8 * MiB;
constexpr size_t WS_WINC = 10 * MiB;
constexpr size_t WS_WOUTC = 13 * MiB;
constexpr size_t WS_WPG = 15 * MiB;
constexpr size_t WS_WPP = 19 * MiB;
constexpr size_t WS_W1 = 20 * MiB;
constexpr size_t WS_W2 = 84 * MiB;
constexpr size_t WS_PB = 116 * MiB;
constexpr size_t WS_XA = 148 * MiB;
constexpr size_t WS_Z = 212 * MiB;
constexpr size_t WS_XA2 = WS_Z;
constexpr size_t WS_HID = WS_Z + 64 * MiB;
constexpr size_t WS_QKV = WS_Z + 64 * MiB;
constexpr size_t WS_PP = 404 * MiB;
constexpr size_t WS_LIST = 468 * MiB;
constexpr size_t WS_WLIST = 471 * MiB;
constexpr size_t WS_SSA = 477 * MiB;
constexpr size_t WS_SSB = 479 * MiB;
constexpr size_t WS_LB = 481 * MiB;
constexpr size_t WS_HL = 484 * MiB;
constexpr size_t WS_HSUM = 500 * MiB;
constexpr size_t WS_END = 501 * MiB;
constexpr int CW_BAR = 4096;
constexpr int CW_CNT = 16384;

constexpr int RING_BYTES = 131072;
constexpr int LX_OFF = RING_BYTES;
constexpr int LX_BAR = LX_OFF + 0;
constexpr int LX_TB = LX_OFF + 64;
constexpr int LX_CNT = LX_OFF + 64 + 128;
constexpr int LX_CLS = LX_OFF + 512;
constexpr int LDS_BYTES = 147456;
constexpr int NWAVES = 8, NTHR = 512;

__device__ __forceinline__ unsigned f2bf(float f) { unsigned u = __builtin_bit_cast(unsigned, f); return (u + 0x7fffu + ((u >> 16) & 1u)) >> 16; }
__device__ __forceinline__ unsigned pk2(float lo, float hi) { return f2bf(lo) | (f2bf(hi) << 16); }
__device__ __forceinline__ float bflo(unsigned w) { return __builtin_bit_cast(float, w << 16); }
__device__ __forceinline__ float bfhi(unsigned w) { return __builtin_bit_cast(float, w & 0xffff0000u); }
__device__ __forceinline__ float bf1(bf16_t h) { return __builtin_bit_cast(float, (unsigned)h << 16); }
__device__ __forceinline__ float sigmoidf_(float x) { return __builtin_amdgcn_rcpf(1.f + __expf(-x)); }
__device__ __forceinline__ float siluf_(float x) { return x * sigmoidf_(x); }
__device__ __forceinline__ float wave_sum(float v) {
#pragma unroll
    for (int o = 1; o < 64; o <<= 1) v += __shfl_xor(v, o);
    return v;
}
__device__ __forceinline__ float wave_max(float v) {
#pragma unroll
    for (int o = 1; o < 64; o <<= 1) v = fmaxf(v, __shfl_xor(v, o));
    return v;
}
#define LDS_WAIT() asm volatile("s_waitcnt lgkmcnt(0)" ::: "memory")

namespace pg8 {
constexpr int BM = 256, BK = 64, HALF = 128, HTB = HALF * BK * 2, NXCD = 8, WGM = 8;
__host__ __device__ __forceinline__ int lds_byte(int r, int c) { const int st = (r >> 4) * 2 + (c >> 5), rr = r & 15, cc = c & 31, ob = rr * 64 + cc * 2; return st * 1024 + (ob ^ (((ob >> 9) & 1) << 5)); }
__host__ __device__ __forceinline__ void stage_rc(int b, int& R, int& C) { const int st = b / 1024, sb = b % 1024, swz = sb ^ (((sb >> 9) & 1) << 5); R = (st >> 1) * 16 + swz / 64; C = (st & 1) * 32 + (swz % 64) / 2; }
__host__ __device__ __forceinline__ int perm32(int rho) { const int n = rho >> 4, i = rho & 15; return 8 * (i >> 2) + 4 * n + (i & 3); }

struct Unit { int pm, pn; const char* pA; const char* pB; const char* pB2; const int* lst; int nv; int aux; };

struct StaticOrder {
    int nM, nN, nwg, G, c;
    __device__ void init(int M, int N, int G_, int c_) { nM = M / BM; nN = N / BM; nwg = nM * nN; G = G_; c = c_; }
    __device__ bool next(int i, int& pm, int& pn) const {
        const long L = (long)i * G + c; if (L >= nwg) return false;
        int wgid = (int)L; { const int q = nwg / NXCD, r = nwg % NXCD, xcd = wgid % NXCD, off = wgid / NXCD; wgid = (xcd < r ? xcd * (q + 1) : r * (q + 1) + (xcd - r) * q) + off; }
        const int nig = WGM * nN, gid = wgid / nig, fm = gid * WGM, gsz = (nM - fm) < WGM ? (nM - fm) : WGM;
        pm = fm + ((wgid % nig) % gsz); pn = (wgid % nig) / gsz; return true;
    }
};
struct DenseSched {
    StaticOrder so; const char* A; const char* B; size_t tA, tB;
    __device__ void init(const void* A_, const void* B_, int M, int N, int lda, int ldb, int G, int c) { so.init(M, N, G, c); A = (const char*)A_; B = (const char*)B_; tA = (size_t)BM * lda * 2; tB = (size_t)BM * ldb * 2; }
    __device__ __forceinline__ bool next(int i, Unit& u) const {
        int pm, pn; if (!so.next(i, pm, pn)) return false;
        u.pm = pm; u.pn = pn; u.pA = A + (size_t)pm * tA; u.pB = B + (size_t)pn * tB; u.pB2 = u.pB; u.lst = nullptr; u.nv = BM; u.aux = 0; return true;
    }
};

typedef __bf16 bf16x2_t __attribute__((ext_vector_type(2)));
__device__ __forceinline__ unsigned cvt_pk_bf16(float lo, float hi) { const f32x2 v = {lo, hi}; const bf16x2_t b = __builtin_convertvector(v, bf16x2_t); return __builtin_bit_cast(unsigned, b); }

template <class Epi, class Sched, bool GATHER, bool SPLITB>
__device__ __forceinline__ void gemm_phase(LAS unsigned char* lds, const int K, const int lda, const int ldb, const Sched& S, const Epi& E) {
    int tid = threadIdx.x; asm volatile("" : "+v"(tid));
    const int wid = __builtin_amdgcn_readfirstlane(tid >> 6), lane = tid & 63, wr = wid >> 2, wc = wid & 3, fr = lane & 15, fq = lane >> 4;
    int nt = K / BK; asm volatile("" : "+s"(nt));
    const int ntB = nt >> 1;
    unsigned voffA[2], voffB[2];
#pragma unroll
    for (int i = 0; i < 2; ++i) { int R, C; stage_rc(tid * 16 + i * 8192, R, C); const int Rb = (R & ~31) + perm32(R & 31); voffA[i] = (unsigned)(R * lda + C) * 2u; voffB[i] = (unsigned)(Rb * ldb + C) * 2u; }
    const size_t kstep = (size_t)(BK * 2);
    const size_t hstepB = (size_t)HALF * ldb * 2;
    const size_t hstepA = (size_t)HALF * lda * 2;
    const unsigned ldsw = (unsigned)wid * 1024u;
    const int aoff = lds_byte(wr * 64 + fr, fq * 8), boff = lds_byte(wc * 32 + fr, fq * 8);
#define PG8_SA(b, h) (((b) * 2 + (h)) * HTB)
#define PG8_SB(b, h) ((4 + (b) * 2 + (h)) * HTB)
#define PG8_STAGE(bufoff, gbase, voff) do { _Pragma("unroll") for (int _i = 0; _i < 2; ++_i) \
        __builtin_amdgcn_global_load_lds((const unsigned*)((const char*)(gbase) + (voff)[_i]), (LAS unsigned*)(lds + (bufoff) + ldsw + _i * 8192), 16, 0, 0); } while (0)
#define PG8_LDA(dst, b, h) do { _Pragma("unroll") for (int m = 0; m < 4; ++m) _Pragma("unroll") for (int k = 0; k < 2; ++k) dst[m][k] = *(const LAS bf16x8*)(lds + PG8_SA(b, h) + aoff + m * 2048 + k * 1024); } while (0)
#define PG8_LDB(dst, b, h) do { _Pragma("unroll") for (int n = 0; n < 2; ++n) _Pragma("unroll") for (int k = 0; k < 2; ++k) dst[n][k] = *(const LAS bf16x8*)(lds + PG8_SB(b, h) + boff + n * 2048 + k * 1024); } while (0)
#define PG8_MMA(ai, bj, At, Bt) do { __builtin_amdgcn_s_setprio(1); _Pragma("unroll") for (int m = 0; m < 4; ++m) _Pragma("unroll") for (int n = 0; n < 2; ++n) _Pragma("unroll") for (int k = 0; k < 2; ++k) \
        acc[ai][bj][m][n] = __builtin_amdgcn_mfma_f32_16x16x32_bf16(Bt[n][k], At[m][k], acc[ai][bj][m][n], 0, 0, 0); __builtin_amdgcn_s_setprio(0); } while (0)
#define PG8_WAIT_V(n) asm volatile("s_waitcnt vmcnt(" #n ")" ::: "memory")
#define PG8_WAIT_L(n) asm volatile("s_waitcnt lgkmcnt(" #n ")" ::: "memory")
#define PG8_BAR __builtin_amdgcn_s_barrier()
#define PG8_SCHED __builtin_amdgcn_sched_barrier(0)
#define PG8_GOFF(G, u) do { if constexpr (GATHER) { _Pragma("unroll") for (int _h = 0; _h < 2; ++_h) _Pragma("unroll") for (int _i = 0; _i < 2; ++_i) { \
        int _R, _C; stage_rc(tid * 16 + _i * 8192, _R, _C); int _ix = _h * HALF + _R; _ix = _ix < (u).nv ? _ix : (u).nv - 1; const int _tok = (u).lst[_ix]; G[_h][_i] = (unsigned)_tok * (unsigned)(lda * 2) + (unsigned)(_C * 2); } } } while (0)
#define PG8_STAGE_A(bufoff, gbase, half, G) do { if constexpr (GATHER) { PG8_STAGE(bufoff, gbase, G[half]); } else { PG8_STAGE(bufoff, (gbase) + (half) * hstepA, voffA); } } while (0)
#define PG8_BPTR(u, tt) ((SPLITB && (tt) >= ntB) ? (u).pB2 + (size_t)((tt) - ntB) * kstep : (u).pB + (size_t)(tt) * kstep)
    Unit cur; int ui = 0;
    if (!S.next(0, cur)) return;
    f32x4 acc[2][2][4][2];
#pragma unroll
    for (int a = 0; a < 2; ++a)
#pragma unroll
        for (int b = 0; b < 2; ++b)
#pragma unroll
            for (int m = 0; m < 4; ++m)
#pragma unroll
                for (int n = 0; n < 2; ++n) acc[a][b][m][n] = (f32x4){0.f, 0.f, 0.f, 0.f};
    bf16x8 At[4][2], B0[2][2], B1[2][2];
    unsigned cG[2][2];
    LAS u32x4* gstash = (LAS u32x4*)(lds + 135168) + tid;
    PG8_GOFF(cG, cur);
    const char* cA = cur.pA; const char* cB = cur.pB;
    PG8_STAGE(PG8_SB(0, 0), cB, voffB); PG8_STAGE(PG8_SB(0, 1), cB + hstepB, voffB); PG8_STAGE_A(PG8_SA(0, 0), cA, 0, cG); PG8_STAGE_A(PG8_SA(0, 1), cA, 1, cG);
    if (wr == 1) PG8_BAR;
    PG8_WAIT_V(2); PG8_BAR;
    PG8_STAGE(PG8_SB(1, 0), cB + kstep, voffB); PG8_STAGE_A(PG8_SA(1, 0), cA + kstep, 0, cG); PG8_STAGE(PG8_SB(1, 1), cB + hstepB + kstep, voffB);
    PG8_WAIT_V(6); PG8_BAR;
    for (;;) {
        Unit nxt; const bool has_next = S.next(ui + 1, nxt);
        if constexpr (GATHER) { unsigned nG[2][2];
            if (has_next) { PG8_GOFF(nG, nxt); } else {
#pragma unroll
            for (int h = 0; h < 2; ++h)
#pragma unroll
                for (int i = 0; i < 2; ++i) nG[h][i] = cG[h][i]; }
            *gstash = (u32x4){nG[0][0], nG[0][1], nG[1][0], nG[1][1]}; }
        const char* nA = has_next ? nxt.pA : cA; const char* nB = has_next ? nxt.pB : cB;
        for (int t = 0; t < nt; t += 2) {
            const bool last = (t == nt - 2);
            const char* a1 = cA + (size_t)(t + 1) * kstep;
            const char* a2 = last ? nA : cA + (size_t)(t + 2) * kstep; const char* a3 = a2 + kstep;
            const char* b2 = last ? nB : PG8_BPTR(cur, t + 2); const char* b3 = b2 + kstep;
            unsigned g2[2][2];
            if constexpr (GATHER) {
                if (last) { const u32x4 st = *gstash; g2[0][0] = st.x; g2[0][1] = st.y; g2[1][0] = st.z; g2[1][1] = st.w; }
                else {
#pragma unroll
                for (int h = 0; h < 2; ++h)
#pragma unroll
                    for (int i = 0; i < 2; ++i) g2[h][i] = cG[h][i]; } }
            PG8_LDB(B0, 0, 0); PG8_LDB(B1, 0, 1); PG8_SCHED; PG8_LDA(At, 0, 0); PG8_STAGE_A(PG8_SA(1, 1), a1, 1, cG);
            PG8_WAIT_V(8); PG8_WAIT_L(0); PG8_BAR; PG8_MMA(0, 0, At, B0); PG8_MMA(0, 1, At, B1); PG8_BAR; PG8_SCHED;
            PG8_LDA(At, 0, 1); PG8_STAGE(PG8_SB(0, 0), b2, voffB); PG8_STAGE(PG8_SB(0, 1), b2 + hstepB, voffB); PG8_STAGE_A(PG8_SA(0, 0), a2, 0, g2);
            PG8_WAIT_V(8); PG8_WAIT_L(0); PG8_BAR; PG8_MMA(1, 0, At, B0); PG8_MMA(1, 1, At, B1); PG8_BAR; PG8_SCHED;
            PG8_LDB(B0, 1, 0); PG8_LDB(B1, 1, 1); PG8_SCHED; PG8_LDA(At, 1, 0); PG8_STAGE_A(PG8_SA(0, 1), a2, 1, g2);
            PG8_WAIT_V(8); PG8_WAIT_L(0); PG8_BAR; PG8_MMA(0, 0, At, B0); PG8_MMA(0, 1, At, B1); PG8_BAR; PG8_SCHED;
            PG8_LDA(At, 1, 1); PG8_STAGE(PG8_SB(1, 0), b3, voffB); PG8_STAGE(PG8_SB(1, 1), b3 + hstepB, voffB); PG8_STAGE_A(PG8_SA(1, 0), a3, 0, g2);
            PG8_WAIT_V(8); PG8_WAIT_L(0); PG8_BAR; PG8_MMA(1, 0, At, B0); PG8_MMA(1, 1, At, B1); PG8_BAR; PG8_SCHED;
        }
        if (wr == 0) PG8_BAR;
        E(acc, cur, wr, wc, fr, fq);
        if (!has_next) break;
#pragma unroll
        for (int a = 0; a < 2; ++a)
#pragma unroll
            for (int b = 0; b < 2; ++b)
#pragma unroll
                for (int m = 0; m < 4; ++m)
#pragma unroll
                    for (int n = 0; n < 2; ++n) acc[a][b][m][n] = (f32x4){0.f, 0.f, 0.f, 0.f};
        ++ui; (void)S.next(ui, cur); cA = nA; cB = nB;
        if constexpr (GATHER) { const u32x4 st = *gstash; cG[0][0] = st.x; cG[0][1] = st.y; cG[1][0] = st.z; cG[1][1] = st.w; }
        if (wr == 1) PG8_BAR;
    }
    PG8_WAIT_V(0);
    PG8_BAR;
#undef PG8_SA
#undef PG8_SB
#undef PG8_STAGE
#undef PG8_LDA
#undef PG8_LDB
#undef PG8_MMA
#undef PG8_WAIT_V
#undef PG8_WAIT_L
#undef PG8_BAR
#undef PG8_SCHED
#undef PG8_GOFF
#undef PG8_STAGE_A
#undef PG8_BPTR
}

typedef const f32x4 (&AccRef)[2][2][4][2];
#define EPI_ROW(u, ai, m) ((u).pm * BM + (ai) * HALF + wr * 64 + (m) * 16 + fr)
#define EPI_COL(u, bj) ((u).pn * BM + (bj) * HALF + wc * 32 + fq * 8)
__device__ __forceinline__ u32x4 pack8(const f32x4& a, const f32x4& b) { u32x4 w; w.x = cvt_pk_bf16(a[0], a[1]); w.y = cvt_pk_bf16(a[2], a[3]); w.z = cvt_pk_bf16(b[0], b[1]); w.w = cvt_pk_bf16(b[2], b[3]); return w; }
__device__ __forceinline__ float sq8(const f32x4& a, const f32x4& b) { return (a[0] * a[0] + a[1] * a[1]) + (a[2] * a[2] + a[3] * a[3]) + (b[0] * b[0] + b[1] * b[1]) + (b[2] * b[2] + b[3] * b[3]); }
__device__ __forceinline__ void unpack8(const u32x4& w, f32x4& a, f32x4& b) { a = (f32x4){bflo(w.x), bfhi(w.x), bflo(w.y), bfhi(w.y)}; b = (f32x4){bflo(w.z), bfhi(w.z), bflo(w.w), bfhi(w.w)}; }

struct EpiBf16 {
    bf16_t* O; int ldc;
    __device__ __forceinline__ void operator()(AccRef acc, const Unit& u, int wr, int wc, int fr, int fq) const {
#pragma unroll
        for (int ai = 0; ai < 2; ++ai)
#pragma unroll
            for (int m = 0; m < 4; ++m) { bf16_t* rowp = O + (size_t)EPI_ROW(u, ai, m) * ldc;
#pragma unroll
                for (int bj = 0; bj < 2; ++bj) *(u32x4*)(rowp + EPI_COL(u, bj)) = pack8(acc[ai][bj][m][0], acc[ai][bj][m][1]); }
    }
};
struct EpiInAb {
    bf16_t* Z;
    __device__ __forceinline__ void operator()(AccRef acc, const Unit& u, int wr, int wc, int fr, int fq) const {
        if (u.pn >= 10) {
#pragma unroll
            for (int ai = 0; ai < 2; ++ai)
#pragma unroll
                for (int m = 0; m < 4; ++m) { bf16_t* rowp = Z + (size_t)EPI_ROW(u, ai, m) * ZW;
                    const f32x4 a = acc[ai][0][m][0] * acc[ai][1][m][0], b = acc[ai][0][m][1] * acc[ai][1][m][1];
                    *(u32x4*)(rowp + 2560 + (u.pn - 10) * HALF + wc * 32 + fq * 8) = pack8(a, b); }
        } else if (u.pn < 2) {
#pragma unroll
            for (int ai = 0; ai < 2; ++ai)
#pragma unroll
                for (int m = 0; m < 4; ++m) { bf16_t* rowp = Z + (size_t)EPI_ROW(u, ai, m) * ZW;
#pragma unroll
                    for (int bj = 0; bj < 2; ++bj) { f32x4 a = acc[ai][bj][m][0], b = acc[ai][bj][m][1];
#pragma unroll
                        for (int j = 0; j < 4; ++j) { a[j] = siluf_(a[j]); b[j] = siluf_(b[j]); }
                        *(u32x4*)(rowp + EPI_COL(u, bj)) = pack8(a, b); }
                    asm volatile("" ::: "memory"); }
        } else {
#pragma unroll
            for (int ai = 0; ai < 2; ++ai)
#pragma unroll
                for (int m = 0; m < 4; ++m) { bf16_t* rowp = Z + (size_t)EPI_ROW(u, ai, m) * ZW;
#pragma unroll
                    for (int bj = 0; bj < 2; ++bj) *(u32x4*)(rowp + EPI_COL(u, bj)) = pack8(acc[ai][bj][m][0], acc[ai][bj][m][1]); }
        }
    }
};
struct EpiRes {
    const float* X; float* O; const float* bias;
    __device__ __forceinline__ void operator()(AccRef acc, const Unit& u, int wr, int wc, int fr, int fq) const {
#pragma unroll
        for (int ai = 0; ai < 2; ++ai)
#pragma unroll
            for (int m = 0; m < 4; ++m) { const size_t ro = (size_t)EPI_ROW(u, ai, m) * D;
#pragma unroll
                for (int bj = 0; bj < 2; ++bj) { const int c = EPI_COL(u, bj);
                    f32x4 x0 = *(const f32x4*)(X + ro + c), x1 = *(const f32x4*)(X + ro + c + 4);
                    if (bias) { x0 += *(const f32x4*)(bias + c); x1 += *(const f32x4*)(bias + c + 4); }
                    *(f32x4*)(O + ro + c) = x0 + acc[ai][bj][m][0]; *(f32x4*)(O + ro + c + 4) = x1 + acc[ai][bj][m][1]; }
                asm volatile("" ::: "memory"); }
    }
};
__device__ __forceinline__ float rstd16(const float* ss, int row) {
    const f32x4* p = (const f32x4*)(ss + (size_t)row * 16); const f32x4 a = p[0], b = p[1], c = p[2], d = p[3];
    const float s = ((a[0] + a[1]) + (a[2] + a[3])) + ((b[0] + b[1]) + (b[2] + b[3])) + ((c[0] + c[1]) + (c[2] + c[3])) + ((d[0] + d[1]) + (d[2] + d[3]));
    return __builtin_amdgcn_rsqf(s * (1.f / D) + EPS);
}
struct EpiQkv {
    bf16_t* O; const float* bias; const float* ss;
    __device__ __forceinline__ void operator()(AccRef acc, const Unit& u, int wr, int wc, int fr, int fq) const {
#pragma unroll
        for (int ai = 0; ai < 2; ++ai)
#pragma unroll
            for (int m = 0; m < 4; ++m) { const int row = EPI_ROW(u, ai, m); const float rs = rstd16(ss, row); bf16_t* rowp = O + (size_t)row * CIN;
#pragma unroll
                for (int bj = 0; bj < 2; ++bj) { const int c = EPI_COL(u, bj);
                    const f32x4 a = acc[ai][bj][m][0] * rs + *(const f32x4*)(bias + c), b = acc[ai][bj][m][1] * rs + *(const f32x4*)(bias + c + 4);
                    *(u32x4*)(rowp + c) = pack8(a, b); }
                asm volatile("" ::: "memory"); }
    }
};
struct EpiG1 {
    bf16_t* HID; const f32x2* wl;
    __device__ __forceinline__ void operator()(AccRef acc, const Unit& u, int wr, int wc, int fr, int fq) const {
#pragma unroll
        for (int ai = 0; ai < 2; ++ai)
#pragma unroll
            for (int m = 0; m < 4; ++m) { const int rit = ai * HALF + wr * 64 + m * 16 + fr;
                const f32x2 w2 = wl[(size_t)u.aux + rit]; const float w = (u.pn < 4) ? w2.x : w2.y;
                bf16_t* rowp = HID + (size_t)(u.pm * BM + rit) * 1024 + (u.pn >> 2) * 512 + (u.pn & 3) * HALF + wc * 32 + fq * 8;
                f32x4 a, b;
#pragma unroll
                for (int j = 0; j < 4; ++j) { a[j] = siluf_(acc[ai][0][m][0][j]) * acc[ai][1][m][0][j] * w; b[j] = siluf_(acc[ai][0][m][1][j]) * acc[ai][1][m][1][j] * w; }
                *(u32x4*)rowp = pack8(a, b);
                asm volatile("" ::: "memory"); }
    }
};
struct EpiG2 {
    float* H; bf16_t* HB; float* SS;
    __device__ __forceinline__ void operator()(AccRef acc, const Unit& u, int wr, int wc, int fr, int fq) const {
#pragma unroll
        for (int ai = 0; ai < 2; ++ai)
#pragma unroll
            for (int m = 0; m < 4; ++m) { const int rit = ai * HALF + wr * 64 + m * 16 + fr; const bool ok = rit < u.nv;
                const int tok = u.lst[ok ? rit : 0]; float part = 0.f;
                if (ok) { const size_t ro = (size_t)tok * D;
#pragma unroll
                    for (int bj = 0; bj < 2; ++bj) { const int c = EPI_COL(u, bj);
                        const f32x4 h0 = *(const f32x4*)(H + ro + c) + acc[ai][bj][m][0], h1 = *(const f32x4*)(H + ro + c + 4) + acc[ai][bj][m][1];
                        *(f32x4*)(H + ro + c) = h0; *(f32x4*)(H + ro + c + 4) = h1; *(u32x4*)(HB + ro + c) = pack8(h0, h1); part += sq8(h0, h1); } }
                part += __shfl_xor(part, 16); part += __shfl_xor(part, 32);
                if (ok && fq == 0) SS[(size_t)tok * 16 + u.pn * 4 + wc] = part;
                asm volatile("" ::: "memory"); }
    }
};
struct EpiPle {
    float* H; bf16_t* HB; const bf16_t* PP; const float* ssi; float* sso;
    __device__ __forceinline__ void operator()(AccRef acc, const Unit& u, int wr, int wc, int fr, int fq) const {
#pragma unroll
        for (int ai = 0; ai < 2; ++ai)
#pragma unroll
            for (int m = 0; m < 4; ++m) { const int row = EPI_ROW(u, ai, m); const float rs = rstd16(ssi, row); const size_t ro = (size_t)row * D; float part = 0.f;
#pragma unroll
                for (int bj = 0; bj < 2; ++bj) { const int c = EPI_COL(u, bj);
                    f32x4 p0, p1; unpack8(*(const u32x4*)(PP + ro + c), p0, p1);
                    f32x4 h0 = *(const f32x4*)(H + ro + c), h1 = *(const f32x4*)(H + ro + c + 4);
#pragma unroll
                    for (int j = 0; j < 4; ++j) { h0[j] += sigmoidf_(acc[ai][bj][m][0][j] * rs) * p0[j]; h1[j] += sigmoidf_(acc[ai][bj][m][1][j] * rs) * p1[j]; }
                    *(f32x4*)(H + ro + c) = h0; *(f32x4*)(H + ro + c + 4) = h1; *(u32x4*)(HB + ro + c) = pack8(h0, h1); part += sq8(h0, h1); }
                part += __shfl_xor(part, 16); part += __shfl_xor(part, 32);
                if (fq == 0) sso[(size_t)row * 16 + u.pn * 4 + wc] = part;
                asm volatile("" ::: "memory"); }
    }
};
}

#define XB_TMO      128
#define XB_XCNT(j)  (256  + 64 * (j))
#define XB_XSUB(j)  (1280 + 64 * (j))
#define XB_XGEN(j)  (2304 + 64 * (j))
#define XB_TOP      3328
#define XB_TOPGEN   3392
#define XCD_BAR_WORDS 3456
#define XB_SPIN_CAP (1u << 18)
__device__ __forceinline__ unsigned xb_ld(unsigned* p)              { return __hip_atomic_load(p, __ATOMIC_RELAXED, __HIP_MEMORY_SCOPE_AGENT); }
__device__ __forceinline__ unsigned xb_add(unsigned* p, unsigned v) { return __hip_atomic_fetch_add(p, v, __ATOMIC_RELAXED, __HIP_MEMORY_SCOPE_AGENT); }
__device__ __forceinline__ unsigned xb_xcc_id() { return (unsigned)__builtin_amdgcn_s_getreg((3 << 11) | 20) & 0xFu; }
#define XB_SPIN(cond, bar) do { unsigned _sp = 0; while (cond) { __builtin_amdgcn_s_sleep(1); \
    if ((++_sp & 255u) == 0u) { if (xb_ld(&(bar)[XB_TMO])) break; if (_sp > XB_SPIN_CAP) { atomicAdd(&(bar)[XB_TMO], 1u); break; } } } } while (0)
struct XcdBarrier { unsigned* bar; unsigned x; volatile LAS unsigned* st; };
__device__ __forceinline__ XcdBarrier xcd_barrier_post(unsigned* bar, volatile LAS unsigned* st) {
    XcdBarrier b; b.bar = bar; b.x = xb_xcc_id(); b.st = st;
    if (threadIdx.x == 0) (void)xb_add(&bar[XB_XCNT(b.x)], 1u);
    return b;
}
__device__ __forceinline__ void xcd_barrier_complete(unsigned* bar, unsigned x, unsigned& nloc, unsigned& nx) {
    const unsigned G = gridDim.x * gridDim.y * gridDim.z;
    unsigned sum, cnt, mine, sp = 0u;
    for (;;) {
        sum = 0u; cnt = 0u; mine = 0u;
#pragma unroll
        for (unsigned j = 0; j < 16; ++j) { const unsigned c = xb_ld(&bar[XB_XCNT(j)]); sum += c; cnt += (c > 0u) ? 1u : 0u; mine = (j == x) ? c : mine; }
        if (sum == G) break;
        __builtin_amdgcn_s_sleep(1);
        if ((++sp & 255u) == 0u) { if (xb_ld(&bar[XB_TMO])) break; if (sp > XB_SPIN_CAP) { atomicAdd(&bar[XB_TMO], 1u); break; } }
    }
    nloc = mine > 0u ? mine : 1u; nx = cnt > 0u ? cnt : 1u;
}
__device__ __forceinline__ void xcd_barrier(const XcdBarrier& b) {
    asm volatile("s_waitcnt vmcnt(0)" ::: "memory");
    __syncthreads();
    if (threadIdx.x == 0) {
        unsigned* bar = b.bar;
        __builtin_amdgcn_s_waitcnt(0);
        unsigned nloc = b.st[0], nx = b.st[1];
        if (nloc == 0u) { xcd_barrier_complete(bar, b.x, nloc, nx); b.st[0] = nloc; b.st[1] = nx; }
        const unsigned old = xb_add(&bar[XB_XSUB(b.x)], 1u);
        const unsigned gen = old / nloc;
        if (old + 1u == (gen + 1u) * nloc) {
            __builtin_amdgcn_fence(__ATOMIC_RELEASE, "agent");
            asm volatile("s_waitcnt vmcnt(0)" ::: "memory");
            const unsigned og = xb_add(&bar[XB_TOP], 1u);
            const unsigned tg = og / nx;
            if (og + 1u == (tg + 1u) * nx) xb_add(&bar[XB_TOPGEN], 1u);
            else XB_SPIN(xb_ld(&bar[XB_TOPGEN]) == tg, bar);
            __builtin_amdgcn_fence(__ATOMIC_ACQUIRE, "agent");
            xb_add(&bar[XB_XGEN(b.x)], 1u);
            asm volatile("s_waitcnt vmcnt(0)" ::: "memory");
        } else {
            XB_SPIN(xb_ld(&bar[XB_XGEN(b.x)]) == gen, bar);
            __builtin_amdgcn_fence(__ATOMIC_ACQUIRE, "agent");
            asm volatile("s_waitcnt vmcnt(0)" ::: "memory");
        }
    }
    __syncthreads();
}

struct Args {
    const float* x; const float* p; const float* norm_mix; const float* norm_ffn; const float* norm_ple; const float* norm_final;
    const float* w_in_ab; const float* lb_logits; const float* hgrn_out_norm; const float* conv_w; const float* w_out_ab;
    const float* w_in_c; const float* b_in_c; const float* sinks; const float* w_out_c; const float* b_out_c;
    const float* w_router; const float* w_gate_e; const float* w_up_e; const float* w_down_e; const float* w_ple_gate; const float* w_ple_proj;
    float* out; unsigned char* ws; int ph_lo, ph_hi;
};
struct Frame { LAS unsigned char* lds; int tid, lane, wave, vcu, G; };

__device__ __forceinline__ void transpose_item(const float* W, int N, int src_n0, int k0, bf16_t* dst  , int ldk, const float* gs, LAS float* scr, int lane) {
#pragma unroll 8
    for (int i = 0; i < 32; ++i) { const int kk = 2 * i + (lane >> 5); scr[kk * 33 + (lane & 31)] = W[(size_t)(k0 + kk) * N + src_n0 + (lane & 31)]; }
    LDS_WAIT(); asm volatile("" ::: "memory");
    const int c = lane & 7;
    float g8[8];
#pragma unroll
    for (int q = 0; q < 8; ++q) g8[q] = gs ? gs[k0 + 8 * c + q] : 1.f;
#pragma unroll
    for (int j = 0; j < 4; ++j) { const int n = (lane >> 3) + 8 * j; const LAS float* s = scr + (8 * c) * 33 + n;
        u32x4 o; o.x = pk2(s[0 * 33] * g8[0], s[1 * 33] * g8[1]); o.y = pk2(s[2 * 33] * g8[2], s[3 * 33] * g8[3]); o.z = pk2(s[4 * 33] * g8[4], s[5 * 33] * g8[5]); o.w = pk2(s[6 * 33] * g8[6], s[7 * 33] * g8[7]);
        *(u32x4*)(dst + (size_t)n * ldk + k0 + 8 * c) = o; }
    LDS_WAIT(); asm volatile("" ::: "memory");
}
__device__ __forceinline__ void phase_prep(const Frame& F, const Args& a) {
    unsigned char* ws = a.ws;
    LAS float* scr = (LAS float*)(F.lds + F.wave * 16384);
    const int gw = F.vcu * NWAVES + F.wave, NGW = F.G * NWAVES;
    constexpr int I_INAB = 16 * (ABIN / 32), I_SQ = 16 * 32, I_INC = 16 * (CIN / 32), I_PP = 4 * 32, I_W1 = 16 * 32, I_W2 = 8 * 32;
    constexpr int T0 = I_INAB, T1 = T0 + I_SQ, T2 = T1 + I_INC, T3 = T2 + I_SQ, T4 = T3 + 2 * I_SQ, T5 = T4 + 2 * I_PP, T6 = T5 + 32 * I_W1, T7 = T6 + 32 * I_W2;
    for (int it = gw; it < T7; it += NGW) {
        if (it < T0) { const int kb = it / (ABIN / 32), nb = it % (ABIN / 32), n0 = nb * 32; int src;
            if (n0 < 2560) src = n0; else { const int q = (n0 - 2560) >> 8, r = (n0 - 2560) & 255; src = (r < 128) ? 2560 + q * 128 + r : 3072 + q * 128 + (r - 128); }
            transpose_item(a.w_in_ab, ABIN, src, kb * 64, (bf16_t*)(ws + WS_WINAB) + (size_t)n0 * D, D, a.norm_mix, scr, F.lane); }
        else if (it < T1) { const int r = it - T0, kb = r / 32, nb = r % 32; transpose_item(a.w_out_ab, D, nb * 32, kb * 64, (bf16_t*)(ws + WS_WOUTAB) + (size_t)nb * 32 * D, D, nullptr, scr, F.lane); }
        else if (it < T2) { const int r = it - T1, kb = r / (CIN / 32), nb = r % (CIN / 32); transpose_item(a.w_in_c, CIN, nb * 32, kb * 64, (bf16_t*)(ws + WS_WINC) + (size_t)nb * 32 * D, D, a.norm_mix + D, scr, F.lane); }
        else if (it < T3) { const int r = it - T2, kb = r / 32, nb = r % 32; transpose_item(a.w_out_c, D, nb * 32, kb * 64, (bf16_t*)(ws + WS_WOUTC) + (size_t)nb * 32 * D, D, nullptr, scr, F.lane); }
        else if (it < T4) { const int r = it - T3, l = r / I_SQ, q = r % I_SQ, kb = q / 32, nb = q % 32;
            transpose_item(a.w_ple_gate + (size_t)l * D * D, D, nb * 32, kb * 64, (bf16_t*)(ws + WS_WPG) + (size_t)l * D * D + (size_t)nb * 32 * D, D, a.norm_ple + l * D, scr, F.lane); }
        else if (it < T5) { const int r = it - T4, l = r / I_PP, q = r % I_PP, kb = q / 32, nb = q % 32;
            transpose_item(a.w_ple_proj + (size_t)l * PLE * D, D, nb * 32, kb * 64, (bf16_t*)(ws + WS_WPP) + (size_t)l * D * PLE + (size_t)nb * 32 * PLE, PLE, nullptr, scr, F.lane); }
        else if (it < T6) { const int r = it - T5, le = r / I_W1, q = r % I_W1, kb = q / 32, nb = q % 32, n0 = nb * 32, uq = n0 >> 8, rr = n0 & 255;
            const float* src = (rr < 128) ? a.w_gate_e + (size_t)le * D * DE : a.w_up_e + (size_t)le * D * DE; const int sn = uq * 128 + (rr & 127);
            transpose_item(src, DE, sn, kb * 64, (bf16_t*)(ws + WS_W1) + (size_t)le * D * D + (size_t)n0 * D, D, nullptr, scr, F.lane); }
        else { const int r = it - T6, le = r / I_W2, q = r % I_W2, kb = q / 32, nb = q % 32;
            transpose_item(a.w_down_e + (size_t)le * DE * D, D, nb * 32, kb * 64, (bf16_t*)(ws + WS_W2) + (size_t)le * D * DE + (size_t)nb * 32 * DE, DE, nullptr, scr, F.lane); }
    }
    const int gt = F.vcu * NTHR + F.tid, NGT = F.G * NTHR;
    if (gt < AW) { const float l0 = a.lb_logits[gt], l1 = a.lb_logits[AW + gt], l2 = a.lb_logits[2 * AW + gt]; const float mx = fmaxf(l0, fmaxf(l1, l2));
        const float e0 = __expf(l0 - mx), e1 = __expf(l1 - mx), e2 = __expf(l2 - mx); ((float*)(ws + WS_LB))[gt] = e0 / (e0 + e1 + e2); }
    { const f32x4* src = (const f32x4*)a.p; u32x4* dst = (u32x4*)(ws + WS_PB); const int n8 = 2 * NT * PLE / 8;
        for (int i = gt; i < n8; i += NGT) { const f32x4 v0 = src[2 * i], v1 = src[2 * i + 1]; u32x4 o; o.x = pk2(v0[0], v0[1]); o.y = pk2(v0[2], v0[3]); o.z = pk2(v1[0], v1[1]); o.w = pk2(v1[2], v1[3]); dst[i] = o; } }
    for (int m = gw; m < NT; m += NGW) { const f32x4* xr = (const f32x4*)(a.x + (size_t)m * D) + F.lane; f32x4 v[4]; float s = 0.f;
#pragma unroll
        for (int j = 0; j < 4; ++j) { v[j] = xr[64 * j]; s += (v[j][0] * v[j][0] + v[j][1] * v[j][1]) + (v[j][2] * v[j][2] + v[j][3] * v[j][3]); }
        const float rs = __builtin_amdgcn_rsqf(wave_sum(s) * (1.f / D) + EPS);
        u32x2* o8 = (u32x2*)((bf16_t*)(ws + WS_XA) + (size_t)m * D) + F.lane;
#pragma unroll
        for (int j = 0; j < 4; ++j) { u32x2 o; o.x = pk2(v[j][0] * rs, v[j][1] * rs); o.y = pk2(v[j][2] * rs, v[j][3] * rs); o8[64 * j] = o; } }
}

__device__ __forceinline__ void phase_hgrn_conv(const Frame& F, const Args& a) {
    unsigned char* ws = a.ws; const bf16_t* Z = (const bf16_t*)(ws + WS_Z); bf16_t* XA = (bf16_t*)(ws + WS_XA); const float* lbv = (const float*)(ws + WS_LB);
    LAS float* FG = (LAS float*)F.lds; LAS float* KK = FG + 4096; LAS float* QQ = KK + 4096; LAS float* VV = QQ + 4096; LAS float* OB = VV + 4096;
    const int tid = F.tid, lane = F.lane, w = F.wave;
    for (int it = F.vcu; it < NB * AH; it += F.G) {
        const int b = it >> 2, h = it & 3; const size_t row0 = (size_t)b * SEQ;
        const int vi = lane & 15, dq = lane >> 4, v = 16 * w + vi;
        float s[32];
#pragma unroll
        for (int i = 0; i < 32; ++i) s[i] = 0.f;
        const int ltt = tid >> 4, ldd = (tid & 15) * 8;
        float lb8[8], gn8[8];
#pragma unroll
        for (int j = 0; j < 8; ++j) { lb8[j] = lbv[h * ADK + ldd + j]; gn8[j] = a.hgrn_out_norm[ldd + j]; }
        for (int c = 0; c < SEQ / 32; ++c) {
            { const bf16_t* zr = Z + (row0 + c * 32 + ltt) * ZW + h * ADK + ldd;
                const u32x4 wq = *(const u32x4*)zr, wf = *(const u32x4*)(zr + 512), wv = *(const u32x4*)(zr + 1024);
                f32x4 q0, q1, f0, f1, v0, v1; pg8::unpack8(wq, q0, q1); pg8::unpack8(wf, f0, f1); pg8::unpack8(wv, v0, v1);
                f32x4 g0, g1, k0, k1;
#pragma unroll
                for (int j = 0; j < 4; ++j) { g0[j] = lb8[j] + (1.f - lb8[j]) * sigmoidf_(f0[j]); g1[j] = lb8[4 + j] + (1.f - lb8[4 + j]) * sigmoidf_(f1[j]); k0[j] = 1.f - g0[j]; k1[j] = 1.f - g1[j]; }
                const int o = ltt * 128 + ldd;
                *(LAS f32x4*)(FG + o) = g0; *(LAS f32x4*)(FG + o + 4) = g1; *(LAS f32x4*)(KK + o) = k0; *(LAS f32x4*)(KK + o + 4) = k1;
                *(LAS f32x4*)(QQ + o) = q0; *(LAS f32x4*)(QQ + o + 4) = q1; *(LAS f32x4*)(VV + o) = v0; *(LAS f32x4*)(VV + o + 4) = v1; }
            __syncthreads();
            for (int tt = 0; tt < 32; ++tt) {
                const float vt = VV[tt * 128 + v]; float acc = 0.f;
                const LAS f32x4* fg = (const LAS f32x4*)(FG + tt * 128 + dq * 32); const LAS f32x4* kk = (const LAS f32x4*)(KK + tt * 128 + dq * 32); const LAS f32x4* qq = (const LAS f32x4*)(QQ + tt * 128 + dq * 32);
#pragma unroll
                for (int d4 = 0; d4 < 8; ++d4) { const f32x4 f4 = fg[d4], k4 = kk[d4], q4 = qq[d4];
#pragma unroll
                    for (int j = 0; j < 4; ++j) { s[d4 * 4 + j] = f4[j] * s[d4 * 4 + j] + k4[j] * vt; acc += s[d4 * 4 + j] * q4[j]; } }
                acc += __shfl_xor(acc, 16); acc += __shfl_xor(acc, 32);
                if (dq == 0) OB[tt * 128 + v] = acc;
            }
            __syncthreads();
            { const f32x4 o0 = *(const LAS f32x4*)(OB + ltt * 128 + ldd), o1 = *(const LAS f32x4*)(OB + ltt * 128 + ldd + 4);
                float ss = pg8::sq8(o0, o1); ss += __shfl_xor(ss, 1); ss += __shfl_xor(ss, 2); ss += __shfl_xor(ss, 4); ss += __shfl_xor(ss, 8);
                const float rs = __builtin_amdgcn_rsqf(ss * (1.f / 128.f) + EPS);
                const size_t row = row0 + c * 32 + ltt; f32x4 g0, g1; pg8::unpack8(*(const u32x4*)(Z + row * ZW + 1536 + h * ADK + ldd), g0, g1);
                f32x4 r0, r1;
#pragma unroll
                for (int j = 0; j < 4; ++j) { r0[j] = o0[j] * rs * gn8[j] * sigmoidf_(g0[j]); r1[j] = o1[j] * rs * gn8[4 + j] * sigmoidf_(g1[j]); }
                u32x4 o; o.x = pk2(r0[0], r0[1]); o.y = pk2(r0[2], r0[3]); o.z = pk2(r1[0], r1[1]); o.w = pk2(r1[2], r1[3]);
                *(u32x4*)(XA + row * D + h * ADK + ldd) = o; }
        }
        __syncthreads();
    }
}

typedef short s16x4 __attribute__((ext_vector_type(4)));
constexpr int SEGT = 512, NSEG = SEQ / SEGT, NCH = SEGT / 32;
constexpr int HROW = 272, HL_TS = 32 * HROW;
constexpr int HL_LF = 0, HL_T = 16384, HL_DEC = 18432, HL_SUM = 18944, HL_QD = 20480, HL_KI = HL_QD + HL_TS, HL_KT = HL_KI + HL_TS, HL_VV = HL_KT + HL_TS, HL_OB = HL_VV + HL_TS;
__device__ __forceinline__ s16x4 lds_tr(const LAS unsigned char* p) { return __builtin_bit_cast(s16x4, __builtin_amdgcn_ds_read_tr16_b64_v4i16((LAS s16x4*)p)); }
__device__ __forceinline__ bf16x8 cat44(s16x4 a, s16x4 b) { return (bf16x8){a[0], a[1], a[2], a[3], b[0], b[1], b[2], b[3]}; }
__device__ __forceinline__ bf16x8 pk8(const f32x4& a, const f32x4& b) { return __builtin_bit_cast(bf16x8, pg8::pack8(a, b)); }
#define MFMA16(A, B, C) __builtin_amdgcn_mfma_f32_16x16x32_bf16(A, B, C, 0, 0, 0)
#ifndef HGRN_SELF
#define HGRN_SELF 0
#endif
#ifndef HGRN_CHECK
#define HGRN_CHECK 0
#endif
template <bool FULL>
__device__ __forceinline__ void hgrn_pass(const Frame& F, const Args& a) {
    unsigned char* ws = a.ws; const bf16_t* Z = (const bf16_t*)(ws + WS_Z); bf16_t* XA = (bf16_t*)(ws + WS_XA); const float* lbv = (const float*)(ws + WS_LB);
    float* HLg = (float*)(ws + WS_HL); float* HSg = (float*)(ws + WS_HSUM);
    LAS unsigned char* L = F.lds;
    LAS float* LF = (LAS float*)(L + HL_LF); LAS float* TT = (LAS float*)(L + HL_T); LAS float* DEC = (LAS float*)(L + HL_DEC); LAS float* SUM = (LAS float*)(L + HL_SUM); LAS float* OB = (LAS float*)(L + HL_OB);
    const LAS unsigned char* QD = L + HL_QD; const LAS unsigned char* KI = L + HL_KI; const LAS unsigned char* KT = L + HL_KT; const LAS unsigned char* VV = L + HL_VV;
    const int tid = F.tid, lane = F.lane, w = F.wave, r15 = lane & 15, g = lane >> 4, trq = r15 >> 2, trp = r15 & 3;
    const int tok = tid >> 4, d0 = (tid & 15) * 8, sd = tid & 127, tq = tid >> 7, Vw0 = 16 * w;
    for (int it = F.vcu; it < NB * AH * NSEG; it += F.G) {
        const int seg = it & (NSEG - 1), h = (it >> 3) & 3, b = it >> 5;
        if (!FULL && seg == NSEG - 1) continue;
        const size_t row0 = (size_t)b * SEQ + (size_t)seg * SEGT;
        float lb8[8], gn8[8];
#pragma unroll
        for (int e = 0; e < 8; ++e) { lb8[e] = lbv[h * ADK + d0 + e]; gn8[e] = a.hgrn_out_norm[d0 + e]; }
        f32x4 S[8];
#pragma unroll
        for (int mt = 0; mt < 8; ++mt) S[mt] = (f32x4){0.f, 0.f, 0.f, 0.f};
        const int pre = (FULL && (HGRN_SELF || HGRN_CHECK)) ? seg * NCH : 0;
        float chkbad = 0.f;
        if (FULL && seg > 0 && !HGRN_SELF) {
            const __amdgpu_buffer_rsrc_t rsL = __builtin_amdgcn_make_buffer_rsrc((void*)HLg, (short)0, 256 * 16384 * 4, 0x00020000);
            const __amdgpu_buffer_rsrc_t rsS = __builtin_amdgcn_make_buffer_rsrc((void*)HSg, (short)0, 256 * 128 * 4, 0x00020000);
            f32x4 cum[8];
#pragma unroll
            for (int mt = 0; mt < 8; ++mt) cum[mt] = (f32x4){0.f, 0.f, 0.f, 0.f};
            for (int sp = seg - 1; sp >= 0; --sp) { const int ip = it - seg + sp; const int lo = (ip * 16384 + (Vw0 + r15) * 128 + 4 * g) * 4, so = (ip * 128 + 4 * g) * 4;
#pragma unroll
                for (int mt = 0; mt < 8; ++mt) { const f32x4 l4 = __builtin_bit_cast(f32x4, __builtin_amdgcn_raw_buffer_load_b128(rsL, lo + mt * 64, 0, 16)), h4 = __builtin_bit_cast(f32x4, __builtin_amdgcn_raw_buffer_load_b128(rsS, so + mt * 64, 0, 16));
#pragma unroll
                    for (int r = 0; r < 4; ++r) { S[mt][r] += __expf(cum[mt][r]) * l4[r]; cum[mt][r] += h4[r]; } } }
        }
        if (FULL && HGRN_CHECK) { LAS f32x4* SA = (LAS f32x4*)(L + 73728) + tid * 4;
#pragma unroll
            for (int mt = 0; mt < 4; ++mt) { SA[mt] = S[mt]; }
#pragma unroll
            for (int mt = 0; mt < 8; ++mt) S[mt] = (f32x4){0.f, 0.f, 0.f, 0.f}; }
        if (tid < 128) SUM[tid] = 0.f;
        const bf16_t* zr = Z + (row0 - (size_t)pre * 32 + tok) * ZW + h * ADK + d0;
        u32x4 wq = (u32x4){0u, 0u, 0u, 0u}, wg = wq, wf = *(const u32x4*)(zr + 512), wv = *(const u32x4*)(zr + 1024);
        if (FULL) { wq = *(const u32x4*)zr; wg = *(const u32x4*)(zr + 1536); }
        for (int cc = 0; cc < pre + NCH; ++cc) { const int c = cc - pre; const bool outp = FULL && (c >= 0);
            if (FULL && HGRN_CHECK && c == 0 && seg > 0) { const LAS f32x4* SA = (const LAS f32x4*)(L + 73728) + tid * 4;
#pragma unroll
                for (int mt = 0; mt < 4; ++mt) { const f32x4 sa = SA[mt];
#pragma unroll
                    for (int r = 0; r < 4; ++r) if (!(fabsf(sa[r] - S[mt][r]) <= 1e-3f + 0.02f * fabsf(S[mt][r]))) chkbad = 1.f; } }
            if (FULL && HGRN_CHECK && chkbad != 0.f) { const unsigned long long t0 = __builtin_amdgcn_s_memrealtime(); while (__builtin_amdgcn_s_memrealtime() - t0 < 10000000000ull) __builtin_amdgcn_s_sleep(64); chkbad = 0.f; }
            float kk[8], qq[8];
            { f32x4 f0, f1, q0 = (f32x4){0.f, 0.f, 0.f, 0.f}, q1 = q0; pg8::unpack8(wf, f0, f1); if (FULL) pg8::unpack8(wq, q0, q1);
                f32x4 l0, l1;
#pragma unroll
                for (int e = 0; e < 4; ++e) { const float fa = lb8[e] + (1.f - lb8[e]) * sigmoidf_(f0[e]), fb = lb8[4 + e] + (1.f - lb8[4 + e]) * sigmoidf_(f1[e]);
                    kk[e] = 1.f - fa; kk[4 + e] = 1.f - fb; l0[e] = __logf(fa); l1[e] = __logf(fb); qq[e] = q0[e]; qq[4 + e] = q1[e]; }
                *(LAS f32x4*)(LF + tok * 128 + d0) = l0; *(LAS f32x4*)(LF + tok * 128 + d0 + 4) = l1;
                *(LAS u32x4*)(L + HL_VV + tok * HROW + d0 * 2) = wv; }
            const u32x4 cg = wg;
            if (c + 1 < NCH) { const bf16_t* zn = zr + (size_t)(cc + 1) * 32 * ZW; wf = *(const u32x4*)(zn + 512); wv = *(const u32x4*)(zn + 1024); if (FULL) { wq = *(const u32x4*)zn; wg = *(const u32x4*)(zn + 1536); } }
            __syncthreads();
            { float x[8];
#pragma unroll
                for (int e = 0; e < 8; ++e) x[e] = LF[(8 * tq + e) * 128 + sd];
#pragma unroll
                for (int e = 1; e < 8; ++e) x[e] += x[e - 1];
                TT[tq * 128 + sd] = x[7];
                __syncthreads();
                const float t0 = TT[sd], t1 = TT[128 + sd], t2 = TT[256 + sd];
                const float off = (tq > 0 ? t0 : 0.f) + (tq > 1 ? t1 : 0.f) + (tq > 2 ? t2 : 0.f);
#pragma unroll
                for (int e = 0; e < 8; ++e) LF[(8 * tq + e) * 128 + sd] = x[e] + off; }
            __syncthreads();
            { const f32x4 b0 = *(const LAS f32x4*)(LF + tok * 128 + d0), b1 = *(const LAS f32x4*)(LF + tok * 128 + d0 + 4), e0 = *(const LAS f32x4*)(LF + 31 * 128 + d0), e1 = *(const LAS f32x4*)(LF + 31 * 128 + d0 + 4);
                f32x4 t0, t1, qa, qb, ia, ib;
#pragma unroll
                for (int e = 0; e < 4; ++e) { t0[e] = kk[e] * __expf(e0[e] - b0[e]); t1[e] = kk[4 + e] * __expf(e1[e] - b1[e]);
                    if (FULL) { qa[e] = qq[e] * __expf(b0[e]); qb[e] = qq[4 + e] * __expf(b1[e]); ia[e] = kk[e] * __expf(-b0[e]); ib[e] = kk[4 + e] * __expf(-b1[e]); } }
                *(LAS u32x4*)(L + HL_KT + tok * HROW + d0 * 2) = pg8::pack8(t0, t1);
                if (FULL) { *(LAS u32x4*)(L + HL_QD + tok * HROW + d0 * 2) = pg8::pack8(qa, qb); *(LAS u32x4*)(L + HL_KI + tok * HROW + d0 * 2) = pg8::pack8(ia, ib); }
                if (tok == 31) {
#pragma unroll
                    for (int e = 0; e < 4; ++e) { DEC[d0 + e] = __expf(e0[e]); DEC[d0 + 4 + e] = __expf(e1[e]); if (!FULL) { SUM[d0 + e] += e0[e]; SUM[d0 + 4 + e] += e1[e]; } } } }
            __syncthreads();
            { const bf16x8 bV = cat44(lds_tr(VV + (4 * g + trq) * HROW + (Vw0 + 4 * trp) * 2), lds_tr(VV + (16 + 4 * g + trq) * HROW + (Vw0 + 4 * trp) * 2));
                if (outp) {
                    f32x4 pt00 = (f32x4){0.f, 0.f, 0.f, 0.f}, pt01 = pt00, pt11 = pt00, o0 = pt00, o1 = pt00;
#pragma unroll
                    for (int ks = 0; ks < 4; ++ks) { const int co = (32 * ks + 8 * g) * 2;
                        const bf16x8 aK0 = *(const LAS bf16x8*)(KI + r15 * HROW + co), aK1 = *(const LAS bf16x8*)(KI + (16 + r15) * HROW + co);
                        const bf16x8 bQ0 = *(const LAS bf16x8*)(QD + r15 * HROW + co), bQ1 = *(const LAS bf16x8*)(QD + (16 + r15) * HROW + co);
                        pt00 = MFMA16(aK0, bQ0, pt00); pt01 = MFMA16(aK0, bQ1, pt01); pt11 = MFMA16(aK1, bQ1, pt11); }
#pragma unroll
                    for (int r = 0; r < 4; ++r) if (4 * g + r > r15) { pt00[r] = 0.f; pt11[r] = 0.f; }
                    const bf16x8 pa0 = pk8(pt00, (f32x4){0.f, 0.f, 0.f, 0.f}), pa1 = pk8(pt01, pt11);
#pragma unroll
                    for (int ks = 0; ks < 4; ++ks) { const bf16x8 bS = pk8(S[2 * ks], S[2 * ks + 1]); const int c0 = (32 * ks + 4 * g) * 2;
                        const u32x2 x0 = *(const LAS u32x2*)(QD + r15 * HROW + c0), x1 = *(const LAS u32x2*)(QD + r15 * HROW + c0 + 32), y0 = *(const LAS u32x2*)(QD + (16 + r15) * HROW + c0), y1 = *(const LAS u32x2*)(QD + (16 + r15) * HROW + c0 + 32);
                        const bf16x8 aQ0 = __builtin_bit_cast(bf16x8, (u32x4){x0.x, x0.y, x1.x, x1.y}), aQ1 = __builtin_bit_cast(bf16x8, (u32x4){y0.x, y0.y, y1.x, y1.y});
                        o0 = MFMA16(aQ0, bS, o0); o1 = MFMA16(aQ1, bS, o1); }
                    o0 = MFMA16(pa0, bV, o0); o1 = MFMA16(pa1, bV, o1);
#pragma unroll
                    for (int r = 0; r < 4; ++r) { OB[(4 * g + r) * 128 + Vw0 + r15] = o0[r]; OB[(16 + 4 * g + r) * 128 + Vw0 + r15] = o1[r]; }
                }
#pragma unroll
                for (int mt = 0; mt < 8; ++mt) { const bf16x8 aKT = cat44(lds_tr(KT + (4 * g + trq) * HROW + (16 * mt + 4 * trp) * 2), lds_tr(KT + (16 + 4 * g + trq) * HROW + (16 * mt + 4 * trp) * 2));
                    const f32x4 dec4 = *(const LAS f32x4*)(DEC + 16 * mt + 4 * g);
                    S[mt] = MFMA16(aKT, bV, S[mt] * dec4); } }
            __syncthreads();
            if (outp) { const f32x4 o0 = *(const LAS f32x4*)(OB + tok * 128 + d0), o1 = *(const LAS f32x4*)(OB + tok * 128 + d0 + 4);
                float ss = pg8::sq8(o0, o1); ss += __shfl_xor(ss, 1); ss += __shfl_xor(ss, 2); ss += __shfl_xor(ss, 4); ss += __shfl_xor(ss, 8);
                const float rs = __builtin_amdgcn_rsqf(ss * (1.f / 128.f) + EPS);
                f32x4 g0, g1, r0, r1; pg8::unpack8(cg, g0, g1);
#pragma unroll
                for (int e = 0; e < 4; ++e) { r0[e] = o0[e] * rs * gn8[e] * sigmoidf_(g0[e]) + chkbad; r1[e] = o1[e] * rs * gn8[4 + e] * sigmoidf_(g1[e]); }
                *(u32x4*)(XA + (row0 + (size_t)c * 32 + tok) * D + h * ADK + d0) = pg8::pack8(r0, r1); }
        }
        if (!FULL) {
            const __amdgpu_buffer_rsrc_t rsL = __builtin_amdgcn_make_buffer_rsrc((void*)HLg, (short)0, 256 * 16384 * 4, 0x00020000);
            const __amdgpu_buffer_rsrc_t rsS = __builtin_amdgcn_make_buffer_rsrc((void*)HSg, (short)0, 256 * 128 * 4, 0x00020000);
            const int lo = (it * 16384 + (Vw0 + r15) * 128 + 4 * g) * 4;
#pragma unroll
            for (int mt = 0; mt < 8; ++mt) __builtin_amdgcn_raw_buffer_store_b128(__builtin_bit_cast(u32x4, S[mt]), rsL, lo + mt * 64, 0, 16);
            if (tid < 128) __builtin_amdgcn_raw_buffer_store_b32(__builtin_bit_cast(unsigned, SUM[tid]), rsS, (it * 128 + tid) * 4, 0, 16); }
        __syncthreads();
    }
}
__device__ __forceinline__ void phase_conv(const Frame& F, const Args& a) {
    unsigned char* ws = a.ws; const bf16_t* Z = (const bf16_t*)(ws + WS_Z); bf16_t* XA = (bf16_t*)(ws + WS_XA); const int tid = F.tid;
    const int gt = F.vcu * NTHR + tid, NGT = F.G * NTHR;
    for (int i = gt; i < NT * (512 / 8); i += NGT) {
        const int row = i >> 6, c0 = (i & 63) * 8, t = row & (SEQ - 1);
        const bf16_t* zr = Z + (size_t)row * ZW;
        f32x4 y0a, y0b, y1a = (f32x4){0.f, 0.f, 0.f, 0.f}, y1b = y1a, y2a = y1a, y2b = y1a, ga, gb;
        pg8::unpack8(*(const u32x4*)(zr + 2560 + c0), y0a, y0b); pg8::unpack8(*(const u32x4*)(zr + 2048 + c0), ga, gb);
        if (t >= 1) pg8::unpack8(*(const u32x4*)(zr - ZW + 2560 + c0), y1a, y1b);
        if (t >= 2) pg8::unpack8(*(const u32x4*)(zr - 2 * ZW + 2560 + c0), y2a, y2b);
        const f32x4 w0a = *(const f32x4*)(a.conv_w + c0), w0b = *(const f32x4*)(a.conv_w + c0 + 4), w1a = *(const f32x4*)(a.conv_w + 512 + c0), w1b = *(const f32x4*)(a.conv_w + 512 + c0 + 4),
                    w2a = *(const f32x4*)(a.conv_w + 1024 + c0), w2b = *(const f32x4*)(a.conv_w + 1024 + c0 + 4);
        const f32x4 ra = ga * (w0a * y2a + w1a * y1a + w2a * y0a), rb = gb * (w0b * y2b + w1b * y1b + w2b * y0b);
        u32x4 o; o.x = pk2(ra[0], ra[1]); o.y = pk2(ra[2], ra[3]); o.z = pk2(rb[0], rb[1]); o.w = pk2(rb[2], rb[3]);
        *(u32x4*)(XA + (size_t)row * D + 512 + c0) = o;
    }
}

__device__ __forceinline__ void phase_attn(const Frame& F, const Args& a) {
    const bf16_t* QKV = (const bf16_t*)(a.ws + WS_QKV); bf16_t* XA = (bf16_t*)(a.ws + WS_XA);
    const int gw = F.vcu * NWAVES + F.wave, NGW = F.G * NWAVES, lane = F.lane;
    for (int task = gw; task < NT * NQH; task += NGW) {
        const int m = task >> 4, hq = task & 15, kv = hq >> 3, t = m & (SEQ - 1);
        const bf16_t* qp = QKV + (size_t)m * CIN + hq * HD;
        float q[64];
#pragma unroll
        for (int i = 0; i < 8; ++i) { f32x4 x0, x1; pg8::unpack8(*(const u32x4*)(qp + 8 * i), x0, x1);
#pragma unroll
            for (int j = 0; j < 4; ++j) { q[8 * i + j] = x0[j]; q[8 * i + 4 + j] = x1[j]; } }
        float sc[2];
#pragma unroll
        for (int r = 0; r < 2; ++r) { const int j = lane + 64 * r, tk = t - 127 + j; float s = -INFINITY;
            if (tk >= 0) { const bf16_t* kp = QKV + (size_t)(m - 127 + j) * CIN + 1024 + kv * HD; float d = 0.f;
#pragma unroll
                for (int i = 0; i < 8; ++i) { f32x4 x0, x1; pg8::unpack8(*(const u32x4*)(kp + 8 * i), x0, x1);
#pragma unroll
                    for (int jj = 0; jj < 4; ++jj) d += q[8 * i + jj] * x0[jj] + q[8 * i + 4 + jj] * x1[jj]; }
                s = d * 0.125f; }
            sc[r] = s; }
        const float sink = a.sinks[hq];
        const float mx = fmaxf(wave_max(fmaxf(sc[0], sc[1])), sink);
        const float e0 = __expf(sc[0] - mx), e1 = __expf(sc[1] - mx);
        const float den = wave_sum(e0 + e1) + __expf(sink - mx);
        const float inv = 1.f / den; const float p0 = e0 * inv, p1 = e1 * inv;
        float o = 0.f;
        const int j0 = (t >= 127) ? 0 : 127 - t;
        for (int j = j0; j < 128; ++j) { const float pj = __shfl(j < 64 ? p0 : p1, j & 63); o += pj * bf1(QKV[(size_t)(m - 127 + j) * CIN + 1152 + kv * HD + lane]); }
        XA[(size_t)m * D + hq * HD + lane] = (bf16_t)f2bf(o);
    }
}

typedef float f32x16 __attribute__((ext_vector_type(16)));
#define MFMA32(A, B, C) __builtin_amdgcn_mfma_f32_32x32x16_bf16(A, B, C, 0, 0, 0)
constexpr int AT_ROW = 144, AT_K = 0, AT_V = 256 * AT_ROW;
__device__ __forceinline__ void phase_attn_fast(const Frame& F, const Args& a) {
    const bf16_t* QKV = (const bf16_t*)(a.ws + WS_QKV); bf16_t* XA = (bf16_t*)(a.ws + WS_XA);
    LAS unsigned char* L = F.lds;
    const int tid = F.tid, lane = F.lane, w = F.wave, c32 = lane & 31, hh = lane >> 5, i16 = lane & 15, trq = i16 >> 2, trp = i16 & 3, G1 = (lane >> 4) & 1;
    const float CS = 0.125f * 1.4426950408889634f;
    for (int unit = F.vcu; unit < NB * NKVH * (SEQ / 128); unit += F.G) {
        const int nb = unit & 31, kv = (unit >> 5) & 1, b = unit >> 6;
        const long rowk0 = (long)b * SEQ + 128 * nb - 128;
        __syncthreads();
#pragma unroll
        for (int i = 0; i < 4; ++i) { const int p = tid + NTHR * i, row = p >> 3, sg = p & 7; const bool ok = (nb > 0) || (row >= 128);
            u32x4 kx = (u32x4){0u, 0u, 0u, 0u}, vx = kx;
            if (ok) { const bf16_t* src = QKV + (size_t)(rowk0 + row) * CIN + 1024 + kv * HD + sg * 8; kx = *(const u32x4*)src; vx = *(const u32x4*)(src + 128); }
            *(LAS u32x4*)(L + AT_K + row * AT_ROW + sg * 16) = kx; *(LAS u32x4*)(L + AT_V + row * AT_ROW + sg * 16) = vx; }
        __syncthreads();
        const int hq = kv * 8 + w; const float sink2 = a.sinks[hq] * 1.4426950408889634f;
        for (int qt = 0; qt < 4; ++qt) {
            const size_t qrow = (size_t)b * SEQ + 128 * nb + 32 * qt + c32;
            const bf16_t* qp = QKV + qrow * CIN + hq * HD + 8 * hh;
            bf16x8 bQ[4];
#pragma unroll
            for (int ks = 0; ks < 4; ++ks) bQ[ks] = *(const bf16x8*)(qp + 16 * ks);
            f32x16 st[5]; float mx = sink2;
#pragma unroll
            for (int t = 0; t < 5; ++t) {
                const bool blk_ok = (nb > 0) || (qt + t >= 4);
#pragma unroll
                for (int r = 0; r < 16; ++r) st[t][r] = 0.f;
                if (blk_ok) {
#pragma unroll
                    for (int ks = 0; ks < 4; ++ks) { const bf16x8 aK = *(const LAS bf16x8*)(L + AT_K + (32 * (qt + t) + c32) * AT_ROW + (16 * ks + 8 * hh) * 2); st[t] = MFMA32(aK, bQ[ks], st[t]); } }
#pragma unroll
                for (int r = 0; r < 16; ++r) { const int kk = (r & 3) + 8 * (r >> 2) + 4 * hh;
                    bool ok = blk_ok; if (t == 0) ok = ok && (kk > c32); if (t == 4) ok = ok && (kk <= c32);
                    const float z = ok ? st[t][r] * CS : -INFINITY; st[t][r] = z; mx = fmaxf(mx, z); }
            }
            mx = fmaxf(mx, __shfl_xor(mx, 32));
            float sum = 0.f;
#pragma unroll
            for (int t = 0; t < 5; ++t)
#pragma unroll
                for (int r = 0; r < 16; ++r) { const float p = __builtin_amdgcn_exp2f(st[t][r] - mx); st[t][r] = p; sum += p; }
            sum += __shfl_xor(sum, 32);
            const float inv = 1.f / (sum + __builtin_amdgcn_exp2f(sink2 - mx));
            f32x16 o0, o1;
#pragma unroll
            for (int r = 0; r < 16; ++r) { o0[r] = 0.f; o1[r] = 0.f; }
#pragma unroll
            for (int t = 0; t < 5; ++t)
#pragma unroll
                for (int s2 = 0; s2 < 2; ++s2) {
                    const bf16x8 bP = pk8((f32x4){st[t][8 * s2], st[t][8 * s2 + 1], st[t][8 * s2 + 2], st[t][8 * s2 + 3]}, (f32x4){st[t][8 * s2 + 4], st[t][8 * s2 + 5], st[t][8 * s2 + 6], st[t][8 * s2 + 7]});
                    const LAS unsigned char* vb = L + AT_V + (32 * (qt + t) + 16 * s2 + 4 * hh + trq) * AT_ROW + (16 * G1 + 4 * trp) * 2;
                    const bf16x8 aV0 = cat44(lds_tr(vb), lds_tr(vb + 8 * AT_ROW)), aV1 = cat44(lds_tr(vb + 64), lds_tr(vb + 8 * AT_ROW + 64));
                    o0 = MFMA32(aV0, bP, o0); o1 = MFMA32(aV1, bP, o1); }
            bf16_t* op = XA + qrow * D + hq * HD + 4 * hh;
#pragma unroll
            for (int rg = 0; rg < 4; ++rg) { u32x2 x0, x1;
                x0.x = pg8::cvt_pk_bf16(o0[4 * rg] * inv, o0[4 * rg + 1] * inv); x0.y = pg8::cvt_pk_bf16(o0[4 * rg + 2] * inv, o0[4 * rg + 3] * inv);
                x1.x = pg8::cvt_pk_bf16(o1[4 * rg] * inv, o1[4 * rg + 1] * inv); x1.y = pg8::cvt_pk_bf16(o1[4 * rg + 2] * inv, o1[4 * rg + 3] * inv);
                *(u32x2*)(op + 8 * rg) = x0; *(u32x2*)(op + 32 + 8 * rg) = x1; }
        }
    }
}

__device__ __forceinline__ void phase_route(const Frame& F, const Args& a, int l) {
    unsigned char* ws = a.ws; const float* H = a.out; bf16_t* XA = (bf16_t*)(ws + WS_XA);
    gu32* cnt = (gu32*)(ws + WS_CTL) + CW_CNT + l * 32; int* list = (int*)(ws + WS_LIST); f32x2* wlist = (f32x2*)(ws + WS_WLIST);
    LAS float* WR = (LAS float*)F.lds;
    for (int i = F.tid; i < D * NE; i += NTHR) { const int k = i >> 4, e = i & 15; const int ln = (k & 255) >> 2, j = k >> 8, ii = k & 3, r = (j * 4 + ii) * 64 + ln;
        WR[r * 16 + (((e >> 2) + (ln >> 2)) & 3) * 4 + (e & 3)] = a.w_router[i]; }
    __syncthreads();
    const float* g = a.norm_ffn + l * D;
    const int gw = F.vcu * NWAVES + F.wave, NGW = F.G * NWAVES, lane = F.lane;
    f32x4 gv[4];
#pragma unroll
    for (int j = 0; j < 4; ++j) gv[j] = *((const f32x4*)g + lane + 64 * j);
    for (int m = gw; m < NT; m += NGW) {
        const f32x4* xr = (const f32x4*)(H + (size_t)m * D) + lane; f32x4 v[4]; float s = 0.f;
#pragma unroll
        for (int j = 0; j < 4; ++j) { v[j] = xr[64 * j]; s += (v[j][0] * v[j][0] + v[j][1] * v[j][1]) + (v[j][2] * v[j][2] + v[j][3] * v[j][3]); }
        const float rs = __builtin_amdgcn_rsqf(wave_sum(s) * (1.f / D) + EPS);
        u32x2* o8 = (u32x2*)(XA + (size_t)m * D) + lane;
        float lg[16];
#pragma unroll
        for (int e = 0; e < 16; ++e) lg[e] = 0.f;
#pragma unroll
        for (int j = 0; j < 4; ++j) { v[j] = v[j] * rs * gv[j]; u32x2 o; o.x = pk2(v[j][0], v[j][1]); o.y = pk2(v[j][2], v[j][3]); o8[64 * j] = o;
#pragma unroll
            for (int i = 0; i < 4; ++i) { const LAS f32x4* wr4 = (const LAS f32x4*)(WR + ((j * 4 + i) * 64 + lane) * 16);
#pragma unroll
                for (int qd = 0; qd < 4; ++qd) { const f32x4 w4 = wr4[(qd + (lane >> 2)) & 3];
#pragma unroll
                    for (int e = 0; e < 4; ++e) lg[qd * 4 + e] += v[j][i] * w4[e]; }
                asm volatile("" ::: "memory"); } }
#pragma unroll
        for (int e = 0; e < 16; ++e) lg[e] = wave_sum(lg[e]);
        float mx = lg[0];
#pragma unroll
        for (int e = 1; e < 16; ++e) mx = fmaxf(mx, lg[e]);
        float ex[16];
#pragma unroll
        for (int e = 0; e < 16; ++e) ex[e] = __expf(lg[e] - mx);
        float gs[4], gv1[4], gv2[4]; int gi1[4], gi2[4];
#pragma unroll
        for (int gq = 0; gq < 4; ++gq) { float m1 = ex[4 * gq]; int i1 = 0;
#pragma unroll
            for (int i = 1; i < 4; ++i) if (ex[4 * gq + i] > m1) { m1 = ex[4 * gq + i]; i1 = i; }
            float m2 = -1.f; int i2 = 0;
#pragma unroll
            for (int i = 0; i < 4; ++i) if (i != i1 && ex[4 * gq + i] > m2) { m2 = ex[4 * gq + i]; i2 = i; }
            gs[gq] = m1 + m2; gv1[gq] = m1; gv2[gq] = m2; gi1[gq] = i1; gi2[gq] = i2; }
        int sel = 0; float best = gs[0], v1 = gv1[0], v2 = gv2[0]; int i1 = gi1[0], i2 = gi2[0];
#pragma unroll
        for (int gq = 1; gq < 4; ++gq) if (gs[gq] > best) { best = gs[gq]; sel = gq; v1 = gv1[gq]; v2 = gv2[gq]; i1 = gi1[gq]; i2 = gi2[gq]; }
        const float wsum = 1.f / (v1 + v2); const float w1 = v1 * wsum, w2 = v2 * wsum;
        const int ea = i1 < i2 ? i1 : i2, eb = i1 < i2 ? i2 : i1; const float wa = i1 < i2 ? w1 : w2, wb = i1 < i2 ? w2 : w1;
        const int pr = (ea == 0) ? eb - 1 : ((ea == 1) ? eb + 1 : 5); const int c = sel * 6 + pr;
        if (lane == 0) { const unsigned pos = __hip_atomic_fetch_add(cnt + c, 1u, __ATOMIC_RELAXED, __HIP_MEMORY_SCOPE_AGENT);
            list[(size_t)c * LCAP + pos] = m; wlist[(size_t)c * LCAP + pos] = (f32x2){wa, wb}; }
    }
}

constexpr int LX_UT = LX_OFF + 2048;
template <int NP>
__device__ __forceinline__ void moe_tables(const Frame& F, unsigned char* ws, int l) {
    const gu32* cnt = (const gu32*)(ws + WS_CTL) + CW_CNT + l * 32;
    volatile LAS int* TB = (volatile LAS int*)(F.lds + LX_TB); volatile LAS int* CN = (volatile LAS int*)(F.lds + LX_CNT); volatile LAS int* CL = (volatile LAS int*)(F.lds + LX_CLS);
    volatile LAS unsigned long long* UT = (volatile LAS unsigned long long*)(F.lds + LX_UT);
    __syncthreads();
    if (F.tid < NCLS) CN[F.tid] = (int)__hip_atomic_load(cnt + F.tid, __ATOMIC_RELAXED, __HIP_MEMORY_SCOPE_AGENT);
    __syncthreads();
    if (F.tid == 0) { int tb = 0;
#pragma unroll 1
        for (int c = 0; c < NCLS; ++c) { TB[c] = tb; const int n = (CN[c] + 255) >> 8;
#pragma unroll 1
            for (int i = 0; i < n; ++i) CL[tb + i] = c;
            tb += n; }
        TB[NCLS] = tb; }
    __syncthreads();
    if (F.tid < 8) { const int i = F.tid; const int L = i * F.G + F.vcu; const int TT = TB[NCLS];
        unsigned long long w0 = ~0ull, w1 = 0, w2 = 0, w3 = 0, w4 = 0;
        if (L < TT * NP) { const int tau = L / NP, pn = L % NP; const int c = CL[tau]; const int ti = tau - TB[c], rem = CN[c] - ti * 256;
            const int g = c / 6, pr = c % 6; const int ea = pr < 3 ? 0 : (pr < 5 ? 1 : 2), eb = pr < 3 ? pr + 1 : (pr < 5 ? pr - 1 : 3);
            const int nv = rem < 256 ? rem : 256, aux = c * LCAP + ti * 256;
            const char *pA, *pB, *pB2;
            if (NP == 8) { const int e = g * 4 + (pn < 4 ? ea : eb); pA = (const char*)(ws + WS_XA); pB = (const char*)(ws + WS_W1) + ((size_t)(l * NE + e) * D * D + (size_t)(pn & 3) * 256 * D) * 2; pB2 = pB; }
            else { pA = (const char*)(ws + WS_HID) + (size_t)tau * 256 * 1024 * 2; pB = (const char*)(ws + WS_W2) + ((size_t)(l * NE + g * 4 + ea) * D * DE + (size_t)pn * 256 * DE) * 2;
                pB2 = (const char*)(ws + WS_W2) + ((size_t)(l * NE + g * 4 + eb) * D * DE + (size_t)pn * 256 * DE) * 2; }
            w0 = (unsigned long long)(unsigned)tau | ((unsigned long long)(unsigned)pn << 32); w1 = (unsigned long long)pA; w2 = (unsigned long long)pB; w3 = (unsigned long long)pB2;
            w4 = (unsigned long long)(unsigned)nv | ((unsigned long long)(unsigned)aux << 32); }
        UT[i * 8 + 0] = w0; UT[i * 8 + 1] = w1; UT[i * 8 + 2] = w2; UT[i * 8 + 3] = w3; UT[i * 8 + 4] = w4; }
    __syncthreads();
}
__device__ __forceinline__ unsigned long long rfl64(unsigned long long v) { const unsigned lo = __builtin_amdgcn_readfirstlane((unsigned)v), hi = __builtin_amdgcn_readfirstlane((unsigned)(v >> 32)); return ((unsigned long long)hi << 32) | lo; }
struct MoeSched {
    const LAS unsigned long long* UT; const int* list;
    __device__ __forceinline__ bool next(int i, pg8::Unit& u) const {
        if (i >= 8) return false;
        const unsigned long long w0 = rfl64(UT[i * 8 + 0]); if ((int)(unsigned)w0 < 0) return false;
        const unsigned long long w1 = rfl64(UT[i * 8 + 1]), w2 = rfl64(UT[i * 8 + 2]), w3 = rfl64(UT[i * 8 + 3]), w4 = rfl64(UT[i * 8 + 4]);
        u.pm = (int)(unsigned)w0; u.pn = (int)(unsigned)(w0 >> 32); u.pA = (const char*)w1; u.pB = (const char*)w2; u.pB2 = (const char*)w3; u.nv = (int)(unsigned)w4; u.aux = (int)(unsigned)(w4 >> 32); u.lst = list + u.aux;
        return true;
    }
};

__device__ __forceinline__ void phase_final(const Frame& F, const Args& a) {
    const int gw = F.vcu * NWAVES + F.wave, NGW = F.G * NWAVES, lane = F.lane;
    f32x4 gv[4];
#pragma unroll
    for (int j = 0; j < 4; ++j) gv[j] = *((const f32x4*)a.norm_final + lane + 64 * j);
    for (int m = gw; m < NT; m += NGW) { f32x4* xr = (f32x4*)(a.out + (size_t)m * D) + lane; f32x4 v[4]; float s = 0.f;
#pragma unroll
        for (int j = 0; j < 4; ++j) { v[j] = xr[64 * j]; s += (v[j][0] * v[j][0] + v[j][1] * v[j][1]) + (v[j][2] * v[j][2] + v[j][3] * v[j][3]); }
        const float rs = __builtin_amdgcn_rsqf(wave_sum(s) * (1.f / D) + EPS);
#pragma unroll
        for (int j = 0; j < 4; ++j) xr[64 * j] = v[j] * rs * gv[j]; }
}

constexpr int N_PHASES = 18;
#ifndef HGRN_NAIVE
#define HGRN_NAIVE 0
#endif
#ifndef ATTN_NAIVE
#define ATTN_NAIVE 0
#endif
#if defined(__HIP_DEVICE_COMPILE__)
#define LOAD_ARGS(a) Args a; { const __attribute__((address_space(4))) char* _kp = (const __attribute__((address_space(4))) char*)__builtin_amdgcn_kernarg_segment_ptr(); asm volatile("" : "+s"(_kp)); a = *(const Args*)(const char*)_kp; } unsigned char* ws = a.ws
#else
#define LOAD_ARGS(a) Args a = args; unsigned char* ws = a.ws
#endif
__global__ void __launch_bounds__(NTHR, 2) mega_fwd(Args args) {
    extern __shared__ __attribute__((aligned(16))) unsigned char lds_raw[];
    Frame F; F.lds = (LAS unsigned char*)lds_raw; F.tid = threadIdx.x; F.lane = F.tid & 63; F.wave = __builtin_amdgcn_readfirstlane(F.tid >> 6);
    F.G = gridDim.x; { const int bx = blockIdx.x; F.vcu = (F.G % 8 == 0) ? (bx % 8) * (F.G / 8) + bx / 8 : bx; }
    for (int u = F.tid; u < (LDS_BYTES - LX_OFF) / 4; u += NTHR) ((LAS unsigned*)(F.lds + LX_OFF))[u] = 0u;
    __syncthreads();
#if !MK_PER_PHASE
    XcdBarrier bar = xcd_barrier_post((unsigned*)((gu32*)(args.ws + WS_CTL) + CW_BAR), (volatile LAS unsigned*)(F.lds + LX_BAR));
#define GRID_BAR() xcd_barrier(bar)
#else
#define GRID_BAR() do { } while (0)
#endif
    const int lo = args.ph_lo, hi = args.ph_hi;
#define SITE_FRAME(Fp) Frame Fp = F; { int _t = threadIdx.x; asm volatile("" : "+v"(_t)); unsigned _z = 0; asm volatile("" : "+s"(_z)); Fp.tid = _t; Fp.lane = _t & 63; Fp.wave = __builtin_amdgcn_readfirstlane(_t >> 6); Fp.lds = F.lds + _z; }
#ifndef PHMASK
#define PHMASK 0x3FFFF
#endif
#define IN(k) (((PHMASK >> (k)) & 1) && lo <= (k) && (k) < hi)
#define BOTH(k) (IN(k) && IN((k) + 1))
    const int bx = (int)blockIdx.x;

    if (IN(0)) { LOAD_ARGS(a); (void)ws; SITE_FRAME(Fp); phase_prep(Fp, a); if (BOTH(0)) GRID_BAR(); }

    for (int l = 0; l < 2; ++l) {
        const int pb = 1 + 8 * l;
        if (IN(pb + 0)) { LOAD_ARGS(a); SITE_FRAME(Fp);
#ifndef NO_S1A
            if (l == 0) { pg8::DenseSched S; S.init(ws + WS_XA, ws + WS_WINAB, NT, ABIN, D, D, Fp.G, bx); pg8::EpiInAb E{(bf16_t*)(ws + WS_Z)};
                pg8::gemm_phase<pg8::EpiInAb, pg8::DenseSched, false, false>(Fp.lds, D, D, D, S, E); }
#endif
#ifndef NO_S1B
            if (l == 1) { pg8::DenseSched S; S.init(ws + WS_XA, ws + WS_WINC, NT, CIN, D, D, Fp.G, bx); pg8::EpiQkv E{(bf16_t*)(ws + WS_QKV), a.b_in_c, (const float*)(ws + WS_SSB)};
                pg8::gemm_phase<pg8::EpiQkv, pg8::DenseSched, false, false>(Fp.lds, D, D, D, S, E); }
#endif
#ifndef NO_S1C
            { pg8::DenseSched S; S.init(ws + WS_PB + (size_t)l * NT * PLE * 2, ws + WS_WPP + (size_t)l * D * PLE * 2, NT, D, PLE, PLE, Fp.G, bx); pg8::EpiBf16 E{(bf16_t*)(ws + WS_PP), D};
                pg8::gemm_phase<pg8::EpiBf16, pg8::DenseSched, false, false>(Fp.lds, PLE, PLE, PLE, S, E); }
#endif
            if (BOTH(pb + 0)) GRID_BAR();
        }
#if HGRN_NAIVE
        if (IN(pb + 1)) { LOAD_ARGS(a); (void)ws; SITE_FRAME(Fp); if (l == 0) { phase_hgrn_conv(Fp, a); phase_conv(Fp, a); } else phase_attn(Fp, a); if (BOTH(pb + 1)) GRID_BAR(); }
#else
        if (IN(pb + 1)) { LOAD_ARGS(a); (void)ws; SITE_FRAME(Fp); if (l == 0) { hgrn_pass<false>(Fp, a); phase_conv(Fp, a); } else { if (ATTN_NAIVE) phase_attn(Fp, a); else phase_attn_fast(Fp, a); } if (BOTH(pb + 1)) GRID_BAR(); }
        if (IN(pb + 2) && l == 0) { LOAD_ARGS(a); (void)ws; SITE_FRAME(Fp); hgrn_pass<true>(Fp, a); if (BOTH(pb + 2)) GRID_BAR(); }
#endif
        if (IN(pb + 3)) { LOAD_ARGS(a); SITE_FRAME(Fp);
            pg8::DenseSched S; S.init(ws + WS_XA, ws + (l == 0 ? WS_WOUTAB : WS_WOUTC), NT, D, D, D, Fp.G, bx);
            pg8::EpiRes E{l == 0 ? a.x : a.out, a.out, l == 0 ? nullptr : a.b_out_c};
            pg8::gemm_phase<pg8::EpiRes, pg8::DenseSched, false, false>(Fp.lds, D, D, D, S, E);
            if (BOTH(pb + 3)) GRID_BAR();
        }
        if (IN(pb + 4)) { LOAD_ARGS(a); (void)ws; SITE_FRAME(Fp); phase_route(Fp, a, l); if (BOTH(pb + 4)) GRID_BAR(); }
        if (IN(pb + 5)) { LOAD_ARGS(a); SITE_FRAME(Fp); moe_tables<8>(Fp, ws, l);
            MoeSched S{(const LAS unsigned long long*)(Fp.lds + LX_UT), (const int*)(ws + WS_LIST)};
            pg8::EpiG1 E{(bf16_t*)(ws + WS_HID), (const f32x2*)(ws + WS_WLIST)};
            pg8::gemm_phase<pg8::EpiG1, MoeSched, true, false>(Fp.lds, D, D, D, S, E);
            if (BOTH(pb + 5)) GRID_BAR(); }
        if (IN(pb + 6)) { LOAD_ARGS(a); SITE_FRAME(Fp); moe_tables<4>(Fp, ws, l);
            MoeSched S{(const LAS unsigned long long*)(Fp.lds + LX_UT), (const int*)(ws + WS_LIST)};
            pg8::EpiG2 E{a.out, (bf16_t*)(ws + WS_XA2), (float*)(ws + WS_SSA)};
            pg8::gemm_phase<pg8::EpiG2, MoeSched, false, true>(Fp.lds, 1024, 1024, DE, S, E);
            if (BOTH(pb + 6)) GRID_BAR(); }
        if (IN(pb + 7)) { LOAD_ARGS(a); SITE_FRAME(Fp);
            pg8::DenseSched S; S.init(ws + WS_XA2, ws + WS_WPG + (size_t)l * D * D * 2, NT, D, D, D, Fp.G, bx);
            pg8::EpiPle E{a.out, (bf16_t*)(ws + WS_XA), (const bf16_t*)(ws + WS_PP), (const float*)(ws + WS_SSA), (float*)(ws + WS_SSB)};
            pg8::gemm_phase<pg8::EpiPle, pg8::DenseSched, false, false>(Fp.lds, D, D, D, S, E);
            if (BOTH(pb + 7)) GRID_BAR();
        }
    }
    if (IN(17)) { LOAD_ARGS(a); (void)ws; SITE_FRAME(Fp); phase_final(Fp, a); }
#undef IN
#undef BOTH
}

extern "C" void kernel_launch(void* const* d_in, const int* in_sizes, int n_in, void* d_out, int out_size, void* d_ws, size_t ws_size, hipStream_t stream) {
    static int grid = 0;
    if (grid == 0) {
        if (n_in != 22 || out_size != NT * D || ws_size < WS_END) { fprintf(stderr, "kernel_launch: unexpected shapes (n_in %d, out %d, ws %zu)\n", n_in, out_size, ws_size); grid = -1; return; }
        int dev = 0, cus = 0, per_cu = 0;
        if (hipGetDevice(&dev) != hipSuccess || hipDeviceGetAttribute(&cus, hipDeviceAttributeMultiprocessorCount, dev) != hipSuccess) { grid = -1; return; }
        if (hipFuncSetAttribute((const void*)mega_fwd, hipFuncAttributeMaxDynamicSharedMemorySize, LDS_BYTES) != hipSuccess) { fprintf(stderr, "kernel_launch: hipFuncSetAttribute failed\n"); grid = -1; return; }
        if (hipOccupancyMaxActiveBlocksPerMultiprocessor(&per_cu, (const void*)mega_fwd, NTHR, LDS_BYTES) != hipSuccess || per_cu < 1) fprintf(stderr, "kernel_launch: occupancy query says %d\n", per_cu);
        (void)hipGetLastError();
        grid = cus;
    }
    if (grid < 0) return;
    (void)hipMemsetAsync((char*)d_ws + WS_CTL, 0, CTL_ZERO_BYTES, stream);
    Args a{};
    a.x = (const float*)d_in[0]; a.p = (const float*)d_in[1]; a.norm_mix = (const float*)d_in[2]; a.norm_ffn = (const float*)d_in[3]; a.norm_ple = (const float*)d_in[4]; a.norm_final = (const float*)d_in[5];
    a.w_in_ab = (const float*)d_in[6]; a.lb_logits = (const float*)d_in[7]; a.hgrn_out_norm = (const float*)d_in[8]; a.conv_w = (const float*)d_in[9]; a.w_out_ab = (const float*)d_in[10];
    a.w_in_c = (const float*)d_in[11]; a.b_in_c = (const float*)d_in[12]; a.sinks = (const float*)d_in[13]; a.w_out_c = (const float*)d_in[14]; a.b_out_c = (const float*)d_in[15];
    a.w_router = (const float*)d_in[16]; a.w_gate_e = (const float*)d_in[17]; a.w_up_e = (const float*)d_in[18]; a.w_down_e = (const float*)d_in[19]; a.w_ple_gate = (const float*)d_in[20]; a.w_ple_proj = (const float*)d_in[21];
    a.out = (float*)d_out; a.ws = (unsigned char*)d_ws;
#if MK_PER_PHASE
    for (int ph = 0; ph < N_PHASES; ++ph) { a.ph_lo = ph; a.ph_hi = ph + 1; hipLaunchKernelGGL(mega_fwd, dim3(grid), dim3(NTHR), LDS_BYTES, stream, a); }
#else
    a.ph_lo = 0; a.ph_hi = N_PHASES; hipLaunchKernelGGL(mega_fwd, dim3(grid), dim3(NTHR), LDS_BYTES, stream, a);
#endif
}
```

```cpp
#include <hip/hip_runtime.h>
#include <cstdio>
#include <cstdint>

#ifndef MK_PER_PHASE
#define MK_PER_PHASE 0
#endif

#define LAS __attribute__((address_space(3)))
#define GAS __attribute__((address_space(1)))
typedef unsigned short bf16_t;
typedef short bf16x8 __attribute__((ext_vector_type(8)));
typedef float f32x4 __attribute__((ext_vector_type(4)));
typedef float f32x2 __attribute__((ext_vector_type(2)));
typedef unsigned u32x4 __attribute__((ext_vector_type(4)));
typedef unsigned u32x2 __attribute__((ext_vector_type(2)));
typedef GAS unsigned gu32;

constexpr int NB = 8, SEQ = 4096, D = 1024, NT = NB * SEQ;
constexpr int PLE = 256;
constexpr int AW = 512, AH = 4, ADK = 128;
constexpr int ABIN = 3584, ZW = 3072;
constexpr int CIN = 1280, HD = 64, NQH = 16, NKVH = 2, WIN = 128;
constexpr int NE = 16, DE = 512;
constexpr int NCLS = 24, LCAP = NT;
constexpr int HIDROWS = NT + NCLS * 256;
constexpr float EPS = 1e-6f;

constexpr size_t MiB = 1u << 20;
constexpr size_t WS_CTL = 0, CTL_ZERO_BYTES = 1 * MiB;
constexpr size_t WS_WINAB = 1 * MiB;
constexpr size_t WS_WOUTAB = 8 * MiB;
constexpr size_t WS_WINC = 10 * MiB;
constexpr size_t WS_WOUTC = 13 * MiB;
constexpr size_t WS_WPG = 15 * MiB;
constexpr size_t WS_WPP = 19 * MiB;
constexpr size_t WS_W1 = 20 * MiB;
constexpr size_t WS_W2 = 84 * MiB;
constexpr size_t WS_PB = 116 * MiB;
constexpr size_t WS_XA = 148 * MiB;
constexpr size_t WS_Z = 212 * MiB;
constexpr size_t WS_XA2 = WS_Z;
constexpr size_t WS_HID = WS_Z + 64 * MiB;
constexpr size_t WS_QKV = WS_Z + 64 * MiB;
constexpr size_t WS_PP = 404 * MiB;
constexpr size_t WS_LIST = 468 * MiB;
constexpr size_t WS_WLIST = 471 * MiB;
constexpr size_t WS_SSA = 477 * MiB;
constexpr size_t WS_SSB = 479 * MiB;
constexpr size_t WS_LB = 481 * MiB;
constexpr size_t WS_HL = 484 * MiB;
constexpr size_t WS_HSUM = 500 * MiB;
constexpr size_t WS_RLIST = 502 * MiB;
constexpr size_t WS_END = 505 * MiB;
constexpr int CW_BAR = 4096;
constexpr int CW_CNT = 16384;

constexpr int RING_BYTES = 131072;
constexpr int LX_OFF = RING_BYTES;
constexpr int LX_BAR = LX_OFF + 0;
constexpr int LX_TB = LX_OFF + 64;
constexpr int LX_CNT = LX_OFF + 64 + 128;
constexpr int LX_CLS = LX_OFF + 512;
constexpr int LDS_BYTES = 147456;
constexpr int NWAVES = 8, NTHR = 512;

__device__ __forceinline__ unsigned f2bf(float f) { unsigned u = __builtin_bit_cast(unsigned, f); return (u + 0x7fffu + ((u >> 16) & 1u)) >> 16; }
__device__ __forceinline__ unsigned pk2(float lo, float hi) { return f2bf(lo) | (f2bf(hi) << 16); }
__device__ __forceinline__ float bflo(unsigned w) { return __builtin_bit_cast(float, w << 16); }
__device__ __forceinline__ float bfhi(unsigned w) { return __builtin_bit_cast(float, w & 0xffff0000u); }
__device__ __forceinline__ float bf1(bf16_t h) { return __builtin_bit_cast(float, (unsigned)h << 16); }
__device__ __forceinline__ float sigmoidf_(float x) { return __builtin_amdgcn_rcpf(1.f + __expf(-x)); }
__device__ __forceinline__ float siluf_(float x) { return x * sigmoidf_(x); }
__device__ __forceinline__ float wave_sum(float v) {
#pragma unroll
    for (int o = 1; o < 64; o <<= 1) v += __shfl_xor(v, o);
    return v;
}
__device__ __forceinline__ float wave_max(float v) {
#pragma unroll
    for (int o = 1; o < 64; o <<= 1) v = fmaxf(v, __shfl_xor(v, o));
    return v;
}
#define LDS_WAIT() asm volatile("s_waitcnt lgkmcnt(0)" ::: "memory")

namespace pg8 {
constexpr int BM = 256, BK = 64, HALF = 128, HTB = HALF * BK * 2, NXCD = 8, WGM = 8;
__host__ __device__ __forceinline__ int lds_byte(int r, int c) { const int st = (r >> 4) * 2 + (c >> 5), rr = r & 15, cc = c & 31, ob = rr * 64 + cc * 2; return st * 1024 + (ob ^ (((ob >> 9) & 1) << 5)); }
__host__ __device__ __forceinline__ void stage_rc(int b, int& R, int& C) { const int st = b / 1024, sb = b % 1024, swz = sb ^ (((sb >> 9) & 1) << 5); R = (st >> 1) * 16 + swz / 64; C = (st & 1) * 32 + (swz % 64) / 2; }
__host__ __device__ __forceinline__ int perm32(int rho) { const int n = rho >> 4, i = rho & 15; return 8 * (i >> 2) + 4 * n + (i & 3); }

struct Unit { int pm, pn; const char* pA; const char* pB; const char* pB2; const int* lst; int nv; int aux; };

struct StaticOrder {
    int nM, nN, nwg, G, c;
    __device__ void init(int M, int N, int G_, int c_) { nM = M / BM; nN = N / BM; nwg = nM * nN; G = G_; c = c_; }
    __device__ bool next(int i, int& pm, int& pn) const {
        const long L = (long)i * G + c; if (L >= nwg) return false;
        int wgid = (int)L; { const int q = nwg / NXCD, r = nwg % NXCD, xcd = wgid % NXCD, off = wgid / NXCD; wgid = (xcd < r ? xcd * (q + 1) : r * (q + 1) + (xcd - r) * q) + off; }
        const int nig = WGM * nN, gid = wgid / nig, fm = gid * WGM, gsz = (nM - fm) < WGM ? (nM - fm) : WGM;
        pm = fm + ((wgid % nig) % gsz); pn = (wgid % nig) / gsz; return true;
    }
};
struct DenseSched {
    StaticOrder so; const char* A; const char* B; size_t tA, tB;
    __device__ void init(const void* A_, const void* B_, int M, int N, int lda, int ldb, int G, int c) { so.init(M, N, G, c); A = (const char*)A_; B = (const char*)B_; tA = (size_t)BM * lda * 2; tB = (size_t)BM * ldb * 2; }
    __device__ __forceinline__ bool next(int i, Unit& u) const {
        int pm, pn; if (!so.next(i, pm, pn)) return false;
        u.pm = pm; u.pn = pn; u.pA = A + (size_t)pm * tA; u.pB = B + (size_t)pn * tB; u.pB2 = u.pB; u.lst = nullptr; u.nv = BM; u.aux = 0; return true;
    }
};

typedef __bf16 bf16x2_t __attribute__((ext_vector_type(2)));
__device__ __forceinline__ unsigned cvt_pk_bf16(float lo, float hi) { const f32x2 v = {lo, hi}; const bf16x2_t b = __builtin_convertvector(v, bf16x2_t); return __builtin_bit_cast(unsigned, b); }

template <class Epi, class Sched, bool GATHER, bool SPLITB>
__device__ __forceinline__ void gemm_phase(LAS unsigned char* lds, const int K, const int lda, const int ldb, const Sched& S, const Epi& E) {
    int tid = threadIdx.x; asm volatile("" : "+v"(tid));
    const int wid = __builtin_amdgcn_readfirstlane(tid >> 6), lane = tid & 63, wr = wid >> 2, wc = wid & 3, fr = lane & 15, fq = lane >> 4;
    int nt = K / BK; asm volatile("" : "+s"(nt));
    const int ntB = nt >> 1;
    unsigned voffA[2], voffB[2];
#pragma unroll
    for (int i = 0; i < 2; ++i) { int R, C; stage_rc(tid * 16 + i * 8192, R, C); const int Rb = (R & ~31) + perm32(R & 31); voffA[i] = (unsigned)(R * lda + C) * 2u; voffB[i] = (unsigned)(Rb * ldb + C) * 2u; }
    const size_t kstep = (size_t)(BK * 2);
    const size_t hstepB = (size_t)HALF * ldb * 2;
    const size_t hstepA = (size_t)HALF * lda * 2;
    const unsigned ldsw = (unsigned)wid * 1024u;
    const int aoff = lds_byte(wr * 64 + fr, fq * 8), boff = lds_byte(wc * 32 + fr, fq * 8);
#define PG8_SA(b, h) (((b) * 2 + (h)) * HTB)
#define PG8_SB(b, h) ((4 + (b) * 2 + (h)) * HTB)
#define PG8_STAGE(bufoff, gbase, voff) do { _Pragma("unroll") for (int _i = 0; _i < 2; ++_i) \
        __builtin_amdgcn_global_load_lds((const unsigned*)((const char*)(gbase) + (voff)[_i]), (LAS unsigned*)(lds + (bufoff) + ldsw + _i * 8192), 16, 0, 0); } while (0)
#define PG8_LDA(dst, b, h) do { _Pragma("unroll") for (int m = 0; m < 4; ++m) _Pragma("unroll") for (int k = 0; k < 2; ++k) dst[m][k] = *(const LAS bf16x8*)(lds + PG8_SA(b, h) + aoff + m * 2048 + k * 1024); } while (0)
#define PG8_LDB(dst, b, h) do { _Pragma("unroll") for (int n = 0; n < 2; ++n) _Pragma("unroll") for (int k = 0; k < 2; ++k) dst[n][k] = *(const LAS bf16x8*)(lds + PG8_SB(b, h) + boff + n * 2048 + k * 1024); } while (0)
#define PG8_MMA(ai, bj, At, Bt) do { __builtin_amdgcn_s_setprio(1); _Pragma("unroll") for (int m = 0; m < 4; ++m) _Pragma("unroll") for (int n = 0; n < 2; ++n) _Pragma("unroll") for (int k = 0; k < 2; ++k) \
        acc[ai][bj][m][n] = __builtin_amdgcn_mfma_f32_16x16x32_bf16(Bt[n][k], At[m][k], acc[ai][bj][m][n], 0, 0, 0); __builtin_amdgcn_s_setprio(0); } while (0)
#define PG8_WAIT_V(n) asm volatile("s_waitcnt vmcnt(" #n ")" ::: "memory")
#define PG8_WAIT_L(n) asm volatile("s_waitcnt lgkmcnt(" #n ")" ::: "memory")
#define PG8_BAR __builtin_amdgcn_s_barrier()
#define PG8_SCHED __builtin_amdgcn_sched_barrier(0)
#define PG8_GOFF(G, u) do { if constexpr (GATHER) { _Pragma("unroll") for (int _h = 0; _h < 2; ++_h) _Pragma("unroll") for (int _i = 0; _i < 2; ++_i) { \
        int _R, _C; stage_rc(tid * 16 + _i * 8192, _R, _C); int _ix = _h * HALF + _R; _ix = _ix < (u).nv ? _ix : (u).nv - 1; const int _tok = (u).lst[_ix]; G[_h][_i] = (unsigned)_tok * (unsigned)(lda * 2) + (unsigned)(_C * 2); } } } while (0)
#define PG8_STAGE_A(bufoff, gbase, half, G) do { if constexpr (GATHER) { PG8_STAGE(bufoff, gbase, G[half]); } else { PG8_STAGE(bufoff, (gbase) + (half) * hstepA, voffA); } } while (0)
#define PG8_BPTR(u, tt) ((SPLITB && (tt) >= ntB) ? (u).pB2 + (size_t)((tt) - ntB) * kstep : (u).pB + (size_t)(tt) * kstep)
    Unit cur; int ui = 0;
    if (!S.next(0, cur)) return;
    f32x4 acc[2][2][4][2];
#pragma unroll
    for (int a = 0; a < 2; ++a)
#pragma unroll
        for (int b = 0; b < 2; ++b)
#pragma unroll
            for (int m = 0; m < 4; ++m)
#pragma unroll
                for (int n = 0; n < 2; ++n) acc[a][b][m][n] = (f32x4){0.f, 0.f, 0.f, 0.f};
    bf16x8 At[4][2], B0[2][2], B1[2][2];
    unsigned cG[2][2];
    LAS u32x4* gstash = (LAS u32x4*)(lds + 135168) + tid;
    PG8_GOFF(cG, cur);
    const char* cA = cur.pA; const char* cB = cur.pB;
    PG8_STAGE(PG8_SB(0, 0), cB, voffB); PG8_STAGE(PG8_SB(0, 1), cB + hstepB, voffB); PG8_STAGE_A(PG8_SA(0, 0), cA, 0, cG); PG8_STAGE_A(PG8_SA(0, 1), cA, 1, cG);
    if (wr == 1) PG8_BAR;
    PG8_WAIT_V(2); PG8_BAR;
    PG8_STAGE(PG8_SB(1, 0), cB + kstep, voffB); PG8_STAGE_A(PG8_SA(1, 0), cA + kstep, 0, cG); PG8_STAGE(PG8_SB(1, 1), cB + hstepB + kstep, voffB);
    PG8_WAIT_V(6); PG8_BAR;
    for (;;) {
        Unit nxt; const bool has_next = S.next(ui + 1, nxt);
        if constexpr (GATHER) { unsigned nG[2][2];
            if (has_next) { PG8_GOFF(nG, nxt); } else {
#pragma unroll
            for (int h = 0; h < 2; ++h)
#pragma unroll
                for (int i = 0; i < 2; ++i) nG[h][i] = cG[h][i]; }
            *gstash = (u32x4){nG[0][0], nG[0][1], nG[1][0], nG[1][1]}; }
        const char* nA = has_next ? nxt.pA : cA; const char* nB = has_next ? nxt.pB : cB;
        for (int t = 0; t < nt; t += 2) {
            const bool last = (t == nt - 2);
            const char* a1 = cA + (size_t)(t + 1) * kstep;
            const char* a2 = last ? nA : cA + (size_t)(t + 2) * kstep; const char* a3 = a2 + kstep;
            const char* b2 = last ? nB : PG8_BPTR(cur, t + 2); const char* b3 = b2 + kstep;
            unsigned g2[2][2];
            if constexpr (GATHER) {
                if (last) { const u32x4 st = *gstash; g2[0][0] = st.x; g2[0][1] = st.y; g2[1][0] = st.z; g2[1][1] = st.w; }
                else {
#pragma unroll
                for (int h = 0; h < 2; ++h)
#pragma unroll
                    for (int i = 0; i < 2; ++i) g2[h][i] = cG[h][i]; } }
            PG8_LDB(B0, 0, 0); PG8_LDB(B1, 0, 1); PG8_SCHED; PG8_LDA(At, 0, 0); PG8_STAGE_A(PG8_SA(1, 1), a1, 1, cG);
            PG8_WAIT_V(8); PG8_WAIT_L(0); PG8_BAR; PG8_MMA(0, 0, At, B0); PG8_MMA(0, 1, At, B1); PG8_BAR; PG8_SCHED;
            PG8_LDA(At, 0, 1); PG8_STAGE(PG8_SB(0, 0), b2, voffB); PG8_STAGE(PG8_SB(0, 1), b2 + hstepB, voffB); PG8_STAGE_A(PG8_SA(0, 0), a2, 0, g2);
            PG8_WAIT_V(8); PG8_WAIT_L(0); PG8_BAR; PG8_MMA(1, 0, At, B0); PG8_MMA(1, 1, At, B1); PG8_BAR; PG8_SCHED;
            PG8_LDB(B0, 1, 0); PG8_LDB(B1, 1, 1); PG8_SCHED; PG8_LDA(At, 1, 0); PG8_STAGE_A(PG8_SA(0, 1), a2, 1, g2);
            PG8_WAIT_V(8); PG8_WAIT_L(0); PG8_BAR; PG8_MMA(0, 0, At, B0); PG8_MMA(0, 1, At, B1); PG8_BAR; PG8_SCHED;
            PG8_LDA(At, 1, 1); PG8_STAGE(PG8_SB(1, 0), b3, voffB); PG8_STAGE(PG8_SB(1, 1), b3 + hstepB, voffB); PG8_STAGE_A(PG8_SA(1, 0), a3, 0, g2);
            PG8_WAIT_V(8); PG8_WAIT_L(0); PG8_BAR; PG8_MMA(1, 0, At, B0); PG8_MMA(1, 1, At, B1); PG8_BAR; PG8_SCHED;
        }
        if (wr == 0) PG8_BAR;
        E(acc, cur, wr, wc, fr, fq);
        if (!has_next) break;
#pragma unroll
        for (int a = 0; a < 2; ++a)
#pragma unroll
            for (int b = 0; b < 2; ++b)
#pragma unroll
                for (int m = 0; m < 4; ++m)
#pragma unroll
                    for (int n = 0; n < 2; ++n) acc[a][b][m][n] = (f32x4){0.f, 0.f, 0.f, 0.f};
        ++ui; (void)S.next(ui, cur); cA = nA; cB = nB;
        if constexpr (GATHER) { const u32x4 st = *gstash; cG[0][0] = st.x; cG[0][1] = st.y; cG[1][0] = st.z; cG[1][1] = st.w; }
        if (wr == 1) PG8_BAR;
    }
    PG8_WAIT_V(0);
    PG8_BAR;
#undef PG8_SA
#undef PG8_SB
#undef PG8_STAGE
#undef PG8_LDA
#undef PG8_LDB
#undef PG8_MMA
#undef PG8_WAIT_V
#undef PG8_WAIT_L
#undef PG8_BAR
#undef PG8_SCHED
#undef PG8_GOFF
#undef PG8_STAGE_A
#undef PG8_BPTR
}

typedef const f32x4 (&AccRef)[2][2][4][2];
#define EPI_ROW(u, ai, m) ((u).pm * BM + (ai) * HALF + wr * 64 + (m) * 16 + fr)
#define EPI_COL(u, bj) ((u).pn * BM + (bj) * HALF + wc * 32 + fq * 8)
__device__ __forceinline__ u32x4 pack8(const f32x4& a, const f32x4& b) { u32x4 w; w.x = cvt_pk_bf16(a[0], a[1]); w.y = cvt_pk_bf16(a[2], a[3]); w.z = cvt_pk_bf16(b[0], b[1]); w.w = cvt_pk_bf16(b[2], b[3]); return w; }
__device__ __forceinline__ float sq8(const f32x4& a, const f32x4& b) { return (a[0] * a[0] + a[1] * a[1]) + (a[2] * a[2] + a[3] * a[3]) + (b[0] * b[0] + b[1] * b[1]) + (b[2] * b[2] + b[3] * b[3]); }
__device__ __forceinline__ void unpack8(const u32x4& w, f32x4& a, f32x4& b) { a = (f32x4){bflo(w.x), bfhi(w.x), bflo(w.y), bfhi(w.y)}; b = (f32x4){bflo(w.z), bfhi(w.z), bflo(w.w), bfhi(w.w)}; }

struct EpiBf16 {
    bf16_t* O; int ldc;
    __device__ __forceinline__ void operator()(AccRef acc, const Unit& u, int wr, int wc, int fr, int fq) const {
#pragma unroll
        for (int ai = 0; ai < 2; ++ai)
#pragma unroll
            for (int m = 0; m < 4; ++m) { bf16_t* rowp = O + (size_t)EPI_ROW(u, ai, m) * ldc;
#pragma unroll
                for (int bj = 0; bj < 2; ++bj) *(u32x4*)(rowp + EPI_COL(u, bj)) = pack8(acc[ai][bj][m][0], acc[ai][bj][m][1]); }
    }
};
struct EpiInAb {
    bf16_t* Z;
    __device__ __forceinline__ void operator()(AccRef acc, const Unit& u, int wr, int wc, int fr, int fq) const {
        if (u.pn >= 10) {
#pragma unroll
            for (int ai = 0; ai < 2; ++ai)
#pragma unroll
                for (int m = 0; m < 4; ++m) { bf16_t* rowp = Z + (size_t)EPI_ROW(u, ai, m) * ZW;
                    const f32x4 a = acc[ai][0][m][0] * acc[ai][1][m][0], b = acc[ai][0][m][1] * acc[ai][1][m][1];
                    *(u32x4*)(rowp + 2560 + (u.pn - 10) * HALF + wc * 32 + fq * 8) = pack8(a, b); }
        } else if (u.pn < 2) {
#pragma unroll
            for (int ai = 0; ai < 2; ++ai)
#pragma unroll
                for (int m = 0; m < 4; ++m) { bf16_t* rowp = Z + (size_t)EPI_ROW(u, ai, m) * ZW;
#pragma unroll
                    for (int bj = 0; bj < 2; ++bj) { f32x4 a = acc[ai][bj][m][0], b = acc[ai][bj][m][1];
#pragma unroll
                        for (int j = 0; j < 4; ++j) { a[j] = siluf_(a[j]); b[j] = siluf_(b[j]); }
                        *(u32x4*)(rowp + EPI_COL(u, bj)) = pack8(a, b); }
                    asm volatile("" ::: "memory"); }
        } else {
#pragma unroll
            for (int ai = 0; ai < 2; ++ai)
#pragma unroll
                for (int m = 0; m < 4; ++m) { bf16_t* rowp = Z + (size_t)EPI_ROW(u, ai, m) * ZW;
#pragma unroll
                    for (int bj = 0; bj < 2; ++bj) *(u32x4*)(rowp + EPI_COL(u, bj)) = pack8(acc[ai][bj][m][0], acc[ai][bj][m][1]); }
        }
    }
};
struct EpiRes {
    const float* X; float* O; const float* bias; bf16_t* HB;
    __device__ __forceinline__ void operator()(AccRef acc, const Unit& u, int wr, int wc, int fr, int fq) const {
#pragma unroll
        for (int ai = 0; ai < 2; ++ai)
#pragma unroll
            for (int m = 0; m < 4; ++m) { const size_t ro = (size_t)EPI_ROW(u, ai, m) * D;
#pragma unroll
                for (int bj = 0; bj < 2; ++bj) { const int c = EPI_COL(u, bj);
                    f32x4 x0 = *(const f32x4*)(X + ro + c), x1 = *(const f32x4*)(X + ro + c + 4);
                    if (bias) { x0 += *(const f32x4*)(bias + c); x1 += *(const f32x4*)(bias + c + 4); }
                    const f32x4 h0 = x0 + acc[ai][bj][m][0], h1 = x1 + acc[ai][bj][m][1];
                    *(f32x4*)(O + ro + c) = h0; *(f32x4*)(O + ro + c + 4) = h1; *(u32x4*)(HB + ro + c) = pack8(h0, h1); }
                asm volatile("" ::: "memory"); }
    }
};
__device__ __forceinline__ float rstd16(const float* ss, int row) {
    const f32x4* p = (const f32x4*)(ss + (size_t)row * 16); const f32x4 a = p[0], b = p[1], c = p[2], d = p[3];
    const float s = ((a[0] + a[1]) + (a[2] + a[3])) + ((b[0] + b[1]) + (b[2] + b[3])) + ((c[0] + c[1]) + (c[2] + c[3])) + ((d[0] + d[1]) + (d[2] + d[3]));
    return __builtin_amdgcn_rsqf(s * (1.f / D) + EPS);
}
struct EpiQkv {
    bf16_t* O; const float* bias; const float* ss;
    __device__ __forceinline__ void operator()(AccRef acc, const Unit& u, int wr, int wc, int fr, int fq) const {
#pragma unroll
        for (int ai = 0; ai < 2; ++ai)
#pragma unroll
            for (int m = 0; m < 4; ++m) { const int row = EPI_ROW(u, ai, m); const float rs = rstd16(ss, row); bf16_t* rowp = O + (size_t)row * CIN;
#pragma unroll
                for (int bj = 0; bj < 2; ++bj) { const int c = EPI_COL(u, bj);
                    const f32x4 a = acc[ai][bj][m][0] * rs + *(const f32x4*)(bias + c), b = acc[ai][bj][m][1] * rs + *(const f32x4*)(bias + c + 4);
                    *(u32x4*)(rowp + c) = pack8(a, b); }
                asm volatile("" ::: "memory"); }
    }
};
struct EpiG1 {
    bf16_t* HID; const f32x2* wl; const float* rl;
    __device__ __forceinline__ void operator()(AccRef acc, const Unit& u, int wr, int wc, int fr, int fq) const {
#pragma unroll
        for (int ai = 0; ai < 2; ++ai)
#pragma unroll
            for (int m = 0; m < 4; ++m) { const int rit = ai * HALF + wr * 64 + m * 16 + fr;
                const f32x2 w2 = wl[(size_t)u.aux + rit]; const float w = (u.pn < 4) ? w2.x : w2.y, rs = rl[(size_t)u.aux + rit], wrs = w * rs;
                bf16_t* rowp = HID + (size_t)(u.pm * BM + rit) * 1024 + (u.pn >> 2) * 512 + (u.pn & 3) * HALF + wc * 32 + fq * 8;
                f32x4 a, b;
#pragma unroll
                for (int j = 0; j < 4; ++j) { a[j] = siluf_(acc[ai][0][m][0][j] * rs) * acc[ai][1][m][0][j] * wrs; b[j] = siluf_(acc[ai][0][m][1][j] * rs) * acc[ai][1][m][1][j] * wrs; }
                *(u32x4*)rowp = pack8(a, b);
                asm volatile("" ::: "memory"); }
    }
};
struct EpiG2 {
    float* H; bf16_t* HB; float* SS;
    __device__ __forceinline__ void operator()(AccRef acc, const Unit& u, int wr, int wc, int fr, int fq) const {
#pragma unroll
        for (int ai = 0; ai < 2; ++ai)
#pragma unroll
            for (int m = 0; m < 4; ++m) { const int rit = ai * HALF + wr * 64 + m * 16 + fr; const bool ok = rit < u.nv;
                const int tok = u.lst[ok ? rit : 0]; float part = 0.f;
                if (ok) { const size_t ro = (size_t)tok * D;
#pragma unroll
                    for (int bj = 0; bj < 2; ++bj) { const int c = EPI_COL(u, bj);
                        const f32x4 h0 = *(const f32x4*)(H + ro + c) + acc[ai][bj][m][0], h1 = *(const f32x4*)(H + ro + c + 4) + acc[ai][bj][m][1];
                        *(f32x4*)(H + ro + c) = h0; *(f32x4*)(H + ro + c + 4) = h1; *(u32x4*)(HB + ro + c) = pack8(h0, h1); part += sq8(h0, h1); } }
                part += __shfl_xor(part, 16); part += __shfl_xor(part, 32);
                if (ok && fq == 0) SS[(size_t)tok * 16 + u.pn * 4 + wc] = part;
                asm volatile("" ::: "memory"); }
    }
};
struct EpiPle {
    float* H; bf16_t* HB; const bf16_t* PP; const float* ssi; float* sso;
    __device__ __forceinline__ void operator()(AccRef acc, const Unit& u, int wr, int wc, int fr, int fq) const {
#pragma unroll
        for (int ai = 0; ai < 2; ++ai)
#pragma unroll
            for (int m = 0; m < 4; ++m) { const int row = EPI_ROW(u, ai, m); const float rs = rstd16(ssi, row); const size_t ro = (size_t)row * D; float part = 0.f;
#pragma unroll
                for (int bj = 0; bj < 2; ++bj) { const int c = EPI_COL(u, bj);
                    f32x4 p0, p1; unpack8(*(const u32x4*)(PP + ro + c), p0, p1);
                    f32x4 h0 = *(const f32x4*)(H + ro + c), h1 = *(const f32x4*)(H + ro + c + 4);
#pragma unroll
                    for (int j = 0; j < 4; ++j) { h0[j] += sigmoidf_(acc[ai][bj][m][0][j] * rs) * p0[j]; h1[j] += sigmoidf_(acc[ai][bj][m][1][j] * rs) * p1[j]; }
                    *(f32x4*)(H + ro + c) = h0; *(f32x4*)(H + ro + c + 4) = h1; *(u32x4*)(HB + ro + c) = pack8(h0, h1); part += sq8(h0, h1); }
                part += __shfl_xor(part, 16); part += __shfl_xor(part, 32);
                if (fq == 0) sso[(size_t)row * 16 + u.pn * 4 + wc] = part;
                asm volatile("" ::: "memory"); }
    }
};
}

#define XB_TMO      128
#define XB_XCNT(j)  (256  + 64 * (j))
#define XB_XSUB(j)  (1280 + 64 * (j))
#define XB_XGEN(j)  (2304 + 64 * (j))
#define XB_TOP      3328
#define XB_TOPGEN   3392
#define XCD_BAR_WORDS 3456
#define XB_SPIN_CAP (1u << 18)
__device__ __forceinline__ unsigned xb_ld(unsigned* p)              { return __hip_atomic_load(p, __ATOMIC_RELAXED, __HIP_MEMORY_SCOPE_AGENT); }
__device__ __forceinline__ unsigned xb_add(unsigned* p, unsigned v) { return __hip_atomic_fetch_add(p, v, __ATOMIC_RELAXED, __HIP_MEMORY_SCOPE_AGENT); }
__device__ __forceinline__ unsigned xb_xcc_id() { return (unsigned)__builtin_amdgcn_s_getreg((3 << 11) | 20) & 0xFu; }
#define XB_SPIN(cond, bar) do { unsigned _sp = 0; while (cond) { __builtin_amdgcn_s_sleep(1); \
    if ((++_sp & 255u) == 0u) { if (xb_ld(&(bar)[XB_TMO])) break; if (_sp > XB_SPIN_CAP) { atomicAdd(&(bar)[XB_TMO], 1u); break; } } } } while (0)
struct XcdBarrier { unsigned* bar; unsigned x; volatile LAS unsigned* st; };
__device__ __forceinline__ XcdBarrier xcd_barrier_post(unsigned* bar, volatile LAS unsigned* st) {
    XcdBarrier b; b.bar = bar; b.x = xb_xcc_id(); b.st = st;
    if (threadIdx.x == 0) (void)xb_add(&bar[XB_XCNT(b.x)], 1u);
    return b;
}
__device__ __forceinline__ void xcd_barrier_complete(unsigned* bar, unsigned x, unsigned& nloc, unsigned& nx) {
    const unsigned G = gridDim.x * gridDim.y * gridDim.z;
    unsigned sum, cnt, mine, sp = 0u;
    for (;;) {
        sum = 0u; cnt = 0u; mine = 0u;
#pragma unroll
        for (unsigned j = 0; j < 16; ++j) { const unsigned c = xb_ld(&bar[XB_XCNT(j)]); sum += c; cnt += (c > 0u) ? 1u : 0u; mine = (j == x) ? c : mine; }
        if (sum == G) break;
        __builtin_amdgcn_s_sleep(1);
        if ((++sp & 255u) == 0u) { if (xb_ld(&bar[XB_TMO])) break; if (sp > XB_SPIN_CAP) { atomicAdd(&bar[XB_TMO], 1u); break; } }
    }
    nloc = mine > 0u ? mine : 1u; nx = cnt > 0u ? cnt : 1u;
}
__device__ __forceinline__ void xcd_barrier(const XcdBarrier& b) {
    asm volatile("s_waitcnt vmcnt(0)" ::: "memory");
    __syncthreads();
    if (threadIdx.x == 0) {
        unsigned* bar = b.bar;
        __builtin_amdgcn_s_waitcnt(0);
        unsigned nloc = b.st[0], nx = b.st[1];
        if (nloc == 0u) { xcd_barrier_complete(bar, b.x, nloc, nx); b.st[0] = nloc; b.st[1] = nx; }
        const unsigned old = xb_add(&bar[XB_XSUB(b.x)], 1u);
        const unsigned gen = old / nloc;
        if (old + 1u == (gen + 1u) * nloc) {
            __builtin_amdgcn_fence(__ATOMIC_RELEASE, "agent");
            asm volatile("s_waitcnt vmcnt(0)" ::: "memory");
            const unsigned og = xb_add(&bar[XB_TOP], 1u);
            const unsigned tg = og / nx;
            if (og + 1u == (tg + 1u) * nx) xb_add(&bar[XB_TOPGEN], 1u);
            else XB_SPIN(xb_ld(&bar[XB_TOPGEN]) == tg, bar);
            __builtin_amdgcn_fence(__ATOMIC_ACQUIRE, "agent");
            xb_add(&bar[XB_XGEN(b.x)], 1u);
            asm volatile("s_waitcnt vmcnt(0)" ::: "memory");
        } else {
            XB_SPIN(xb_ld(&bar[XB_XGEN(b.x)]) == gen, bar);
            __builtin_amdgcn_fence(__ATOMIC_ACQUIRE, "agent");
            asm volatile("s_waitcnt vmcnt(0)" ::: "memory");
        }
    }
    __syncthreads();
}

struct Args {
    const float* x; const float* p; const float* norm_mix; const float* norm_ffn; const float* norm_ple; const float* norm_final;
    const float* w_in_ab; const float* lb_logits; const float* hgrn_out_norm; const float* conv_w; const float* w_out_ab;
    const float* w_in_c; const float* b_in_c; const float* sinks; const float* w_out_c; const float* b_out_c;
    const float* w_router; const float* w_gate_e; const float* w_up_e; const float* w_down_e; const float* w_ple_gate; const float* w_ple_proj;
    float* out; unsigned char* ws; int ph_lo, ph_hi;
};
struct Frame { LAS unsigned char* lds; int tid, lane, wave, vcu, G; };

__device__ __forceinline__ void transpose_item(const float* W, int N, int src_n0, int k0, bf16_t* dst  , int ldk, const float* gs, LAS float* scr, int lane) {
#pragma unroll 8
    for (int i = 0; i < 32; ++i) { const int kk = 2 * i + (lane >> 5); scr[kk * 33 + (lane & 31)] = W[(size_t)(k0 + kk) * N + src_n0 + (lane & 31)]; }
    LDS_WAIT(); asm volatile("" ::: "memory");
    const int c = lane & 7;
    float g8[8];
#pragma unroll
    for (int q = 0; q < 8; ++q) g8[q] = gs ? gs[k0 + 8 * c + q] : 1.f;
#pragma unroll
    for (int j = 0; j < 4; ++j) { const int n = (lane >> 3) + 8 * j; const LAS float* s = scr + (8 * c) * 33 + n;
        u32x4 o; o.x = pk2(s[0 * 33] * g8[0], s[1 * 33] * g8[1]); o.y = pk2(s[2 * 33] * g8[2], s[3 * 33] * g8[3]); o.z = pk2(s[4 * 33] * g8[4], s[5 * 33] * g8[5]); o.w = pk2(s[6 * 33] * g8[6], s[7 * 33] * g8[7]);
        *(u32x4*)(dst + (size_t)n * ldk + k0 + 8 * c) = o; }
    LDS_WAIT(); asm volatile("" ::: "memory");
}
__device__ __forceinline__ void phase_prep(const Frame& F, const Args& a) {
    unsigned char* ws = a.ws;
    LAS float* scr = (LAS float*)(F.lds + F.wave * 16384);
    const int gw = F.vcu * NWAVES + F.wave, NGW = F.G * NWAVES;
    constexpr int I_INAB = 16 * (ABIN / 32), I_SQ = 16 * 32, I_INC = 16 * (CIN / 32), I_PP = 4 * 32, I_W1 = 16 * 32, I_W2 = 8 * 32;
    constexpr int T0 = I_INAB, T1 = T0 + I_SQ, T2 = T1 + I_INC, T3 = T2 + I_SQ, T4 = T3 + 2 * I_SQ, T5 = T4 + 2 * I_PP, T6 = T5 + 32 * I_W1, T7 = T6 + 32 * I_W2;
    for (int it = gw; it < T7; it += NGW) {
        if (it < T0) { const int kb = it / (ABIN / 32), nb = it % (ABIN / 32), n0 = nb * 32; int src;
            if (n0 < 2560) src = n0; else { const int q = (n0 - 2560) >> 8, r = (n0 - 2560) & 255; src = (r < 128) ? 2560 + q * 128 + r : 3072 + q * 128 + (r - 128); }
            transpose_item(a.w_in_ab, ABIN, src, kb * 64, (bf16_t*)(ws + WS_WINAB) + (size_t)n0 * D, D, a.norm_mix, scr, F.lane); }
        else if (it < T1) { const int r = it - T0, kb = r / 32, nb = r % 32; transpose_item(a.w_out_ab, D, nb * 32, kb * 64, (bf16_t*)(ws + WS_WOUTAB) + (size_t)nb * 32 * D, D, nullptr, scr, F.lane); }
        else if (it < T2) { const int r = it - T1, kb = r / (CIN / 32), nb = r % (CIN / 32); transpose_item(a.w_in_c, CIN, nb * 32, kb * 64, (bf16_t*)(ws + WS_WINC) + (size_t)nb * 32 * D, D, a.norm_mix + D, scr, F.lane); }
        else if (it < T3) { const int r = it - T2, kb = r / 32, nb = r % 32; transpose_item(a.w_out_c, D, nb * 32, kb * 64, (bf16_t*)(ws + WS_WOUTC) + (size_t)nb * 32 * D, D, nullptr, scr, F.lane); }
        else if (it < T4) { const int r = it - T3, l = r / I_SQ, q = r % I_SQ, kb = q / 32, nb = q % 32;
            transpose_item(a.w_ple_gate + (size_t)l * D * D, D, nb * 32, kb * 64, (bf16_t*)(ws + WS_WPG) + (size_t)l * D * D + (size_t)nb * 32 * D, D, a.norm_ple + l * D, scr, F.lane); }
        else if (it < T5) { const int r = it - T4, l = r / I_PP, q = r % I_PP, kb = q / 32, nb = q % 32;
            transpose_item(a.w_ple_proj + (size_t)l * PLE * D, D, nb * 32, kb * 64, (bf16_t*)(ws + WS_WPP) + (size_t)l * D * PLE + (size_t)nb * 32 * PLE, PLE, nullptr, scr, F.lane); }
        else if (it < T6) { const int r = it - T5, le = r / I_W1, q = r % I_W1, kb = q / 32, nb = q % 32, n0 = nb * 32, uq = n0 >> 8, rr = n0 & 255;
            const float* src = (rr < 128) ? a.w_gate_e + (size_t)le * D * DE : a.w_up_e + (size_t)le * D * DE; const int sn = uq * 128 + (rr & 127);
            transpose_item(src, DE, sn, kb * 64, (bf16_t*)(ws + WS_W1) + (size_t)le * D * D + (size_t)n0 * D, D, a.norm_ffn + (le >> 4) * D, scr, F.lane); }
        else { const int r = it - T6, le = r / I_W2, q = r % I_W2, kb = q / 32, nb = q % 32;
            transpose_item(a.w_down_e + (size_t)le * DE * D, D, nb * 32, kb * 64, (bf16_t*)(ws + WS_W2) + (size_t)le * D * DE + (size_t)nb * 32 * DE, DE, nullptr, scr, F.lane); }
    }
    const int gt = F.vcu * NTHR + F.tid, NGT = F.G * NTHR;
    if (gt < AW) { const float l0 = a.lb_logits[gt], l1 = a.lb_logits[AW + gt], l2 = a.lb_logits[2 * AW + gt]; const float mx = fmaxf(l0, fmaxf(l1, l2));
        const float e0 = __expf(l0 - mx), e1 = __expf(l1 - mx), e2 = __expf(l2 - mx); ((float*)(ws + WS_LB))[gt] = e0 / (e0 + e1 + e2); }
    { const f32x4* src = (const f32x4*)a.p; u32x4* dst = (u32x4*)(ws + WS_PB); const int n8 = 2 * NT * PLE / 8;
        for (int i = gt; i < n8; i += NGT) { const f32x4 v0 = src[2 * i], v1 = src[2 * i + 1]; u32x4 o; o.x = pk2(v0[0], v0[1]); o.y = pk2(v0[2], v0[3]); o.z = pk2(v1[0], v1[1]); o.w = pk2(v1[2], v1[3]); dst[i] = o; } }
    for (int m = gw; m < NT; m += NGW) { const f32x4* xr = (const f32x4*)(a.x + (size_t)m * D) + F.lane; f32x4 v[4]; float s = 0.f;
#pragma unroll
        for (int j = 0; j < 4; ++j) { v[j] = xr[64 * j]; s += (v[j][0] * v[j][0] + v[j][1] * v[j][1]) + (v[j][2] * v[j][2] + v[j][3] * v[j][3]); }
        const float rs = __builtin_amdgcn_rsqf(wave_sum(s) * (1.f / D) + EPS);
        u32x2* o8 = (u32x2*)((bf16_t*)(ws + WS_XA) + (size_t)m * D) + F.lane;
#pragma unroll
        for (int j = 0; j < 4; ++j) { u32x2 o; o.x = pk2(v[j][0] * rs, v[j][1] * rs); o.y = pk2(v[j][2] * rs, v[j][3] * rs); o8[64 * j] = o; } }
}

__device__ __forceinline__ void phase_hgrn_conv(const Frame& F, const Args& a) {
    unsigned char* ws = a.ws; const bf16_t* Z = (const bf16_t*)(ws + WS_Z); bf16_t* XA = (bf16_t*)(ws + WS_XA); const float* lbv = (const float*)(ws + WS_LB);
    LAS float* FG = (LAS float*)F.lds; LAS float* KK = FG + 4096; LAS float* QQ = KK + 4096; LAS float* VV = QQ + 4096; LAS float* OB = VV + 4096;
    const int tid = F.tid, lane = F.lane, w = F.wave;
    for (int it = F.vcu; it < NB * AH; it += F.G) {
        const int b = it >> 2, h = it & 3; const size_t row0 = (size_t)b * SEQ;
        const int vi = lane & 15, dq = lane >> 4, v = 16 * w + vi;
        float s[32];
#pragma unroll
        for (int i = 0; i < 32; ++i) s[i] = 0.f;
        const int ltt = tid >> 4, ldd = (tid & 15) * 8;
        float lb8[8], gn8[8];
#pragma unroll
        for (int j = 0; j < 8; ++j) { lb8[j] = lbv[h * ADK + ldd + j]; gn8[j] = a.hgrn_out_norm[ldd + j]; }
        for (int c = 0; c < SEQ / 32; ++c) {
            { const bf16_t* zr = Z + (row0 + c * 32 + ltt) * ZW + h * ADK + ldd;
                const u32x4 wq = *(const u32x4*)zr, wf = *(const u32x4*)(zr + 512), wv = *(const u32x4*)(zr + 1024);
                f32x4 q0, q1, f0, f1, v0, v1; pg8::unpack8(wq, q0, q1); pg8::unpack8(wf, f0, f1); pg8::unpack8(wv, v0, v1);
                f32x4 g0, g1, k0, k1;
#pragma unroll
                for (int j = 0; j < 4; ++j) { g0[j] = lb8[j] + (1.f - lb8[j]) * sigmoidf_(f0[j]); g1[j] = lb8[4 + j] + (1.f - lb8[4 + j]) * sigmoidf_(f1[j]); k0[j] = 1.f - g0[j]; k1[j] = 1.f - g1[j]; }
                const int o = ltt * 128 + ldd;
                *(LAS f32x4*)(FG + o) = g0; *(LAS f32x4*)(FG + o + 4) = g1; *(LAS f32x4*)(KK + o) = k0; *(LAS f32x4*)(KK + o + 4) = k1;
                *(LAS f32x4*)(QQ + o) = q0; *(LAS f32x4*)(QQ + o + 4) = q1; *(LAS f32x4*)(VV + o) = v0; *(LAS f32x4*)(VV + o + 4) = v1; }
            __syncthreads();
            for (int tt = 0; tt < 32; ++tt) {
                const float vt = VV[tt * 128 + v]; float acc = 0.f;
                const LAS f32x4* fg = (const LAS f32x4*)(FG + tt * 128 + dq * 32); const LAS f32x4* kk = (const LAS f32x4*)(KK + tt * 128 + dq * 32); const LAS f32x4* qq = (const LAS f32x4*)(QQ + tt * 128 + dq * 32);
#pragma unroll
                for (int d4 = 0; d4 < 8; ++d4) { const f32x4 f4 = fg[d4], k4 = kk[d4], q4 = qq[d4];
#pragma unroll
                    for (int j = 0; j < 4; ++j) { s[d4 * 4 + j] = f4[j] * s[d4 * 4 + j] + k4[j] * vt; acc += s[d4 * 4 + j] * q4[j]; } }
                acc += __shfl_xor(acc, 16); acc += __shfl_xor(acc, 32);
                if (dq == 0) OB[tt * 128 + v] = acc;
            }
            __syncthreads();
            { const f32x4 o0 = *(const LAS f32x4*)(OB + ltt * 128 + ldd), o1 = *(const LAS f32x4*)(OB + ltt * 128 + ldd + 4);
                float ss = pg8::sq8(o0, o1); ss += __shfl_xor(ss, 1); ss += __shfl_xor(ss, 2); ss += __shfl_xor(ss, 4); ss += __shfl_xor(ss, 8);
                const float rs = __builtin_amdgcn_rsqf(ss * (1.f / 128.f) + EPS);
                const size_t row = row0 + c * 32 + ltt; f32x4 g0, g1; pg8::unpack8(*(const u32x4*)(Z + row * ZW + 1536 + h * ADK + ldd), g0, g1);
                f32x4 r0, r1;
#pragma unroll
                for (int j = 0; j < 4; ++j) { r0[j] = o0[j] * rs * gn8[j] * sigmoidf_(g0[j]); r1[j] = o1[j] * rs * gn8[4 + j] * sigmoidf_(g1[j]); }
                u32x4 o; o.x = pk2(r0[0], r0[1]); o.y = pk2(r0[2], r0[3]); o.z = pk2(r1[0], r1[1]); o.w = pk2(r1[2], r1[3]);
                *(u32x4*)(XA + row * D + h * ADK + ldd) = o; }
        }
        __syncthreads();
    }
}

typedef short s16x4 __attribute__((ext_vector_type(4)));
constexpr int SEGT = 512, NSEG = SEQ / SEGT, NCH = SEGT / 32;
constexpr int HROW = 272, HL_TS = 32 * HROW;
constexpr int HL_LF = 0, HL_T = 16384, HL_DEC = 18432, HL_SUM = 18944, HL_QD = 20480, HL_KI = HL_QD + HL_TS, HL_KT = HL_KI + HL_TS, HL_VV = HL_KT + HL_TS, HL_OB = HL_VV + HL_TS;
__device__ __forceinline__ s16x4 lds_tr(const LAS unsigned char* p) { return __builtin_bit_cast(s16x4, __builtin_amdgcn_ds_read_tr16_b64_v4i16((LAS s16x4*)p)); }
__device__ __forceinline__ bf16x8 cat44(s16x4 a, s16x4 b) { return (bf16x8){a[0], a[1], a[2], a[3], b[0], b[1], b[2], b[3]}; }
__device__ __forceinline__ bf16x8 pk8(const f32x4& a, const f32x4& b) { return __builtin_bit_cast(bf16x8, pg8::pack8(a, b)); }
#define MFMA16(A, B, C) __builtin_amdgcn_mfma_f32_16x16x32_bf16(A, B, C, 0, 0, 0)
#ifndef HGRN_SELF
#define HGRN_SELF 0
#endif
#ifndef HGRN_CHECK
#define HGRN_CHECK 0
#endif
template <bool FULL>
__device__ __forceinline__ void hgrn_pass(const Frame& F, const Args& a) {
    unsigned char* ws = a.ws; const bf16_t* Z = (const bf16_t*)(ws + WS_Z); bf16_t* XA = (bf16_t*)(ws + WS_XA); const float* lbv = (const float*)(ws + WS_LB);
    float* HLg = (float*)(ws + WS_HL); float* HSg = (float*)(ws + WS_HSUM);
    LAS unsigned char* L = F.lds;
    LAS float* LF = (LAS float*)(L + HL_LF); LAS float* TT = (LAS float*)(L + HL_T); LAS float* DEC = (LAS float*)(L + HL_DEC); LAS float* SUM = (LAS float*)(L + HL_SUM); LAS float* OB = (LAS float*)(L + HL_OB);
    const LAS unsigned char* QD = L + HL_QD; const LAS unsigned char* KI = L + HL_KI; const LAS unsigned char* KT = L + HL_KT; const LAS unsigned char* VV = L + HL_VV;
    const int tid = F.tid, lane = F.lane, w = F.wave, r15 = lane & 15, g = lane >> 4, trq = r15 >> 2, trp = r15 & 3;
    const int tok = tid >> 4, d0 = (tid & 15) * 8, sd = tid & 127, tq = tid >> 7, Vw0 = 16 * w;
    for (int it = F.vcu; it < NB * AH * NSEG; it += F.G) {
        const int seg = it & (NSEG - 1), h = (it >> 3) & 3, b = it >> 5;
        if (!FULL && seg == NSEG - 1) continue;
        const size_t row0 = (size_t)b * SEQ + (size_t)seg * SEGT;
        float lb8[8], gn8[8];
#pragma unroll
        for (int e = 0; e < 8; ++e) { lb8[e] = lbv[h * ADK + d0 + e]; gn8[e] = a.hgrn_out_norm[d0 + e]; }
        f32x4 S[8];
#pragma unroll
        for (int mt = 0; mt < 8; ++mt) S[mt] = (f32x4){0.f, 0.f, 0.f, 0.f};
        const int pre = (FULL && (HGRN_SELF || HGRN_CHECK)) ? seg * NCH : 0;
        float chkbad = 0.f;
        if (FULL && seg > 0 && !HGRN_SELF) {
            const __amdgpu_buffer_rsrc_t rsL = __builtin_amdgcn_make_buffer_rsrc((void*)HLg, (short)0, 256 * 16384 * 4, 0x00020000);
            const __amdgpu_buffer_rsrc_t rsS = __builtin_amdgcn_make_buffer_rsrc((void*)HSg, (short)0, 256 * 128 * 4, 0x00020000);
            f32x4 cum[8];
#pragma unroll
            for (int mt = 0; mt < 8; ++mt) cum[mt] = (f32x4){0.f, 0.f, 0.f, 0.f};
            for (int sp = seg - 1; sp >= 0; --sp) { const int ip = it - seg + sp; const int lo = (ip * 16384 + (Vw0 + r15) * 128 + 4 * g) * 4, so = (ip * 128 + 4 * g) * 4;
#pragma unroll
                for (int mt = 0; mt < 8; ++mt) { const f32x4 l4 = __builtin_bit_cast(f32x4, __builtin_amdgcn_raw_buffer_load_b128(rsL, lo + mt * 64, 0, 16)), h4 = __builtin_bit_cast(f32x4, __builtin_amdgcn_raw_buffer_load_b128(rsS, so + mt * 64, 0, 16));
#pragma unroll
                    for (int r = 0; r < 4; ++r) { S[mt][r] += __expf(cum[mt][r]) * l4[r]; cum[mt][r] += h4[r]; } } }
        }
        if (FULL && HGRN_CHECK) { LAS f32x4* SA = (LAS f32x4*)(L + 73728) + tid * 4;
#pragma unroll
            for (int mt = 0; mt < 4; ++mt) { SA[mt] = S[mt]; }
#pragma unroll
            for (int mt = 0; mt < 8; ++mt) S[mt] = (f32x4){0.f, 0.f, 0.f, 0.f}; }
        if (tid < 128) SUM[tid] = 0.f;
        const bf16_t* zr = Z + (row0 - (size_t)pre * 32 + tok) * ZW + h * ADK + d0;
        u32x4 wq = (u32x4){0u, 0u, 0u, 0u}, wg = wq, wf = *(const u32x4*)(zr + 512), wv = *(const u32x4*)(zr + 1024);
        if (FULL) { wq = *(const u32x4*)zr; wg = *(const u32x4*)(zr + 1536); }
        for (int cc = 0; cc < pre + NCH; ++cc) { const int c = cc - pre; const bool outp = FULL && (c >= 0);
            if (FULL && HGRN_CHECK && c == 0 && seg > 0) { const LAS f32x4* SA = (const LAS f32x4*)(L + 73728) + tid * 4;
#pragma unroll
                for (int mt = 0; mt < 4; ++mt) { const f32x4 sa = SA[mt];
#pragma unroll
                    for (int r = 0; r < 4; ++r) if (!(fabsf(sa[r] - S[mt][r]) <= 1e-3f + 0.02f * fabsf(S[mt][r]))) chkbad = 1.f; } }
            if (FULL && HGRN_CHECK && chkbad != 0.f) { const unsigned long long t0 = __builtin_amdgcn_s_memrealtime(); while (__builtin_amdgcn_s_memrealtime() - t0 < 10000000000ull) __builtin_amdgcn_s_sleep(64); chkbad = 0.f; }
            float kk[8], qq[8];
            { f32x4 f0, f1, q0 = (f32x4){0.f, 0.f, 0.f, 0.f}, q1 = q0; pg8::unpack8(wf, f0, f1); if (FULL) pg8::unpack8(wq, q0, q1);
                f32x4 l0, l1;
#pragma unroll
                for (int e = 0; e < 4; ++e) { const float fa = lb8[e] + (1.f - lb8[e]) * sigmoidf_(f0[e]), fb = lb8[4 + e] + (1.f - lb8[4 + e]) * sigmoidf_(f1[e]);
                    kk[e] = 1.f - fa; kk[4 + e] = 1.f - fb; l0[e] = __logf(fa); l1[e] = __logf(fb); qq[e] = q0[e]; qq[4 + e] = q1[e]; }
                *(LAS f32x4*)(LF + tok * 128 + d0) = l0; *(LAS f32x4*)(LF + tok * 128 + d0 + 4) = l1;
                *(LAS u32x4*)(L + HL_VV + tok * HROW + d0 * 2) = wv; }
            const u32x4 cg = wg;
            if (c + 1 < NCH) { const bf16_t* zn = zr + (size_t)(cc + 1) * 32 * ZW; wf = *(const u32x4*)(zn + 512); wv = *(const u32x4*)(zn + 1024); if (FULL) { wq = *(const u32x4*)zn; wg = *(const u32x4*)(zn + 1536); } }
            __syncthreads();
            { float x[8];
#pragma unroll
                for (int e = 0; e < 8; ++e) x[e] = LF[(8 * tq + e) * 128 + sd];
#pragma unroll
                for (int e = 1; e < 8; ++e) x[e] += x[e - 1];
                TT[tq * 128 + sd] = x[7];
                __syncthreads();
                const float t0 = TT[sd], t1 = TT[128 + sd], t2 = TT[256 + sd];
                const float off = (tq > 0 ? t0 : 0.f) + (tq > 1 ? t1 : 0.f) + (tq > 2 ? t2 : 0.f);
#pragma unroll
                for (int e = 0; e < 8; ++e) LF[(8 * tq + e) * 128 + sd] = x[e] + off; }
            __syncthreads();
            { const f32x4 b0 = *(const LAS f32x4*)(LF + tok * 128 + d0), b1 = *(const LAS f32x4*)(LF + tok * 128 + d0 + 4), e0 = *(const LAS f32x4*)(LF + 31 * 128 + d0), e1 = *(const LAS f32x4*)(LF + 31 * 128 + d0 + 4);
                f32x4 t0, t1, qa, qb, ia, ib;
#pragma unroll
                for (int e = 0; e < 4; ++e) { t0[e] = kk[e] * __expf(e0[e] - b0[e]); t1[e] = kk[4 + e] * __expf(e1[e] - b1[e]);
                    if (FULL) { qa[e] = qq[e] * __expf(b0[e]); qb[e] = qq[4 + e] * __expf(b1[e]); ia[e] = kk[e] * __expf(-b0[e]); ib[e] = kk[4 + e] * __expf(-b1[e]); } }
                *(LAS u32x4*)(L + HL_KT + tok * HROW + d0 * 2) = pg8::pack8(t0, t1);
                if (FULL) { *(LAS u32x4*)(L + HL_QD + tok * HROW + d0 * 2) = pg8::pack8(qa, qb); *(LAS u32x4*)(L + HL_KI + tok * HROW + d0 * 2) = pg8::pack8(ia, ib); }
                if (tok == 31) {
#pragma unroll
                    for (int e = 0; e < 4; ++e) { DEC[d0 + e] = __expf(e0[e]); DEC[d0 + 4 + e] = __expf(e1[e]); if (!FULL) { SUM[d0 + e] += e0[e]; SUM[d0 + 4 + e] += e1[e]; } } } }
            __syncthreads();
            { const bf16x8 bV = cat44(lds_tr(VV + (4 * g + trq) * HROW + (Vw0 + 4 * trp) * 2), lds_tr(VV + (16 + 4 * g + trq) * HROW + (Vw0 + 4 * trp) * 2));
                if (outp) {
                    f32x4 pt00 = (f32x4){0.f, 0.f, 0.f, 0.f}, pt01 = pt00, pt11 = pt00, o0 = pt00, o1 = pt00;
#pragma unroll
                    for (int ks = 0; ks < 4; ++ks) { const int co = (32 * ks + 8 * g) * 2;
                        const bf16x8 aK0 = *(const LAS bf16x8*)(KI + r15 * HROW + co), aK1 = *(const LAS bf16x8*)(KI + (16 + r15) * HROW + co);
                        const bf16x8 bQ0 = *(const LAS bf16x8*)(QD + r15 * HROW + co), bQ1 = *(const LAS bf16x8*)(QD + (16 + r15) * HROW + co);
                        pt00 = MFMA16(aK0, bQ0, pt00); pt01 = MFMA16(aK0, bQ1, pt01); pt11 = MFMA16(aK1, bQ1, pt11); }
#pragma unroll
                    for (int r = 0; r < 4; ++r) if (4 * g + r > r15) { pt00[r] = 0.f; pt11[r] = 0.f; }
                    const bf16x8 pa0 = pk8(pt00, (f32x4){0.f, 0.f, 0.f, 0.f}), pa1 = pk8(pt01, pt11);
#pragma unroll
                    for (int ks = 0; ks < 4; ++ks) { const bf16x8 bS = pk8(S[2 * ks], S[2 * ks + 1]); const int c0 = (32 * ks + 4 * g) * 2;
                        const u32x2 x0 = *(const LAS u32x2*)(QD + r15 * HROW + c0), x1 = *(const LAS u32x2*)(QD + r15 * HROW + c0 + 32), y0 = *(const LAS u32x2*)(QD + (16 + r15) * HROW + c0), y1 = *(const LAS u32x2*)(QD + (16 + r15) * HROW + c0 + 32);
                        const bf16x8 aQ0 = __builtin_bit_cast(bf16x8, (u32x4){x0.x, x0.y, x1.x, x1.y}), aQ1 = __builtin_bit_cast(bf16x8, (u32x4){y0.x, y0.y, y1.x, y1.y});
                        o0 = MFMA16(aQ0, bS, o0); o1 = MFMA16(aQ1, bS, o1); }
                    o0 = MFMA16(pa0, bV, o0); o1 = MFMA16(pa1, bV, o1);
#pragma unroll
                    for (int r = 0; r < 4; ++r) { OB[(4 * g + r) * 128 + Vw0 + r15] = o0[r]; OB[(16 + 4 * g + r) * 128 + Vw0 + r15] = o1[r]; }
                }
#pragma unroll
                for (int mt = 0; mt < 8; ++mt) { const bf16x8 aKT = cat44(lds_tr(KT + (4 * g + trq) * HROW + (16 * mt + 4 * trp) * 2), lds_tr(KT + (16 + 4 * g + trq) * HROW + (16 * mt + 4 * trp) * 2));
                    const f32x4 dec4 = *(const LAS f32x4*)(DEC + 16 * mt + 4 * g);
                    S[mt] = MFMA16(aKT, bV, S[mt] * dec4); } }
            __syncthreads();
            if (outp) { const f32x4 o0 = *(const LAS f32x4*)(OB + tok * 128 + d0), o1 = *(const LAS f32x4*)(OB + tok * 128 + d0 + 4);
                float ss = pg8::sq8(o0, o1); ss += __shfl_xor(ss, 1); ss += __shfl_xor(ss, 2); ss += __shfl_xor(ss, 4); ss += __shfl_xor(ss, 8);
                const float rs = __builtin_amdgcn_rsqf(ss * (1.f / 128.f) + EPS);
                f32x4 g0, g1, r0, r1; pg8::unpack8(cg, g0, g1);
#pragma unroll
                for (int e = 0; e < 4; ++e) { r0[e] = o0[e] * rs * gn8[e] * sigmoidf_(g0[e]) + chkbad; r1[e] = o1[e] * rs * gn8[4 + e] * sigmoidf_(g1[e]); }
                *(u32x4*)(XA + (row0 + (size_t)c * 32 + tok) * D + h * ADK + d0) = pg8::pack8(r0, r1); }
        }
        if (!FULL) {
            const __amdgpu_buffer_rsrc_t rsL = __builtin_amdgcn_make_buffer_rsrc((void*)HLg, (short)0, 256 * 16384 * 4, 0x00020000);
            const __amdgpu_buffer_rsrc_t rsS = __builtin_amdgcn_make_buffer_rsrc((void*)HSg, (short)0, 256 * 128 * 4, 0x00020000);
            const int lo = (it * 16384 + (Vw0 + r15) * 128 + 4 * g) * 4;
#pragma unroll
            for (int mt = 0; mt < 8; ++mt) __builtin_amdgcn_raw_buffer_store_b128(__builtin_bit_cast(u32x4, S[mt]), rsL, lo + mt * 64, 0, 16);
            if (tid < 128) __builtin_amdgcn_raw_buffer_store_b32(__builtin_bit_cast(unsigned, SUM[tid]), rsS, (it * 128 + tid) * 4, 0, 16); }
        __syncthreads();
    }
}
__device__ __forceinline__ void phase_conv(const Frame& F, const Args& a) {
    unsigned char* ws = a.ws; const bf16_t* Z = (const bf16_t*)(ws + WS_Z); bf16_t* XA = (bf16_t*)(ws + WS_XA); const int tid = F.tid;
    const int gt = F.vcu * NTHR + tid, NGT = F.G * NTHR;
    for (int i = gt; i < NT * (512 / 8); i += NGT) {
        const int row = i >> 6, c0 = (i & 63) * 8, t = row & (SEQ - 1);
        const bf16_t* zr = Z + (size_t)row * ZW;
        f32x4 y0a, y0b, y1a = (f32x4){0.f, 0.f, 0.f, 0.f}, y1b = y1a, y2a = y1a, y2b = y1a, ga, gb;
        pg8::unpack8(*(const u32x4*)(zr + 2560 + c0), y0a, y0b); pg8::unpack8(*(const u32x4*)(zr + 2048 + c0), ga, gb);
        if (t >= 1) pg8::unpack8(*(const u32x4*)(zr - ZW + 2560 + c0), y1a, y1b);
        if (t >= 2) pg8::unpack8(*(const u32x4*)(zr - 2 * ZW + 2560 + c0), y2a, y2b);
        const f32x4 w0a = *(const f32x4*)(a.conv_w + c0), w0b = *(const f32x4*)(a.conv_w + c0 + 4), w1a = *(const f32x4*)(a.conv_w + 512 + c0), w1b = *(const f32x4*)(a.conv_w + 512 + c0 + 4),
                    w2a = *(const f32x4*)(a.conv_w + 1024 + c0), w2b = *(const f32x4*)(a.conv_w + 1024 + c0 + 4);
        const f32x4 ra = ga * (w0a * y2a + w1a * y1a + w2a * y0a), rb = gb * (w0b * y2b + w1b * y1b + w2b * y0b);
        u32x4 o; o.x = pk2(ra[0], ra[1]); o.y = pk2(ra[2], ra[3]); o.z = pk2(rb[0], rb[1]); o.w = pk2(rb[2], rb[3]);
        *(u32x4*)(XA + (size_t)row * D + 512 + c0) = o;
    }
}

__device__ __forceinline__ void phase_attn(const Frame& F, const Args& a) {
    const bf16_t* QKV = (const bf16_t*)(a.ws + WS_QKV); bf16_t* XA = (bf16_t*)(a.ws + WS_XA);
    const int gw = F.vcu * NWAVES + F.wave, NGW = F.G * NWAVES, lane = F.lane;
    for (int task = gw; task < NT * NQH; task += NGW) {
        const int m = task >> 4, hq = task & 15, kv = hq >> 3, t = m & (SEQ - 1);
        const bf16_t* qp = QKV + (size_t)m * CIN + hq * HD;
        float q[64];
#pragma unroll
        for (int i = 0; i < 8; ++i) { f32x4 x0, x1; pg8::unpack8(*(const u32x4*)(qp + 8 * i), x0, x1);
#pragma unroll
            for (int j = 0; j < 4; ++j) { q[8 * i + j] = x0[j]; q[8 * i + 4 + j] = x1[j]; } }
        float sc[2];
#pragma unroll
        for (int r = 0; r < 2; ++r) { const int j = lane + 64 * r, tk = t - 127 + j; float s = -INFINITY;
            if (tk >= 0) { const bf16_t* kp = QKV + (size_t)(m - 127 + j) * CIN + 1024 + kv * HD; float d = 0.f;
#pragma unroll
                for (int i = 0; i < 8; ++i) { f32x4 x0, x1; pg8::unpack8(*(const u32x4*)(kp + 8 * i), x0, x1);
#pragma unroll
                    for (int jj = 0; jj < 4; ++jj) d += q[8 * i + jj] * x0[jj] + q[8 * i + 4 + jj] * x1[jj]; }
                s = d * 0.125f; }
            sc[r] = s; }
        const float sink = a.sinks[hq];
        const float mx = fmaxf(wave_max(fmaxf(sc[0], sc[1])), sink);
        const float e0 = __expf(sc[0] - mx), e1 = __expf(sc[1] - mx);
        const float den = wave_sum(e0 + e1) + __expf(sink - mx);
        const float inv = 1.f / den; const float p0 = e0 * inv, p1 = e1 * inv;
        float o = 0.f;
        const int j0 = (t >= 127) ? 0 : 127 - t;
        for (int j = j0; j < 128; ++j) { const float pj = __shfl(j < 64 ? p0 : p1, j & 63); o += pj * bf1(QKV[(size_t)(m - 127 + j) * CIN + 1152 + kv * HD + lane]); }
        XA[(size_t)m * D + hq * HD + lane] = (bf16_t)f2bf(o);
    }
}

typedef float f32x16 __attribute__((ext_vector_type(16)));
#define MFMA32(A, B, C) __builtin_amdgcn_mfma_f32_32x32x16_bf16(A, B, C, 0, 0, 0)
constexpr int AT_ROW = 144, AT_K = 0, AT_V = 256 * AT_ROW;
__device__ __forceinline__ void phase_attn_fast(const Frame& F, const Args& a) {
    const bf16_t* QKV = (const bf16_t*)(a.ws + WS_QKV); bf16_t* XA = (bf16_t*)(a.ws + WS_XA);
    LAS unsigned char* L = F.lds;
    const int tid = F.tid, lane = F.lane, w = F.wave, c32 = lane & 31, hh = lane >> 5, i16 = lane & 15, trq = i16 >> 2, trp = i16 & 3, G1 = (lane >> 4) & 1;
    const float CS = 0.125f * 1.4426950408889634f;
    for (int unit = F.vcu; unit < NB * NKVH * (SEQ / 128); unit += F.G) {
        const int nb = unit & 31, kv = (unit >> 5) & 1, b = unit >> 6;
        const long rowk0 = (long)b * SEQ + 128 * nb - 128;
        __syncthreads();
#pragma unroll
        for (int i = 0; i < 4; ++i) { const int p = tid + NTHR * i, row = p >> 3, sg = p & 7; const bool ok = (nb > 0) || (row >= 128);
            u32x4 kx = (u32x4){0u, 0u, 0u, 0u}, vx = kx;
            if (ok) { const bf16_t* src = QKV + (size_t)(rowk0 + row) * CIN + 1024 + kv * HD + sg * 8; kx = *(const u32x4*)src; vx = *(const u32x4*)(src + 128); }
            *(LAS u32x4*)(L + AT_K + row * AT_ROW + sg * 16) = kx; *(LAS u32x4*)(L + AT_V + row * AT_ROW + sg * 16) = vx; }
        __syncthreads();
        const int hq = kv * 8 + w; const float sink2 = a.sinks[hq] * 1.4426950408889634f;
        for (int qt = 0; qt < 4; ++qt) {
            const size_t qrow = (size_t)b * SEQ + 128 * nb + 32 * qt + c32;
            const bf16_t* qp = QKV + qrow * CIN + hq * HD + 8 * hh;
            bf16x8 bQ[4];
#pragma unroll
            for (int ks = 0; ks < 4; ++ks) bQ[ks] = *(const bf16x8*)(qp + 16 * ks);
            f32x16 st[5]; float mx = sink2;
#pragma unroll
            for (int t = 0; t < 5; ++t) {
                const bool blk_ok = (nb > 0) || (qt + t >= 4);
#pragma unroll
                for (int r = 0; r < 16; ++r) st[t][r] = 0.f;
                if (blk_ok) {
#pragma unroll
                    for (int ks = 0; ks < 4; ++ks) { const bf16x8 aK = *(const LAS bf16x8*)(L + AT_K + (32 * (qt + t) + c32) * AT_ROW + (16 * ks + 8 * hh) * 2); st[t] = MFMA32(aK, bQ[ks], st[t]); } }
#pragma unroll
                for (int r = 0; r < 16; ++r) { const int kk = (r & 3) + 8 * (r >> 2) + 4 * hh;
                    bool ok = blk_ok; if (t == 0) ok = ok && (kk > c32); if (t == 4) ok = ok && (kk <= c32);
                    const float z = ok ? st[t][r] * CS : -INFINITY; st[t][r] = z; mx = fmaxf(mx, z); }
            }
            mx = fmaxf(mx, __shfl_xor(mx, 32));
            float sum = 0.f;
#pragma unroll
            for (int t = 0; t < 5; ++t)
#pragma unroll
                for (int r = 0; r < 16; ++r) { const float p = __builtin_amdgcn_exp2f(st[t][r] - mx); st[t][r] = p; sum += p; }
            sum += __shfl_xor(sum, 32);
            const float inv = 1.f / (sum + __builtin_amdgcn_exp2f(sink2 - mx));
            f32x16 o0, o1;
#pragma unroll
            for (int r = 0; r < 16; ++r) { o0[r] = 0.f; o1[r] = 0.f; }
#pragma unroll
            for (int t = 0; t < 5; ++t)
#pragma unroll
                for (int s2 = 0; s2 < 2; ++s2) {
                    const bf16x8 bP = pk8((f32x4){st[t][8 * s2], st[t][8 * s2 + 1], st[t][8 * s2 + 2], st[t][8 * s2 + 3]}, (f32x4){st[t][8 * s2 + 4], st[t][8 * s2 + 5], st[t][8 * s2 + 6], st[t][8 * s2 + 7]});
                    const LAS unsigned char* vb = L + AT_V + (32 * (qt + t) + 16 * s2 + 4 * hh + trq) * AT_ROW + (16 * G1 + 4 * trp) * 2;
                    const bf16x8 aV0 = cat44(lds_tr(vb), lds_tr(vb + 8 * AT_ROW)), aV1 = cat44(lds_tr(vb + 64), lds_tr(vb + 8 * AT_ROW + 64));
                    o0 = MFMA32(aV0, bP, o0); o1 = MFMA32(aV1, bP, o1); }
            bf16_t* op = XA + qrow * D + hq * HD + 4 * hh;
#pragma unroll
            for (int rg = 0; rg < 4; ++rg) { u32x2 x0, x1;
                x0.x = pg8::cvt_pk_bf16(o0[4 * rg] * inv, o0[4 * rg + 1] * inv); x0.y = pg8::cvt_pk_bf16(o0[4 * rg + 2] * inv, o0[4 * rg + 3] * inv);
                x1.x = pg8::cvt_pk_bf16(o1[4 * rg] * inv, o1[4 * rg + 1] * inv); x1.y = pg8::cvt_pk_bf16(o1[4 * rg + 2] * inv, o1[4 * rg + 3] * inv);
                *(u32x2*)(op + 8 * rg) = x0; *(u32x2*)(op + 32 + 8 * rg) = x1; }
        }
    }
}

constexpr int CNT_STRIDE = 64;
constexpr int RT_WROW = 2064;
constexpr int RT_WH = 0, RT_WL = 16 * RT_WROW, RT_LG = 2 * 16 * RT_WROW, RT_TC = RT_LG + 8 * 1088, RT_TW = RT_TC + 512, RT_LC = RT_TW + 2048, RT_GB = RT_LC + 128;
__device__ __forceinline__ void phase_route(const Frame& F, const Args& a, int l) {
    unsigned char* ws = a.ws; const float* H = a.out;
    gu32* cnt = (gu32*)(ws + WS_CTL) + CW_CNT + l * 32 * CNT_STRIDE; int* list = (int*)(ws + WS_LIST); f32x2* wlist = (f32x2*)(ws + WS_WLIST); float* rlist = (float*)(ws + WS_RLIST);
    LAS unsigned char* L = F.lds;
    LAS float* LG = (LAS float*)(L + RT_LG) + F.wave * 272; LAS int* TC = (LAS int*)(L + RT_TC); LAS f32x4* TW = (LAS f32x4*)(L + RT_TW); LAS int* LC = (LAS int*)(L + RT_LC); LAS int* GB = (LAS int*)(L + RT_GB);
    const float* gn = a.norm_ffn + l * D;
    for (int i = F.tid; i < D * NE; i += NTHR) { const int k = i >> 4, e = i & 15; const float wv = a.w_router[i] * gn[k]; const unsigned hi = f2bf(wv); const unsigned lo = f2bf(wv - bflo(hi));
        *(LAS bf16_t*)(L + RT_WH + e * RT_WROW + k * 2) = (bf16_t)hi; *(LAS bf16_t*)(L + RT_WL + e * RT_WROW + k * 2) = (bf16_t)lo; }
    if (F.tid < 32) LC[F.tid] = 0;
    __syncthreads();
    const int lane = F.lane, r15 = lane & 15, g = lane >> 4;
    for (int blk = F.vcu; blk < NT / 128; blk += F.G) {
        const int tl0 = F.wave * 16, m0 = blk * 128 + tl0;
        const f32x4* xr = (const f32x4*)(H + (size_t)(m0 + r15) * D + 8 * g);
        f32x4 acc = (f32x4){0.f, 0.f, 0.f, 0.f}; float ssq = 0.f;
        const LAS unsigned char* wh = L + RT_WH + r15 * RT_WROW + 16 * g; const LAS unsigned char* wl_ = L + RT_WL + r15 * RT_WROW + 16 * g;
#pragma unroll 1
        for (int k8 = 0; k8 < 4; ++k8) {
            f32x4 xv[16];
#pragma unroll
            for (int q = 0; q < 8; ++q) { xv[2 * q] = xr[(k8 * 8 + q) * 8]; xv[2 * q + 1] = xr[(k8 * 8 + q) * 8 + 1]; }
#pragma unroll
            for (int q = 0; q < 8; ++q) { const f32x4 x0 = xv[2 * q], x1 = xv[2 * q + 1]; ssq += pg8::sq8(x0, x1);
                const u32x4 hp = pg8::pack8(x0, x1); f32x4 h0, h1; pg8::unpack8(hp, h0, h1);
                const bf16x8 xh = __builtin_bit_cast(bf16x8, hp), xl = pk8(x0 - h0, x1 - h1);
                const bf16x8 bh = *(const LAS bf16x8*)(wh + (k8 * 8 + q) * 64), bl = *(const LAS bf16x8*)(wl_ + (k8 * 8 + q) * 64);
                acc = MFMA16(xh, bh, acc); acc = MFMA16(xh, bl, acc); acc = MFMA16(xl, bh, acc); }
        }
        ssq += __shfl_xor(ssq, 16); ssq += __shfl_xor(ssq, 32);
        const float rs = __builtin_amdgcn_rsqf(ssq * (1.f / D) + EPS);
#pragma unroll
        for (int r = 0; r < 4; ++r) LG[(4 * g + r) * 17 + r15] = acc[r];
        LDS_WAIT(); asm volatile("" ::: "memory");
        if (lane < 16) { float ex[16]; float mx = -INFINITY;
#pragma unroll
            for (int e = 0; e < 16; ++e) { ex[e] = LG[lane * 17 + e] * rs; mx = fmaxf(mx, ex[e]); }
#pragma unroll
            for (int e = 0; e < 16; ++e) ex[e] = __expf(ex[e] - mx);
            float gs[4], gv1[4], gv2[4]; int gi1[4], gi2[4];
#pragma unroll
            for (int gq = 0; gq < 4; ++gq) { float m1 = ex[4 * gq]; int i1 = 0;
#pragma unroll
                for (int i = 1; i < 4; ++i) if (ex[4 * gq + i] > m1) { m1 = ex[4 * gq + i]; i1 = i; }
                float m2 = -1.f; int i2 = 0;
#pragma unroll
                for (int i = 0; i < 4; ++i) if (i != i1 && ex[4 * gq + i] > m2) { m2 = ex[4 * gq + i]; i2 = i; }
                gs[gq] = m1 + m2; gv1[gq] = m1; gv2[gq] = m2; gi1[gq] = i1; gi2[gq] = i2; }
            int sel = 0; float best = gs[0], v1 = gv1[0], v2 = gv2[0]; int i1 = gi1[0], i2 = gi2[0];
#pragma unroll
            for (int gq = 1; gq < 4; ++gq) if (gs[gq] > best) { best = gs[gq]; sel = gq; v1 = gv1[gq]; v2 = gv2[gq]; i1 = gi1[gq]; i2 = gi2[gq]; }
            const float wsum = 1.f / (v1 + v2); const float w1 = v1 * wsum, w2 = v2 * wsum;
            const int ea = i1 < i2 ? i1 : i2, eb = i1 < i2 ? i2 : i1; const float wa = i1 < i2 ? w1 : w2, wb = i1 < i2 ? w2 : w1;
            const int pr = (ea == 0) ? eb - 1 : ((ea == 1) ? eb + 1 : 5);
            TC[tl0 + lane] = sel * 6 + pr; TW[tl0 + lane] = (f32x4){wa, wb, rs, 0.f}; }
        __syncthreads();
        int myc = 0, lp = 0;
        if (F.tid < 128) { myc = TC[F.tid]; lp = __hip_atomic_fetch_add(LC + myc, 1, __ATOMIC_RELAXED, __HIP_MEMORY_SCOPE_WORKGROUP); }
        __syncthreads();
        if (F.tid < NCLS) { const int n = LC[F.tid]; GB[F.tid] = n ? (int)__hip_atomic_fetch_add(cnt + F.tid * CNT_STRIDE, (unsigned)n, __ATOMIC_RELAXED, __HIP_MEMORY_SCOPE_AGENT) : 0; }
        __syncthreads();
        if (F.tid < 128) { const size_t pos = (size_t)myc * LCAP + GB[myc] + lp; const f32x4 tw = TW[F.tid]; list[pos] = blk * 128 + F.tid; wlist[pos] = (f32x2){tw[0], tw[1]}; rlist[pos] = tw[2]; }
        if (F.tid < 32) LC[F.tid] = 0;
        __syncthreads();
    }
}

constexpr int LX_UT = LX_OFF + 2048;
template <int NP>
__device__ __forceinline__ void moe_tables(const Frame& F, unsigned char* ws, int l) {
    const gu32* cnt = (const gu32*)(ws + WS_CTL) + CW_CNT + l * 32 * CNT_STRIDE;
    volatile LAS int* TB = (volatile LAS int*)(F.lds + LX_TB); volatile LAS int* CN = (volatile LAS int*)(F.lds + LX_CNT); volatile LAS int* CL = (volatile LAS int*)(F.lds + LX_CLS);
    volatile LAS unsigned long long* UT = (volatile LAS unsigned long long*)(F.lds + LX_UT);
    __syncthreads();
    if (F.tid < NCLS) CN[F.tid] = (int)__hip_atomic_load(cnt + F.tid * CNT_STRIDE, __ATOMIC_RELAXED, __HIP_MEMORY_SCOPE_AGENT);
    __syncthreads();
    if (F.tid == 0) { int tb = 0;
#pragma unroll 1
        for (int c = 0; c < NCLS; ++c) { TB[c] = tb; const int n = (CN[c] + 255) >> 8;
#pragma unroll 1
            for (int i = 0; i < n; ++i) CL[tb + i] = c;
            tb += n; }
        TB[NCLS] = tb; }
    __syncthreads();
    if (F.tid < 8) { const int i = F.tid; const int L = i * F.G + F.vcu; const int TT = TB[NCLS];
        unsigned long long w0 = ~0ull, w1 = 0, w2 = 0, w3 = 0, w4 = 0;
        if (L < TT * NP) { const int tau = L / NP, pn = L % NP; const int c = CL[tau]; const int ti = tau - TB[c], rem = CN[c] - ti * 256;
            const int g = c / 6, pr = c % 6; const int ea = pr < 3 ? 0 : (pr < 5 ? 1 : 2), eb = pr < 3 ? pr + 1 : (pr < 5 ? pr - 1 : 3);
            const int nv = rem < 256 ? rem : 256, aux = c * LCAP + ti * 256;
            const char *pA, *pB, *pB2;
            if (NP == 8) { const int e = g * 4 + (pn < 4 ? ea : eb); pA = (const char*)(ws + WS_XA2); pB = (const char*)(ws + WS_W1) + ((size_t)(l * NE + e) * D * D + (size_t)(pn & 3) * 256 * D) * 2; pB2 = pB; }
            else { pA = (const char*)(ws + WS_HID) + (size_t)tau * 256 * 1024 * 2; pB = (const char*)(ws + WS_W2) + ((size_t)(l * NE + g * 4 + ea) * D * DE + (size_t)pn * 256 * DE) * 2;
                pB2 = (const char*)(ws + WS_W2) + ((size_t)(l * NE + g * 4 + eb) * D * DE + (size_t)pn * 256 * DE) * 2; }
            w0 = (unsigned long long)(unsigned)tau | ((unsigned long long)(unsigned)pn << 32); w1 = (unsigned long long)pA; w2 = (unsigned long long)pB; w3 = (unsigned long long)pB2;
            w4 = (unsigned long long)(unsigned)nv | ((unsigned long long)(unsigned)aux << 32); }
        UT[i * 8 + 0] = w0; UT[i * 8 + 1] = w1; UT[i * 8 + 2] = w2; UT[i * 8 + 3] = w3; UT[i * 8 + 4] = w4; }
    __syncthreads();
}
__device__ __forceinline__ unsigned long long rfl64(unsigned long long v) { const unsigned lo = __builtin_amdgcn_readfirstlane((unsigned)v), hi = __builtin_amdgcn_readfirstlane((unsigned)(v >> 32)); return ((unsigned long long)hi << 32) | lo; }
struct MoeSched {
    const LAS unsigned long long* UT; const int* list;
    __device__ __forceinline__ bool next(int i, pg8::Unit& u) const {
        if (i >= 8) return false;
        const unsigned long long w0 = rfl64(UT[i * 8 + 0]); if ((int)(unsigned)w0 < 0) return false;
        const unsigned long long w1 = rfl64(UT[i * 8 + 1]), w2 = rfl64(UT[i * 8 + 2]), w3 = rfl64(UT[i * 8 + 3]), w4 = rfl64(UT[i * 8 + 4]);
        u.pm = (int)(unsigned)w0; u.pn = (int)(unsigned)(w0 >> 32); u.pA = (const char*)w1; u.pB = (const char*)w2; u.pB2 = (const char*)w3; u.nv = (int)(unsigned)w4; u.aux = (int)(unsigned)(w4 >> 32); u.lst = list + u.aux;
        return true;
    }
};

__device__ __forceinline__ void phase_final(const Frame& F, const Args& a) {
    const int gw = F.vcu * NWAVES + F.wave, NGW = F.G * NWAVES, lane = F.lane;
    f32x4 gv[4];
#pragma unroll
    for (int j = 0; j < 4; ++j) gv[j] = *((const f32x4*)a.norm_final + lane + 64 * j);
    for (int m = gw; m < NT; m += NGW) { f32x4* xr = (f32x4*)(a.out + (size_t)m * D) + lane; f32x4 v[4]; float s = 0.f;
#pragma unroll
        for (int j = 0; j < 4; ++j) { v[j] = xr[64 * j]; s += (v[j][0] * v[j][0] + v[j][1] * v[j][1]) + (v[j][2] * v[j][2] + v[j][3] * v[j][3]); }
        const float rs = __builtin_amdgcn_rsqf(wave_sum(s) * (1.f / D) + EPS);
#pragma unroll
        for (int j = 0; j < 4; ++j) xr[64 * j] = v[j] * rs * gv[j]; }
}

constexpr int N_PHASES = 18;
#ifndef HGRN_NAIVE
#define HGRN_NAIVE 0
#endif
#ifndef ATTN_NAIVE
#define ATTN_NAIVE 0
#endif
#if defined(__HIP_DEVICE_COMPILE__)
#define LOAD_ARGS(a) Args a; { const __attribute__((address_space(4))) char* _kp = (const __attribute__((address_space(4))) char*)__builtin_amdgcn_kernarg_segment_ptr(); asm volatile("" : "+s"(_kp)); a = *(const Args*)(const char*)_kp; } unsigned char* ws = a.ws
#else
#define LOAD_ARGS(a) Args a = args; unsigned char* ws = a.ws
#endif
__global__ void __launch_bounds__(NTHR, 2) mega_fwd(Args args) {
    extern __shared__ __attribute__((aligned(16))) unsigned char lds_raw[];
    Frame F; F.lds = (LAS unsigned char*)lds_raw; F.tid = threadIdx.x; F.lane = F.tid & 63; F.wave = __builtin_amdgcn_readfirstlane(F.tid >> 6);
    F.G = gridDim.x; { const int bx = blockIdx.x; F.vcu = (F.G % 8 == 0) ? (bx % 8) * (F.G / 8) + bx / 8 : bx; }
    for (int u = F.tid; u < (LDS_BYTES - LX_OFF) / 4; u += NTHR) ((LAS unsigned*)(F.lds + LX_OFF))[u] = 0u;
    __syncthreads();
#if !MK_PER_PHASE
    XcdBarrier bar = xcd_barrier_post((unsigned*)((gu32*)(args.ws + WS_CTL) + CW_BAR), (volatile LAS unsigned*)(F.lds + LX_BAR));
#define GRID_BAR() xcd_barrier(bar)
#else
#define GRID_BAR() do { } while (0)
#endif
    const int lo = args.ph_lo, hi = args.ph_hi;
#define SITE_FRAME(Fp) Frame Fp = F; { int _t = threadIdx.x; asm volatile("" : "+v"(_t)); unsigned _z = 0; asm volatile("" : "+s"(_z)); Fp.tid = _t; Fp.lane = _t & 63; Fp.wave = __builtin_amdgcn_readfirstlane(_t >> 6); Fp.lds = F.lds + _z; }
#ifndef PHMASK
#define PHMASK 0x3FFFF
#endif
#define IN(k) (((PHMASK >> (k)) & 1) && lo <= (k) && (k) < hi)
#define BOTH(k) (IN(k) && IN((k) + 1))
    const int bx = (int)blockIdx.x;

    if (IN(0)) { LOAD_ARGS(a); (void)ws; SITE_FRAME(Fp); phase_prep(Fp, a); if (BOTH(0)) GRID_BAR(); }

    for (int l = 0; l < 2; ++l) {
        const int pb = 1 + 8 * l;
        if (IN(pb + 0)) { LOAD_ARGS(a); SITE_FRAME(Fp);
#ifndef NO_S1A
            if (l == 0) { pg8::DenseSched S; S.init(ws + WS_XA, ws + WS_WINAB, NT, ABIN, D, D, Fp.G, bx); pg8::EpiInAb E{(bf16_t*)(ws + WS_Z)};
                pg8::gemm_phase<pg8::EpiInAb, pg8::DenseSched, false, false>(Fp.lds, D, D, D, S, E); }
#endif
#ifndef NO_S1B
            if (l == 1) { pg8::DenseSched S; S.init(ws + WS_XA, ws + WS_WINC, NT, CIN, D, D, Fp.G, bx); pg8::EpiQkv E{(bf16_t*)(ws + WS_QKV), a.b_in_c, (const float*)(ws + WS_SSB)};
                pg8::gemm_phase<pg8::EpiQkv, pg8::DenseSched, false, false>(Fp.lds, D, D, D, S, E); }
#endif
#ifndef NO_S1C
            { pg8::DenseSched S; S.init(ws + WS_PB + (size_t)l * NT * PLE * 2, ws + WS_WPP + (size_t)l * D * PLE * 2, NT, D, PLE, PLE, Fp.G, bx); pg8::EpiBf16 E{(bf16_t*)(ws + WS_PP), D};
                pg8::gemm_phase<pg8::EpiBf16, pg8::DenseSched, false, false>(Fp.lds, PLE, PLE, PLE, S, E); }
#endif
            if (BOTH(pb + 0)) GRID_BAR();
        }
#if HGRN_NAIVE
        if (IN(pb + 1)) { LOAD_ARGS(a); (void)ws; SITE_FRAME(Fp); if (l == 0) { phase_hgrn_conv(Fp, a); phase_conv(Fp, a); } else phase_attn(Fp, a); if (BOTH(pb + 1)) GRID_BAR(); }
#else
        if (IN(pb + 1)) { LOAD_ARGS(a); (void)ws; SITE_FRAME(Fp); if (l == 0) { hgrn_pass<false>(Fp, a); phase_conv(Fp, a); } else { if (ATTN_NAIVE) phase_attn(Fp, a); else phase_attn_fast(Fp, a); } if (BOTH(pb + 1)) GRID_BAR(); }
        if (IN(pb + 2) && l == 0) { LOAD_ARGS(a); (void)ws; SITE_FRAME(Fp); hgrn_pass<true>(Fp, a); if (BOTH(pb + 2)) GRID_BAR(); }
#endif
        if (IN(pb + 3)) { LOAD_ARGS(a); SITE_FRAME(Fp);
            pg8::DenseSched S; S.init(ws + WS_XA, ws + (l == 0 ? WS_WOUTAB : WS_WOUTC), NT, D, D, D, Fp.G, bx);
            pg8::EpiRes E{l == 0 ? a.x : a.out, a.out, l == 0 ? nullptr : a.b_out_c, (bf16_t*)(ws + WS_XA2)};
            pg8::gemm_phase<pg8::EpiRes, pg8::DenseSched, false, false>(Fp.lds, D, D, D, S, E);
            if (BOTH(pb + 3)) GRID_BAR();
        }
        if (IN(pb + 4)) { LOAD_ARGS(a); (void)ws; SITE_FRAME(Fp); phase_route(Fp, a, l); if (BOTH(pb + 4)) GRID_BAR(); }
        if (IN(pb + 5)) { LOAD_ARGS(a); SITE_FRAME(Fp); moe_tables<8>(Fp, ws, l);
            MoeSched S{(const LAS unsigned long long*)(Fp.lds + LX_UT), (const int*)(ws + WS_LIST)};
            pg8::EpiG1 E{(bf16_t*)(ws + WS_HID), (const f32x2*)(ws + WS_WLIST), (const float*)(ws + WS_RLIST)};
            pg8::gemm_phase<pg8::EpiG1, MoeSched, true, false>(Fp.lds, D, D, D, S, E);
            if (BOTH(pb + 5)) GRID_BAR(); }
        if (IN(pb + 6)) { LOAD_ARGS(a); SITE_FRAME(Fp); moe_tables<4>(Fp, ws, l);
            MoeSched S{(const LAS unsigned long long*)(Fp.lds + LX_UT), (const int*)(ws + WS_LIST)};
            pg8::EpiG2 E{a.out, (bf16_t*)(ws + WS_XA2), (float*)(ws + WS_SSA)};
            pg8::gemm_phase<pg8::EpiG2, MoeSched, false, true>(Fp.lds, 1024, 1024, DE, S, E);
            if (BOTH(pb + 6)) GRID_BAR(); }
        if (IN(pb + 7)) { LOAD_ARGS(a); SITE_FRAME(Fp);
            pg8::DenseSched S; S.init(ws + WS_XA2, ws + WS_WPG + (size_t)l * D * D * 2, NT, D, D, D, Fp.G, bx);
            pg8::EpiPle E{a.out, (bf16_t*)(ws + WS_XA), (const bf16_t*)(ws + WS_PP), (const float*)(ws + WS_SSA), (float*)(ws + WS_SSB)};
            pg8::gemm_phase<pg8::EpiPle, pg8::DenseSched, false, false>(Fp.lds, D, D, D, S, E);
            if (BOTH(pb + 7)) GRID_BAR();
        }
    }
    if (IN(17)) { LOAD_ARGS(a); (void)ws; SITE_FRAME(Fp); phase_final(Fp, a); }
#undef IN
#undef BOTH
}

extern "C" void kernel_launch(void* const* d_in, const int* in_sizes, int n_in, void* d_out, int out_size, void* d_ws, size_t ws_size, hipStream_t stream) {
    static int grid = 0;
    if (grid == 0) {
        if (n_in != 22 || out_size != NT * D || ws_size < WS_END) { fprintf(stderr, "kernel_launch: unexpected shapes (n_in %d, out %d, ws %zu)\n", n_in, out_size, ws_size); grid = -1; return; }
        int dev = 0, cus = 0, per_cu = 0;
        if (hipGetDevice(&dev) != hipSuccess || hipDeviceGetAttribute(&cus, hipDeviceAttributeMultiprocessorCount, dev) != hipSuccess) { grid = -1; return; }
        if (hipFuncSetAttribute((const void*)mega_fwd, hipFuncAttributeMaxDynamicSharedMemorySize, LDS_BYTES) != hipSuccess) { fprintf(stderr, "kernel_launch: hipFuncSetAttribute failed\n"); grid = -1; return; }
        if (hipOccupancyMaxActiveBlocksPerMultiprocessor(&per_cu, (const void*)mega_fwd, NTHR, LDS_BYTES) != hipSuccess || per_cu < 1) fprintf(stderr, "kernel_launch: occupancy query says %d\n", per_cu);
        (void)hipGetLastError();
        grid = cus;
    }
    if (grid < 0) return;
    (void)hipMemsetAsync((char*)d_ws + WS_CTL, 0, CTL_ZERO_BYTES, stream);
    Args a{};
    a.x = (const float*)d_in[0]; a.p = (const float*)d_in[1]; a.norm_mix = (const float*)d_in[2]; a.norm_ffn = (const float*)d_in[3]; a.norm_ple = (const float*)d_in[4]; a.norm_final = (const float*)d_in[5];
    a.w_in_ab = (const float*)d_in[6]; a.lb_logits = (const float*)d_in[7]; a.hgrn_out_norm = (const float*)d_in[8]; a.conv_w = (const float*)d_in[9]; a.w_out_ab = (const float*)d_in[10];
    a.w_in_c = (const float*)d_in[11]; a.b_in_c = (const float*)d_in[12]; a.sinks = (const float*)d_in[13]; a.w_out_c = (const float*)d_in[14]; a.b_out_c = (const float*)d_in[15];
    a.w_router = (const float*)d_in[16]; a.w_gate_e = (const float*)d_in[17]; a.w_up_e = (const float*)d_in[18]; a.w_down_e = (const float*)d_in[19]; a.w_ple_gate = (const float*)d_in[20]; a.w_ple_proj = (const float*)d_in[21];
    a.out = (float*)d_out; a.ws = (unsigned char*)d_ws;
#if MK_PER_PHASE
#ifndef RP
#define RP (-1)
#define RN 0
#endif
    for (int ph = 0; ph < N_PHASES; ++ph) { a.ph_lo = ph; a.ph_hi = ph + 1; const int reps = (ph == RP) ? RN + 1 : 1;
        for (int r = 0; r < reps; ++r) { if (r > 0 && (ph == 5 || ph == 13)) (void)hipMemsetAsync((char*)d_ws + WS_CTL, 0, CTL_ZERO_BYTES, stream); hipLaunchKernelGGL(mega_fwd, dim3(grid), dim3(NTHR), LDS_BYTES, stream, a); } }
#else
    a.ph_lo = 0; a.ph_hi = N_PHASES; hipLaunchKernelGGL(mega_fwd, dim3(grid), dim3(NTHR), LDS_BYTES, stream, a);
#endif
}
```

```cpp
#include <hip/hip_runtime.h>
#include <cstdio>
#include <cstdint>

#ifndef MK_PER_PHASE
#define MK_PER_PHASE 0
#endif

#define LAS __attribute__((address_space(3)))
#define GAS __attribute__((address_space(1)))
typedef unsigned short bf16_t;
typedef short bf16x8 __attribute__((ext_vector_type(8)));
typedef float f32x4 __attribute__((ext_vector_type(4)));
typedef float f32x2 __attribute__((ext_vector_type(2)));
typedef unsigned u32x4 __attribute__((ext_vector_type(4)));
typedef unsigned u32x2 __attribute__((ext_vector_type(2)));
typedef GAS unsigned gu32;

constexpr int NB = 8, SEQ = 4096, D = 1024, NT = NB * SEQ;
constexpr int PLE = 256;
constexpr int AW = 512, AH = 4, ADK = 128;
constexpr int ABIN = 3584, ZW = 3072;
constexpr int CIN = 1280, HD = 64, NQH = 16, NKVH = 2, WIN = 128;
constexpr int NE = 16, DE = 512;
constexpr int NCLS = 24, LCAP = NT;
constexpr int HIDROWS = NT + NCLS * 256;
constexpr float EPS = 1e-6f;

constexpr size_t MiB = 1u << 20;
constexpr size_t WS_CTL = 0, CTL_ZERO_BYTES = 1 * MiB;
constexpr size_t WS_WINAB = 1 * MiB;
constexpr size_t WS_WOUTAB = 8 * MiB;
constexpr size_t WS_WINC = 10 * MiB;
constexpr size_t WS_WOUTC = 13 * MiB;
constexpr size_t WS_WPG = 15 * MiB;
constexpr size_t WS_WPP = 19 * MiB;
constexpr size_t WS_W1 = 20 * MiB;
constexpr size_t WS_W2 = 84 * MiB;
constexpr size_t WS_PB = 116 * MiB;
constexpr size_t WS_XA = 148 * MiB;
constexpr size_t WS_Z = 212 * MiB;
constexpr size_t WS_XA2 = WS_Z;
constexpr size_t WS_HID = WS_Z + 64 * MiB;
constexpr size_t WS_QKV = WS_Z + 64 * MiB;
constexpr size_t WS_PP = 404 * MiB;
constexpr size_t WS_LIST = 468 * MiB;
constexpr size_t WS_WLIST = 471 * MiB;
constexpr size_t WS_SSA = 477 * MiB;
constexpr size_t WS_SSB = 479 * MiB;
constexpr size_t WS_LB = 481 * MiB;
constexpr size_t WS_HL = 484 * MiB;
constexpr size_t WS_HSUM = 500 * MiB;
constexpr size_t WS_RLIST = 502 * MiB;
constexpr size_t WS_END = 505 * MiB;
constexpr int CW_BAR = 4096;
constexpr int CW_CNT = 16384;

constexpr int RING_BYTES = 131072;
constexpr int LX_OFF = RING_BYTES;
constexpr int LX_BAR = LX_OFF + 0;
constexpr int LX_TB = LX_OFF + 64;
constexpr int LX_CNT = LX_OFF + 64 + 128;
constexpr int LX_CLS = LX_OFF + 512;
constexpr int LDS_BYTES = 147456;
constexpr int NWAVES = 8, NTHR = 512;

__device__ __forceinline__ unsigned f2bf(float f) { unsigned u = __builtin_bit_cast(unsigned, f); return (u + 0x7fffu + ((u >> 16) & 1u)) >> 16; }
__device__ __forceinline__ unsigned pk2(float lo, float hi) { return f2bf(lo) | (f2bf(hi) << 16); }
__device__ __forceinline__ float bflo(unsigned w) { return __builtin_bit_cast(float, w << 16); }
__device__ __forceinline__ float bfhi(unsigned w) { return __builtin_bit_cast(float, w & 0xffff0000u); }
__device__ __forceinline__ float bf1(bf16_t h) { return __builtin_bit_cast(float, (unsigned)h << 16); }
__device__ __forceinline__ float sigmoidf_(float x) { return __builtin_amdgcn_rcpf(1.f + __expf(-x)); }
__device__ __forceinline__ float siluf_(float x) { return x * sigmoidf_(x); }
__device__ __forceinline__ float wave_sum(float v) {
#pragma unroll
    for (int o = 1; o < 64; o <<= 1) v += __shfl_xor(v, o);
    return v;
}
__device__ __forceinline__ float wave_max(float v) {
#pragma unroll
    for (int o = 1; o < 64; o <<= 1) v = fmaxf(v, __shfl_xor(v, o));
    return v;
}
#define LDS_WAIT() asm volatile("s_waitcnt lgkmcnt(0)" ::: "memory")

namespace pg8 {
constexpr int BM = 256, BK = 64, HALF = 128, HTB = HALF * BK * 2, NXCD = 8, WGM = 8;
__host__ __device__ __forceinline__ int lds_byte(int r, int c) { const int st = (r >> 4) * 2 + (c >> 5), rr = r & 15, cc = c & 31, ob = rr * 64 + cc * 2; return st * 1024 + (ob ^ (((ob >> 9) & 1) << 5)); }
__host__ __device__ __forceinline__ void stage_rc(int b, int& R, int& C) { const int st = b / 1024, sb = b % 1024, swz = sb ^ (((sb >> 9) & 1) << 5); R = (st >> 1) * 16 + swz / 64; C = (st & 1) * 32 + (swz % 64) / 2; }
__host__ __device__ __forceinline__ int perm32(int rho) { const int n = rho >> 4, i = rho & 15; return 8 * (i >> 2) + 4 * n + (i & 3); }

struct Unit { int pm, pn; const char* pA; const char* pB; const char* pB2; const int* lst; int nv; int aux; };

struct StaticOrder {
    int nM, nN, nwg, G, c;
    __device__ void init(int M, int N, int G_, int c_) { nM = M / BM; nN = N / BM; nwg = nM * nN; G = G_; c = c_; }
    __device__ bool next(int i, int& pm, int& pn) const {
        const long L = (long)i * G + c; if (L >= nwg) return false;
        int wgid = (int)L; { const int q = nwg / NXCD, r = nwg % NXCD, xcd = wgid % NXCD, off = wgid / NXCD; wgid = (xcd < r ? xcd * (q + 1) : r * (q + 1) + (xcd - r) * q) + off; }
        const int nig = WGM * nN, gid = wgid / nig, fm = gid * WGM, gsz = (nM - fm) < WGM ? (nM - fm) : WGM;
        pm = fm + ((wgid % nig) % gsz); pn = (wgid % nig) / gsz; return true;
    }
};
struct DenseSched {
    StaticOrder so; const char* A; const char* B; size_t tA, tB;
    __device__ void init(const void* A_, const void* B_, int M, int N, int lda, int ldb, int G, int c) { so.init(M, N, G, c); A = (const char*)A_; B = (const char*)B_; tA = (size_t)BM * lda * 2; tB = (size_t)BM * ldb * 2; }
    __device__ __forceinline__ bool next(int i, Unit& u) const {
        int pm, pn; if (!so.next(i, pm, pn)) return false;
        u.pm = pm; u.pn = pn; u.pA = A + (size_t)pm * tA; u.pB = B + (size_t)pn * tB; u.pB2 = u.pB; u.lst = nullptr; u.nv = BM; u.aux = i; return true;
    }
};

typedef __bf16 bf16x2_t __attribute__((ext_vector_type(2)));
__device__ __forceinline__ unsigned cvt_pk_bf16(float lo, float hi) { const f32x2 v = {lo, hi}; const bf16x2_t b = __builtin_convertvector(v, bf16x2_t); return __builtin_bit_cast(unsigned, b); }

template <class Epi, class Sched, bool GATHER, bool SPLITB>
__device__ __forceinline__ void gemm_phase(LAS unsigned char* lds, const int tid_in, const int K, const int lda, const int ldb, const Sched& S, const Epi& E) {
    int tid = tid_in; asm volatile("" : "+v"(tid));
    const int wid = __builtin_amdgcn_readfirstlane(tid >> 6), lane = tid & 63, wr = wid >> 2, wc = wid & 3, fr = lane & 15, fq = lane >> 4;
    int nt = K / BK; asm volatile("" : "+s"(nt));
    const int ntB = nt >> 1;
    unsigned voffA[2], voffB[2];
#pragma unroll
    for (int i = 0; i < 2; ++i) { int R, C; stage_rc(tid * 16 + i * 8192, R, C); const int Rb = (R & ~31) + perm32(R & 31); voffA[i] = (unsigned)(R * lda + C) * 2u; voffB[i] = (unsigned)(Rb * ldb + C) * 2u; }
    const size_t kstep = (size_t)(BK * 2);
    const size_t hstepB = (size_t)HALF * ldb * 2;
    const size_t hstepA = (size_t)HALF * lda * 2;
    const unsigned ldsw = (unsigned)wid * 1024u;
    const int aoff = lds_byte(wr * 64 + fr, fq * 8), boff = lds_byte(wc * 32 + fr, fq * 8);
#define PG8_SA(b, h) (((b) * 2 + (h)) * HTB)
#define PG8_SB(b, h) ((4 + (b) * 2 + (h)) * HTB)
#define PG8_STAGE(bufoff, gbase, voff) do { _Pragma("unroll") for (int _i = 0; _i < 2; ++_i) \
        __builtin_amdgcn_global_load_lds((const unsigned*)((const char*)(gbase) + (voff)[_i]), (LAS unsigned*)(lds + (bufoff) + ldsw + _i * 8192), 16, 0, 0); } while (0)
#define PG8_LDA(dst, b, h) do { _Pragma("unroll") for (int m = 0; m < 4; ++m) _Pragma("unroll") for (int k = 0; k < 2; ++k) dst[m][k] = *(const LAS bf16x8*)(lds + PG8_SA(b, h) + aoff + m * 2048 + k * 1024); } while (0)
#define PG8_LDB(dst, b, h) do { _Pragma("unroll") for (int n = 0; n < 2; ++n) _Pragma("unroll") for (int k = 0; k < 2; ++k) dst[n][k] = *(const LAS bf16x8*)(lds + PG8_SB(b, h) + boff + n * 2048 + k * 1024); } while (0)
#define PG8_MMA(ai, bj, At, Bt) do { __builtin_amdgcn_s_setprio(1); _Pragma("unroll") for (int m = 0; m < 4; ++m) _Pragma("unroll") for (int n = 0; n < 2; ++n) _Pragma("unroll") for (int k = 0; k < 2; ++k) \
        acc[ai][bj][m][n] = __builtin_amdgcn_mfma_f32_16x16x32_bf16(Bt[n][k], At[m][k], acc[ai][bj][m][n], 0, 0, 0); __builtin_amdgcn_s_setprio(0); } while (0)
#define PG8_WAIT_V(n) asm volatile("s_waitcnt vmcnt(" #n ")" ::: "memory")
#define PG8_WAIT_L(n) asm volatile("s_waitcnt lgkmcnt(" #n ")" ::: "memory")
#define PG8_BAR __builtin_amdgcn_s_barrier()
#define PG8_SCHED __builtin_amdgcn_sched_barrier(0)
#define PG8_GOFF(G, u) do { if constexpr (GATHER) { _Pragma("unroll") for (int _h = 0; _h < 2; ++_h) _Pragma("unroll") for (int _i = 0; _i < 2; ++_i) { \
        int _R, _C; stage_rc(tid * 16 + _i * 8192, _R, _C); int _ix = _h * HALF + _R; _ix = _ix < (u).nv ? _ix : (u).nv - 1; const int _tok = (u).lst[_ix]; G[_h][_i] = (unsigned)_tok * (unsigned)(lda * 2) + (unsigned)(_C * 2); } } } while (0)
#define PG8_STAGE_A(bufoff, gbase, half, G) do { if constexpr (GATHER) { PG8_STAGE(bufoff, gbase, G[half]); } else { PG8_STAGE(bufoff, (gbase) + (half) * hstepA, voffA); } } while (0)
#define PG8_BPTR(u, tt) ((SPLITB && (tt) >= ntB) ? (u).pB2 + (size_t)((tt) - ntB) * kstep : (u).pB + (size_t)(tt) * kstep)
    Unit cur; int ui = 0;
    if (!S.next(0, cur)) return;
    f32x4 acc[2][2][4][2];
#pragma unroll
    for (int a = 0; a < 2; ++a)
#pragma unroll
        for (int b = 0; b < 2; ++b)
#pragma unroll
            for (int m = 0; m < 4; ++m)
#pragma unroll
                for (int n = 0; n < 2; ++n) acc[a][b][m][n] = (f32x4){0.f, 0.f, 0.f, 0.f};
    bf16x8 At[4][2], B0[2][2], B1[2][2];
    unsigned cG[2][2];
    LAS u32x4* gstash = (LAS u32x4*)(lds + 135168) + tid;
    PG8_GOFF(cG, cur);
    const char* cA = cur.pA; const char* cB = cur.pB;
    PG8_STAGE(PG8_SB(0, 0), cB, voffB); PG8_STAGE(PG8_SB(0, 1), cB + hstepB, voffB); PG8_STAGE_A(PG8_SA(0, 0), cA, 0, cG); PG8_STAGE_A(PG8_SA(0, 1), cA, 1, cG);
    if (wr == 1) PG8_BAR;
    PG8_WAIT_V(2); PG8_BAR;
    PG8_STAGE(PG8_SB(1, 0), cB + kstep, voffB); PG8_STAGE_A(PG8_SA(1, 0), cA + kstep, 0, cG); PG8_STAGE(PG8_SB(1, 1), cB + hstepB + kstep, voffB);
    PG8_WAIT_V(6); PG8_BAR;
    for (;;) {
        Unit nxt; const bool has_next = S.next(ui + 1, nxt);
        if constexpr (GATHER) { unsigned nG[2][2];
            if (has_next) { PG8_GOFF(nG, nxt); } else {
#pragma unroll
            for (int h = 0; h < 2; ++h)
#pragma unroll
                for (int i = 0; i < 2; ++i) nG[h][i] = cG[h][i]; }
            *gstash = (u32x4){nG[0][0], nG[0][1], nG[1][0], nG[1][1]}; }
        const char* nA = has_next ? nxt.pA : cA; const char* nB = has_next ? nxt.pB : cB;
        for (int t = 0; t < nt; t += 2) {
            const bool last = (t == nt - 2);
            const char* a1 = cA + (size_t)(t + 1) * kstep;
            const char* a2 = last ? nA : cA + (size_t)(t + 2) * kstep; const char* a3 = a2 + kstep;
            const char* b2 = last ? nB : PG8_BPTR(cur, t + 2); const char* b3 = b2 + kstep;
            unsigned g2[2][2];
            if constexpr (GATHER) {
                if (last) { const u32x4 st = *gstash; g2[0][0] = st.x; g2[0][1] = st.y; g2[1][0] = st.z; g2[1][1] = st.w; }
                else {
#pragma unroll
                for (int h = 0; h < 2; ++h)
#pragma unroll
                    for (int i = 0; i < 2; ++i) g2[h][i] = cG[h][i]; } }
            PG8_LDB(B0, 0, 0); PG8_LDB(B1, 0, 1); PG8_SCHED; PG8_LDA(At, 0, 0); PG8_STAGE_A(PG8_SA(1, 1), a1, 1, cG);
            PG8_WAIT_V(8); PG8_WAIT_L(0); PG8_BAR; PG8_MMA(0, 0, At, B0); PG8_MMA(0, 1, At, B1); PG8_BAR; PG8_SCHED;
            PG8_LDA(At, 0, 1); PG8_STAGE(PG8_SB(0, 0), b2, voffB); PG8_STAGE(PG8_SB(0, 1), b2 + hstepB, voffB); PG8_STAGE_A(PG8_SA(0, 0), a2, 0, g2);
            PG8_WAIT_V(8); PG8_WAIT_L(0); PG8_BAR; PG8_MMA(1, 0, At, B0); PG8_MMA(1, 1, At, B1); PG8_BAR; PG8_SCHED;
            PG8_LDB(B0, 1, 0); PG8_LDB(B1, 1, 1); PG8_SCHED; PG8_LDA(At, 1, 0); PG8_STAGE_A(PG8_SA(0, 1), a2, 1, g2);
            PG8_WAIT_V(8); PG8_WAIT_L(0); PG8_BAR; PG8_MMA(0, 0, At, B0); PG8_MMA(0, 1, At, B1); PG8_BAR; PG8_SCHED;
            PG8_LDA(At, 1, 1); PG8_STAGE(PG8_SB(1, 0), b3, voffB); PG8_STAGE(PG8_SB(1, 1), b3 + hstepB, voffB); PG8_STAGE_A(PG8_SA(1, 0), a3, 0, g2);
            PG8_WAIT_V(8); PG8_WAIT_L(0); PG8_BAR; PG8_MMA(1, 0, At, B0); PG8_MMA(1, 1, At, B1); PG8_BAR; PG8_SCHED;
        }
        if (wr == 0) PG8_BAR;
        E(acc, cur, wr, wc, fr, fq);
        if (!has_next) break;
#pragma unroll
        for (int a = 0; a < 2; ++a)
#pragma unroll
            for (int b = 0; b < 2; ++b)
#pragma unroll
                for (int m = 0; m < 4; ++m)
#pragma unroll
                    for (int n = 0; n < 2; ++n) acc[a][b][m][n] = (f32x4){0.f, 0.f, 0.f, 0.f};
        ++ui; (void)S.next(ui, cur); cA = nA; cB = nB;
        if constexpr (GATHER) { const u32x4 st = *gstash; cG[0][0] = st.x; cG[0][1] = st.y; cG[1][0] = st.z; cG[1][1] = st.w; }
        if (wr == 1) PG8_BAR;
    }
    PG8_WAIT_V(0);
    PG8_BAR;
#undef PG8_SA
#undef PG8_SB
#undef PG8_STAGE
#undef PG8_LDA
#undef PG8_LDB
#undef PG8_MMA
#undef PG8_WAIT_V
#undef PG8_WAIT_L
#undef PG8_BAR
#undef PG8_SCHED
#undef PG8_GOFF
#undef PG8_STAGE_A
#undef PG8_BPTR
}

typedef const f32x4 (&AccRef)[2][2][4][2];
#define EPI_ROW(u, ai, m) ((u).pm * BM + (ai) * HALF + wr * 64 + (m) * 16 + fr)
#define EPI_COL(u, bj) ((u).pn * BM + (bj) * HALF + wc * 32 + fq * 8)
__device__ __forceinline__ u32x4 pack8(const f32x4& a, const f32x4& b) { u32x4 w; w.x = cvt_pk_bf16(a[0], a[1]); w.y = cvt_pk_bf16(a[2], a[3]); w.z = cvt_pk_bf16(b[0], b[1]); w.w = cvt_pk_bf16(b[2], b[3]); return w; }
__device__ __forceinline__ float sq8(const f32x4& a, const f32x4& b) { return (a[0] * a[0] + a[1] * a[1]) + (a[2] * a[2] + a[3] * a[3]) + (b[0] * b[0] + b[1] * b[1]) + (b[2] * b[2] + b[3] * b[3]); }
__device__ __forceinline__ void unpack8(const u32x4& w, f32x4& a, f32x4& b) { a = (f32x4){bflo(w.x), bfhi(w.x), bflo(w.y), bfhi(w.y)}; b = (f32x4){bflo(w.z), bfhi(w.z), bflo(w.w), bfhi(w.w)}; }

struct EpiBf16 {
    bf16_t* O; int ldc;
    __device__ __forceinline__ void operator()(AccRef acc, const Unit& u, int wr, int wc, int fr, int fq) const {
#pragma unroll
        for (int ai = 0; ai < 2; ++ai)
#pragma unroll
            for (int m = 0; m < 4; ++m) { bf16_t* rowp = O + (size_t)EPI_ROW(u, ai, m) * ldc;
#pragma unroll
                for (int bj = 0; bj < 2; ++bj) *(u32x4*)(rowp + EPI_COL(u, bj)) = pack8(acc[ai][bj][m][0], acc[ai][bj][m][1]); }
    }
};
struct EpiInAb {
    bf16_t* Z;
    __device__ __forceinline__ void operator()(AccRef acc, const Unit& u, int wr, int wc, int fr, int fq) const {
        if (u.pn >= 10) {
#pragma unroll
            for (int ai = 0; ai < 2; ++ai)
#pragma unroll
                for (int m = 0; m < 4; ++m) { bf16_t* rowp = Z + (size_t)EPI_ROW(u, ai, m) * ZW;
                    const f32x4 a = acc[ai][0][m][0] * acc[ai][1][m][0], b = acc[ai][0][m][1] * acc[ai][1][m][1];
                    *(u32x4*)(rowp + 2560 + (u.pn - 10) * HALF + wc * 32 + fq * 8) = pack8(a, b); }
        } else if (u.pn < 2) {
#pragma unroll
            for (int ai = 0; ai < 2; ++ai)
#pragma unroll
                for (int m = 0; m < 4; ++m) { bf16_t* rowp = Z + (size_t)EPI_ROW(u, ai, m) * ZW;
#pragma unroll
                    for (int bj = 0; bj < 2; ++bj) { f32x4 a = acc[ai][bj][m][0], b = acc[ai][bj][m][1];
#pragma unroll
                        for (int j = 0; j < 4; ++j) { a[j] = siluf_(a[j]); b[j] = siluf_(b[j]); }
                        *(u32x4*)(rowp + EPI_COL(u, bj)) = pack8(a, b); }
                    asm volatile("" ::: "memory"); }
        } else {
#pragma unroll
            for (int ai = 0; ai < 2; ++ai)
#pragma unroll
                for (int m = 0; m < 4; ++m) { bf16_t* rowp = Z + (size_t)EPI_ROW(u, ai, m) * ZW;
#pragma unroll
                    for (int bj = 0; bj < 2; ++bj) *(u32x4*)(rowp + EPI_COL(u, bj)) = pack8(acc[ai][bj][m][0], acc[ai][bj][m][1]); }
        }
    }
};
struct EpiRes {
    const float* X; float* O; const float* bias; bf16_t* HB;
    __device__ __forceinline__ void operator()(AccRef acc, const Unit& u, int wr, int wc, int fr, int fq) const {
        f32x4 bv[2][2];
#pragma unroll
        for (int bj = 0; bj < 2; ++bj) { const int c = EPI_COL(u, bj); bv[bj][0] = bias ? *(const f32x4*)(bias + c) : (f32x4){0.f, 0.f, 0.f, 0.f}; bv[bj][1] = bias ? *(const f32x4*)(bias + c + 4) : (f32x4){0.f, 0.f, 0.f, 0.f}; }
#pragma unroll
        for (int ai = 0; ai < 2; ++ai) { f32x4 xv[4][2][2];
#pragma unroll
            for (int m = 0; m < 4; ++m) { const size_t ro = (size_t)EPI_ROW(u, ai, m) * D;
#pragma unroll
                for (int bj = 0; bj < 2; ++bj) { const int c = EPI_COL(u, bj); xv[m][bj][0] = *(const f32x4*)(X + ro + c); xv[m][bj][1] = *(const f32x4*)(X + ro + c + 4); } }
#pragma unroll
            for (int m = 0; m < 4; ++m) { const size_t ro = (size_t)EPI_ROW(u, ai, m) * D;
#pragma unroll
                for (int bj = 0; bj < 2; ++bj) { const int c = EPI_COL(u, bj);
                    const f32x4 h0 = xv[m][bj][0] + bv[bj][0] + acc[ai][bj][m][0], h1 = xv[m][bj][1] + bv[bj][1] + acc[ai][bj][m][1];
                    *(f32x4*)(O + ro + c) = h0; *(f32x4*)(O + ro + c + 4) = h1; *(u32x4*)(HB + ro + c) = pack8(h0, h1); } }
            asm volatile("" ::: "memory"); }
    }
};
__device__ __forceinline__ float rstd16(const float* ss, int row) {
    const f32x4* p = (const f32x4*)(ss + (size_t)row * 16); const f32x4 a = p[0], b = p[1], c = p[2], d = p[3];
    const float s = ((a[0] + a[1]) + (a[2] + a[3])) + ((b[0] + b[1]) + (b[2] + b[3])) + ((c[0] + c[1]) + (c[2] + c[3])) + ((d[0] + d[1]) + (d[2] + d[3]));
    return __builtin_amdgcn_rsqf(s * (1.f / D) + EPS);
}
constexpr int RSL_OFF = 135168;
template <class Sched> __device__ __forceinline__ void rstd_table(LAS unsigned char* lds, const int tid_in, const Sched& S, const float* ss) {
    LAS float* RSL = (LAS float*)(lds + RSL_OFF); int tid = tid_in; asm volatile("" : "+v"(tid));
    for (int i = tid >> 8; i < 8; i += 2) { Unit u; if (!S.next(i, u)) break; RSL[i * 256 + (tid & 255)] = rstd16(ss, u.pm * BM + (tid & 255)); }
    __syncthreads();
}
struct EpiQkv {
    bf16_t* O; const float* bias; const LAS float* RSL;
    __device__ __forceinline__ void operator()(AccRef acc, const Unit& u, int wr, int wc, int fr, int fq) const {
        float rs[2][4];
#pragma unroll
        for (int ai = 0; ai < 2; ++ai)
#pragma unroll
            for (int m = 0; m < 4; ++m) rs[ai][m] = RSL[u.aux * 256 + ai * HALF + wr * 64 + m * 16 + fr];
        f32x4 bv[2][2];
#pragma unroll
        for (int bj = 0; bj < 2; ++bj) { const int c = EPI_COL(u, bj); bv[bj][0] = *(const f32x4*)(bias + c); bv[bj][1] = *(const f32x4*)(bias + c + 4); }
#pragma unroll
        for (int ai = 0; ai < 2; ++ai)
#pragma unroll
            for (int m = 0; m < 4; ++m) { bf16_t* rowp = O + (size_t)EPI_ROW(u, ai, m) * CIN;
#pragma unroll
                for (int bj = 0; bj < 2; ++bj) *(u32x4*)(rowp + EPI_COL(u, bj)) = pack8(acc[ai][bj][m][0] * rs[ai][m] + bv[bj][0], acc[ai][bj][m][1] * rs[ai][m] + bv[bj][1]); }
    }
};
struct EpiG1 {
    bf16_t* HID; const f32x2* wl; const float* rl;
    __device__ __forceinline__ void operator()(AccRef acc, const Unit& u, int wr, int wc, int fr, int fq) const {
        float wv[2][4], rv[2][4];
#pragma unroll
        for (int ai = 0; ai < 2; ++ai)
#pragma unroll
            for (int m = 0; m < 4; ++m) { const int rit = ai * HALF + wr * 64 + m * 16 + fr; const f32x2 w2 = wl[(size_t)u.aux + rit]; wv[ai][m] = (u.pn < 4) ? w2.x : w2.y; rv[ai][m] = rl[(size_t)u.aux + rit]; }
#pragma unroll
        for (int ai = 0; ai < 2; ++ai)
#pragma unroll
            for (int m = 0; m < 4; ++m) { const int rit = ai * HALF + wr * 64 + m * 16 + fr;
                const float rs = rv[ai][m], wrs = wv[ai][m] * rs;
                bf16_t* rowp = HID + (size_t)(u.pm * BM + rit) * 1024 + (u.pn >> 2) * 512 + (u.pn & 3) * HALF + wc * 32 + fq * 8;
                f32x4 a, b;
#pragma unroll
                for (int j = 0; j < 4; ++j) { a[j] = siluf_(acc[ai][0][m][0][j] * rs) * acc[ai][1][m][0][j] * wrs; b[j] = siluf_(acc[ai][0][m][1][j] * rs) * acc[ai][1][m][1][j] * wrs; }
                *(u32x4*)rowp = pack8(a, b); }
    }
};
struct EpiG2 {
    float* H; bf16_t* HB; float* SS;
    __device__ __forceinline__ void operator()(AccRef acc, const Unit& u, int wr, int wc, int fr, int fq) const {
        int tk[2][4];
#pragma unroll
        for (int ai = 0; ai < 2; ++ai)
#pragma unroll
            for (int m = 0; m < 4; ++m) { const int rit = ai * HALF + wr * 64 + m * 16 + fr; tk[ai][m] = (rit < u.nv) ? u.lst[rit] : -1; }
#pragma unroll
        for (int ai = 0; ai < 2; ++ai) { f32x4 hv[4][2][2];
#pragma unroll
            for (int m = 0; m < 4; ++m) { const int tok = tk[ai][m]; const size_t ro = (size_t)(tok < 0 ? 0 : tok) * D;
#pragma unroll
                for (int bj = 0; bj < 2; ++bj) { const int c = EPI_COL(u, bj); hv[m][bj][0] = *(const f32x4*)(H + ro + c); hv[m][bj][1] = *(const f32x4*)(H + ro + c + 4); } }
#pragma unroll
            for (int m = 0; m < 4; ++m) { const int tok = tk[ai][m]; const bool ok = tok >= 0; const size_t ro = (size_t)(ok ? tok : 0) * D; float part = 0.f;
#pragma unroll
                for (int bj = 0; bj < 2; ++bj) { const int c = EPI_COL(u, bj);
                    const f32x4 h0 = hv[m][bj][0] + acc[ai][bj][m][0], h1 = hv[m][bj][1] + acc[ai][bj][m][1];
                    if (ok) { *(f32x4*)(H + ro + c) = h0; *(f32x4*)(H + ro + c + 4) = h1; *(u32x4*)(HB + ro + c) = pack8(h0, h1); } part += sq8(h0, h1); }
                part += __shfl_xor(part, 16); part += __shfl_xor(part, 32);
                if (ok && fq == 0) SS[(size_t)tok * 16 + u.pn * 4 + wc] = part; }
            asm volatile("" ::: "memory"); }
    }
};
struct EpiPle {
    float* H; bf16_t* HB; const bf16_t* PP; const LAS float* RSL; float* sso;
    __device__ __forceinline__ void operator()(AccRef acc, const Unit& u, int wr, int wc, int fr, int fq) const {
#pragma unroll
        for (int ai = 0; ai < 2; ++ai)
#pragma unroll
            for (int mp = 0; mp < 2; ++mp) { f32x4 hv[2][2][2]; u32x4 pv[2][2];
#pragma unroll
                for (int mm = 0; mm < 2; ++mm) { const size_t ro = (size_t)EPI_ROW(u, ai, 2 * mp + mm) * D;
#pragma unroll
                    for (int bj = 0; bj < 2; ++bj) { const int c = EPI_COL(u, bj); hv[mm][bj][0] = *(const f32x4*)(H + ro + c); hv[mm][bj][1] = *(const f32x4*)(H + ro + c + 4); pv[mm][bj] = *(const u32x4*)(PP + ro + c); } }
#pragma unroll
                for (int mm = 0; mm < 2; ++mm) { const int m = 2 * mp + mm; const int row = EPI_ROW(u, ai, m); const size_t ro = (size_t)row * D; const float r_ = RSL[u.aux * 256 + ai * HALF + wr * 64 + m * 16 + fr]; float part = 0.f;
#pragma unroll
                    for (int bj = 0; bj < 2; ++bj) { const int c = EPI_COL(u, bj);
                        f32x4 p0, p1; unpack8(pv[mm][bj], p0, p1); f32x4 h0 = hv[mm][bj][0], h1 = hv[mm][bj][1];
#pragma unroll
                        for (int j = 0; j < 4; ++j) { h0[j] += sigmoidf_(acc[ai][bj][m][0][j] * r_) * p0[j]; h1[j] += sigmoidf_(acc[ai][bj][m][1][j] * r_) * p1[j]; }
                        *(f32x4*)(H + ro + c) = h0; *(f32x4*)(H + ro + c + 4) = h1; *(u32x4*)(HB + ro + c) = pack8(h0, h1); part += sq8(h0, h1); }
                    part += __shfl_xor(part, 16); part += __shfl_xor(part, 32);
                    if (fq == 0) sso[(size_t)row * 16 + u.pn * 4 + wc] = part; }
                asm volatile("" ::: "memory"); }
    }
};
}

#define XB_TMO      128
#define XB_XCNT(j)  (256  + 64 * (j))
#define XB_XSUB(j)  (1280 + 64 * (j))
#define XB_XGEN(j)  (2304 + 64 * (j))
#define XB_TOP      3328
#define XB_TOPGEN   3392
#define XCD_BAR_WORDS 3456
#define XB_SPIN_CAP (1u << 18)
__device__ __forceinline__ unsigned xb_ld(unsigned* p)              { return __hip_atomic_load(p, __ATOMIC_RELAXED, __HIP_MEMORY_SCOPE_AGENT); }
__device__ __forceinline__ unsigned xb_add(unsigned* p, unsigned v) { return __hip_atomic_fetch_add(p, v, __ATOMIC_RELAXED, __HIP_MEMORY_SCOPE_AGENT); }
__device__ __forceinline__ unsigned xb_xcc_id() { return (unsigned)__builtin_amdgcn_s_getreg((3 << 11) | 20) & 0xFu; }
#define XB_SPIN(cond, bar) do { unsigned _sp = 0; while (cond) { __builtin_amdgcn_s_sleep(1); \
    if ((++_sp & 255u) == 0u) { if (xb_ld(&(bar)[XB_TMO])) break; if (_sp > XB_SPIN_CAP) { atomicAdd(&(bar)[XB_TMO], 1u); break; } } } } while (0)
struct XcdBarrier { unsigned* bar; unsigned x; volatile LAS unsigned* st; int w0; };
__device__ __forceinline__ bool xb_tid0(int w0) { return w0 == 0 && __builtin_amdgcn_mbcnt_hi(~0u, __builtin_amdgcn_mbcnt_lo(~0u, 0u)) == 0u; }
__device__ __forceinline__ XcdBarrier xcd_barrier_post(unsigned* bar, volatile LAS unsigned* st, int w0) {
    XcdBarrier b; b.bar = bar; b.x = (unsigned)__builtin_amdgcn_readfirstlane((int)xb_xcc_id()); b.st = st; b.w0 = w0;
    if (xb_tid0(w0)) (void)xb_add(&bar[XB_XCNT(b.x)], 1u);
    return b;
}
__device__ __forceinline__ void xcd_barrier_complete(unsigned* bar, unsigned x, unsigned& nloc, unsigned& nx) {
    const unsigned G = gridDim.x * gridDim.y * gridDim.z;
    unsigned sum, cnt, mine, sp = 0u;
    for (;;) {
        sum = 0u; cnt = 0u; mine = 0u;
#pragma unroll
        for (unsigned j = 0; j < 16; ++j) { const unsigned c = xb_ld(&bar[XB_XCNT(j)]); sum += c; cnt += (c > 0u) ? 1u : 0u; mine = (j == x) ? c : mine; }
        if (sum == G) break;
        __builtin_amdgcn_s_sleep(1);
        if ((++sp & 255u) == 0u) { if (xb_ld(&bar[XB_TMO])) break; if (sp > XB_SPIN_CAP) { atomicAdd(&bar[XB_TMO], 1u); break; } }
    }
    nloc = mine > 0u ? mine : 1u; nx = cnt > 0u ? cnt : 1u;
}
__device__ __forceinline__ void xcd_barrier(const XcdBarrier& b) {
    asm volatile("s_waitcnt vmcnt(0)" ::: "memory");
    __syncthreads();
    if (xb_tid0(b.w0)) {
        unsigned* bar = b.bar; asm volatile("" : "+s"(bar));
        __builtin_amdgcn_s_waitcnt(0);
        unsigned nloc = b.st[0], nx = b.st[1];
        if (nloc == 0u) { xcd_barrier_complete(bar, b.x, nloc, nx); b.st[0] = nloc; b.st[1] = nx; }
        const unsigned old = xb_add(&bar[XB_XSUB(b.x)], 1u);
        const unsigned gen = old / nloc;
        if (old + 1u == (gen + 1u) * nloc) {
            __builtin_amdgcn_fence(__ATOMIC_RELEASE, "agent");
            asm volatile("s_waitcnt vmcnt(0)" ::: "memory");
            const unsigned og = xb_add(&bar[XB_TOP], 1u);
            const unsigned tg = og / nx;
            if (og + 1u == (tg + 1u) * nx) xb_add(&bar[XB_TOPGEN], 1u);
            else XB_SPIN(xb_ld(&bar[XB_TOPGEN]) == tg, bar);
            __builtin_amdgcn_fence(__ATOMIC_ACQUIRE, "agent");
            xb_add(&bar[XB_XGEN(b.x)], 1u);
            asm volatile("s_waitcnt vmcnt(0)" ::: "memory");
        } else {
            XB_SPIN(xb_ld(&bar[XB_XGEN(b.x)]) == gen, bar);
            __builtin_amdgcn_fence(__ATOMIC_ACQUIRE, "agent");
            asm volatile("s_waitcnt vmcnt(0)" ::: "memory");
        }
    }
    __syncthreads();
}

struct Args {
    const float* x; const float* p; const float* norm_mix; const float* norm_ffn; const float* norm_ple; const float* norm_final;
    const float* w_in_ab; const float* lb_logits; const float* hgrn_out_norm; const float* conv_w; const float* w_out_ab;
    const float* w_in_c; const float* b_in_c; const float* sinks; const float* w_out_c; const float* b_out_c;
    const float* w_router; const float* w_gate_e; const float* w_up_e; const float* w_down_e; const float* w_ple_gate; const float* w_ple_proj;
    float* out; unsigned char* ws; int ph_lo, ph_hi;
};
struct Frame { LAS unsigned char* lds; int tid, lane, wave, vcu, G; };

__device__ __forceinline__ void transpose_item(const float* W, int N, int src_n0, int k0, bf16_t* dst  , int ldk, const float* gs, LAS float* scr, int lane) {
#pragma unroll 8
    for (int i = 0; i < 32; ++i) { const int kk = 2 * i + (lane >> 5); scr[kk * 33 + (lane & 31)] = W[(size_t)(k0 + kk) * N + src_n0 + (lane & 31)]; }
    LDS_WAIT(); asm volatile("" ::: "memory");
    const int c = lane & 7;
    float g8[8];
#pragma unroll
    for (int q = 0; q < 8; ++q) g8[q] = gs ? gs[k0 + 8 * c + q] : 1.f;
#pragma unroll
    for (int j = 0; j < 4; ++j) { const int n = (lane >> 3) + 8 * j; const LAS float* s = scr + (8 * c) * 33 + n;
        u32x4 o; o.x = pk2(s[0 * 33] * g8[0], s[1 * 33] * g8[1]); o.y = pk2(s[2 * 33] * g8[2], s[3 * 33] * g8[3]); o.z = pk2(s[4 * 33] * g8[4], s[5 * 33] * g8[5]); o.w = pk2(s[6 * 33] * g8[6], s[7 * 33] * g8[7]);
        *(u32x4*)(dst + (size_t)n * ldk + k0 + 8 * c) = o; }
    LDS_WAIT(); asm volatile("" ::: "memory");
}
__device__ __forceinline__ void phase_prep(const Frame& F, const Args& a) {
    unsigned char* ws = a.ws;
    LAS float* scr = (LAS float*)(F.lds + F.wave * 16384);
    const int gw = F.vcu * NWAVES + F.wave, NGW = F.G * NWAVES;
    constexpr int I_INAB = 16 * (ABIN / 32), I_SQ = 16 * 32, I_INC = 16 * (CIN / 32), I_PP = 4 * 32, I_W1 = 16 * 32, I_W2 = 8 * 32;
    constexpr int T0 = I_INAB, T1 = T0 + I_SQ, T2 = T1 + I_INC, T3 = T2 + I_SQ, T4 = T3 + 2 * I_SQ, T5 = T4 + 2 * I_PP, T6 = T5 + 32 * I_W1, T7 = T6 + 32 * I_W2;
    for (int it = gw; it < T7; it += NGW) {
        if (it < T0) { const int kb = it / (ABIN / 32), nb = it % (ABIN / 32), n0 = nb * 32; int src;
            if (n0 < 2560) src = n0; else { const int q = (n0 - 2560) >> 8, r = (n0 - 2560) & 255; src = (r < 128) ? 2560 + q * 128 + r : 3072 + q * 128 + (r - 128); }
            transpose_item(a.w_in_ab, ABIN, src, kb * 64, (bf16_t*)(ws + WS_WINAB) + (size_t)n0 * D, D, a.norm_mix, scr, F.lane); }
        else if (it < T1) { const int r = it - T0, kb = r / 32, nb = r % 32; transpose_item(a.w_out_ab, D, nb * 32, kb * 64, (bf16_t*)(ws + WS_WOUTAB) + (size_t)nb * 32 * D, D, nullptr, scr, F.lane); }
        else if (it < T2) { const int r = it - T1, kb = r / (CIN / 32), nb = r % (CIN / 32); transpose_item(a.w_in_c, CIN, nb * 32, kb * 64, (bf16_t*)(ws + WS_WINC) + (size_t)nb * 32 * D, D, a.norm_mix + D, scr, F.lane); }
        else if (it < T3) { const int r = it - T2, kb = r / 32, nb = r % 32; transpose_item(a.w_out_c, D, nb * 32, kb * 64, (bf16_t*)(ws + WS_WOUTC) + (size_t)nb * 32 * D, D, nullptr, scr, F.lane); }
        else if (it < T4) { const int r = it - T3, l = r / I_SQ, q = r % I_SQ, kb = q / 32, nb = q % 32;
            transpose_item(a.w_ple_gate + (size_t)l * D * D, D, nb * 32, kb * 64, (bf16_t*)(ws + WS_WPG) + (size_t)l * D * D + (size_t)nb * 32 * D, D, a.norm_ple + l * D, scr, F.lane); }
        else if (it < T5) { const int r = it - T4, l = r / I_PP, q = r % I_PP, kb = q / 32, nb = q % 32;
            transpose_item(a.w_ple_proj + (size_t)l * PLE * D, D, nb * 32, kb * 64, (bf16_t*)(ws + WS_WPP) + (size_t)l * D * PLE + (size_t)nb * 32 * PLE, PLE, nullptr, scr, F.lane); }
        else if (it < T6) { const int r = it - T5, le = r / I_W1, q = r % I_W1, kb = q / 32, nb = q % 32, n0 = nb * 32, uq = n0 >> 8, rr = n0 & 255;
            const float* src = (rr < 128) ? a.w_gate_e + (size_t)le * D * DE : a.w_up_e + (size_t)le * D * DE; const int sn = uq * 128 + (rr & 127);
            transpose_item(src, DE, sn, kb * 64, (bf16_t*)(ws + WS_W1) + (size_t)le * D * D + (size_t)n0 * D, D, a.norm_ffn + (le >> 4) * D, scr, F.lane); }
        else { const int r = it - T6, le = r / I_W2, q = r % I_W2, kb = q / 32, nb = q % 32;
            transpose_item(a.w_down_e + (size_t)le * DE * D, D, nb * 32, kb * 64, (bf16_t*)(ws + WS_W2) + (size_t)le * D * DE + (size_t)nb * 32 * DE, DE, nullptr, scr, F.lane); }
    }
    const int gt = F.vcu * NTHR + F.tid, NGT = F.G * NTHR;
    if (gt < AW) { const float l0 = a.lb_logits[gt], l1 = a.lb_logits[AW + gt], l2 = a.lb_logits[2 * AW + gt]; const float mx = fmaxf(l0, fmaxf(l1, l2));
        const float e0 = __expf(l0 - mx), e1 = __expf(l1 - mx), e2 = __expf(l2 - mx); ((float*)(ws + WS_LB))[gt] = e0 / (e0 + e1 + e2); }
    { const f32x4* src = (const f32x4*)a.p; u32x4* dst = (u32x4*)(ws + WS_PB); const int n8 = 2 * NT * PLE / 8;
        for (int i = gt; i < n8; i += NGT) { const f32x4 v0 = src[2 * i], v1 = src[2 * i + 1]; u32x4 o; o.x = pk2(v0[0], v0[1]); o.y = pk2(v0[2], v0[3]); o.z = pk2(v1[0], v1[1]); o.w = pk2(v1[2], v1[3]); dst[i] = o; } }
    for (int m = gw; m < NT; m += NGW) { const f32x4* xr = (const f32x4*)(a.x + (size_t)m * D) + F.lane; f32x4 v[4]; float s = 0.f;
#pragma unroll
        for (int j = 0; j < 4; ++j) { v[j] = xr[64 * j]; s += (v[j][0] * v[j][0] + v[j][1] * v[j][1]) + (v[j][2] * v[j][2] + v[j][3] * v[j][3]); }
        const float rs = __builtin_amdgcn_rsqf(wave_sum(s) * (1.f / D) + EPS);
        u32x2* o8 = (u32x2*)((bf16_t*)(ws + WS_XA) + (size_t)m * D) + F.lane;
#pragma unroll
        for (int j = 0; j < 4; ++j) { u32x2 o; o.x = pk2(v[j][0] * rs, v[j][1] * rs); o.y = pk2(v[j][2] * rs, v[j][3] * rs); o8[64 * j] = o; } }
}

__device__ __forceinline__ void phase_hgrn_conv(const Frame& F, const Args& a) {
    unsigned char* ws = a.ws; const bf16_t* Z = (const bf16_t*)(ws + WS_Z); bf16_t* XA = (bf16_t*)(ws + WS_XA); const float* lbv = (const float*)(ws + WS_LB);
    LAS float* FG = (LAS float*)F.lds; LAS float* KK = FG + 4096; LAS float* QQ = KK + 4096; LAS float* VV = QQ + 4096; LAS float* OB = VV + 4096;
    const int tid = F.tid, lane = F.lane, w = F.wave;
    for (int it = F.vcu; it < NB * AH; it += F.G) {
        const int b = it >> 2, h = it & 3; const size_t row0 = (size_t)b * SEQ;
        const int vi = lane & 15, dq = lane >> 4, v = 16 * w + vi;
        float s[32];
#pragma unroll
        for (int i = 0; i < 32; ++i) s[i] = 0.f;
        const int ltt = tid >> 4, ldd = (tid & 15) * 8;
        float lb8[8], gn8[8];
#pragma unroll
        for (int j = 0; j < 8; ++j) { lb8[j] = lbv[h * ADK + ldd + j]; gn8[j] = a.hgrn_out_norm[ldd + j]; }
        for (int c = 0; c < SEQ / 32; ++c) {
            { const bf16_t* zr = Z + (row0 + c * 32 + ltt) * ZW + h * ADK + ldd;
                const u32x4 wq = *(const u32x4*)zr, wf = *(const u32x4*)(zr + 512), wv = *(const u32x4*)(zr + 1024);
                f32x4 q0, q1, f0, f1, v0, v1; pg8::unpack8(wq, q0, q1); pg8::unpack8(wf, f0, f1); pg8::unpack8(wv, v0, v1);
                f32x4 g0, g1, k0, k1;
#pragma unroll
                for (int j = 0; j < 4; ++j) { g0[j] = lb8[j] + (1.f - lb8[j]) * sigmoidf_(f0[j]); g1[j] = lb8[4 + j] + (1.f - lb8[4 + j]) * sigmoidf_(f1[j]); k0[j] = 1.f - g0[j]; k1[j] = 1.f - g1[j]; }
                const int o = ltt * 128 + ldd;
                *(LAS f32x4*)(FG + o) = g0; *(LAS f32x4*)(FG + o + 4) = g1; *(LAS f32x4*)(KK + o) = k0; *(LAS f32x4*)(KK + o + 4) = k1;
                *(LAS f32x4*)(QQ + o) = q0; *(LAS f32x4*)(QQ + o + 4) = q1; *(LAS f32x4*)(VV + o) = v0; *(LAS f32x4*)(VV + o + 4) = v1; }
            __syncthreads();
            for (int tt = 0; tt < 32; ++tt) {
                const float vt = VV[tt * 128 + v]; float acc = 0.f;
                const LAS f32x4* fg = (const LAS f32x4*)(FG + tt * 128 + dq * 32); const LAS f32x4* kk = (const LAS f32x4*)(KK + tt * 128 + dq * 32); const LAS f32x4* qq = (const LAS f32x4*)(QQ + tt * 128 + dq * 32);
#pragma unroll
                for (int d4 = 0; d4 < 8; ++d4) { const f32x4 f4 = fg[d4], k4 = kk[d4], q4 = qq[d4];
#pragma unroll
                    for (int j = 0; j < 4; ++j) { s[d4 * 4 + j] = f4[j] * s[d4 * 4 + j] + k4[j] * vt; acc += s[d4 * 4 + j] * q4[j]; } }
                acc += __shfl_xor(acc, 16); acc += __shfl_xor(acc, 32);
                if (dq == 0) OB[tt * 128 + v] = acc;
            }
            __syncthreads();
            { const f32x4 o0 = *(const LAS f32x4*)(OB + ltt * 128 + ldd), o1 = *(const LAS f32x4*)(OB + ltt * 128 + ldd + 4);
                float ss = pg8::sq8(o0, o1); ss += __shfl_xor(ss, 1); ss += __shfl_xor(ss, 2); ss += __shfl_xor(ss, 4); ss += __shfl_xor(ss, 8);
                const float rs = __builtin_amdgcn_rsqf(ss * (1.f / 128.f) + EPS);
                const size_t row = row0 + c * 32 + ltt; f32x4 g0, g1; pg8::unpack8(*(const u32x4*)(Z + row * ZW + 1536 + h * ADK + ldd), g0, g1);
                f32x4 r0, r1;
#pragma unroll
                for (int j = 0; j < 4; ++j) { r0[j] = o0[j] * rs * gn8[j] * sigmoidf_(g0[j]); r1[j] = o1[j] * rs * gn8[4 + j] * sigmoidf_(g1[j]); }
                u32x4 o; o.x = pk2(r0[0], r0[1]); o.y = pk2(r0[2], r0[3]); o.z = pk2(r1[0], r1[1]); o.w = pk2(r1[2], r1[3]);
                *(u32x4*)(XA + row * D + h * ADK + ldd) = o; }
        }
        __syncthreads();
    }
}

typedef short s16x4 __attribute__((ext_vector_type(4)));
constexpr int SEGT = 512, NSEG = SEQ / SEGT, NCH = SEGT / 32;
constexpr int HROW = 272, HL_TS = 32 * HROW;
constexpr int HL_LF = 0, HL_T = 16384, HL_DEC = 18432, HL_SUM = 18944, HL_QD = 20480, HL_KI = HL_QD + HL_TS, HL_KT = HL_KI + HL_TS, HL_VV = HL_KT + HL_TS, HL_OB = HL_VV + HL_TS;
__device__ __forceinline__ s16x4 lds_tr(const LAS unsigned char* p) { return __builtin_bit_cast(s16x4, __builtin_amdgcn_ds_read_tr16_b64_v4i16((LAS s16x4*)p)); }
__device__ __forceinline__ bf16x8 cat44(s16x4 a, s16x4 b) { return (bf16x8){a[0], a[1], a[2], a[3], b[0], b[1], b[2], b[3]}; }
__device__ __forceinline__ bf16x8 pk8(const f32x4& a, const f32x4& b) { return __builtin_bit_cast(bf16x8, pg8::pack8(a, b)); }
#define MFMA16(A, B, C) __builtin_amdgcn_mfma_f32_16x16x32_bf16(A, B, C, 0, 0, 0)
#ifndef HGRN_SELF
#define HGRN_SELF 0
#endif
#ifndef HGRN_CHECK
#define HGRN_CHECK 0
#endif
template <bool FULL>
__device__ __forceinline__ void hgrn_pass(const Frame& F, const Args& a) {
    unsigned char* ws = a.ws; const bf16_t* Z = (const bf16_t*)(ws + WS_Z); bf16_t* XA = (bf16_t*)(ws + WS_XA); const float* lbv = (const float*)(ws + WS_LB);
    float* HLg = (float*)(ws + WS_HL); float* HSg = (float*)(ws + WS_HSUM);
    LAS unsigned char* L = F.lds;
    LAS float* LF = (LAS float*)(L + HL_LF); LAS float* TT = (LAS float*)(L + HL_T); LAS float* DEC = (LAS float*)(L + HL_DEC); LAS float* SUM = (LAS float*)(L + HL_SUM); LAS float* OB = (LAS float*)(L + HL_OB);
    const LAS unsigned char* QD = L + HL_QD; const LAS unsigned char* KI = L + HL_KI; const LAS unsigned char* KT = L + HL_KT; const LAS unsigned char* VV = L + HL_VV;
    const int tid = F.tid, lane = F.lane, w = F.wave, r15 = lane & 15, g = lane >> 4, trq = r15 >> 2, trp = r15 & 3;
    const int tok = tid >> 4, d0 = (tid & 15) * 8, sd = tid & 127, tq = tid >> 7, Vw0 = 16 * w;
    for (int it = F.vcu; it < NB * AH * NSEG; it += F.G) {
        const int seg = it & (NSEG - 1), h = (it >> 3) & 3, b = it >> 5;
        if (!FULL && seg == NSEG - 1) continue;
        const size_t row0 = (size_t)b * SEQ + (size_t)seg * SEGT;
        float lb8[8], gn8[8];
#pragma unroll
        for (int e = 0; e < 8; ++e) { lb8[e] = lbv[h * ADK + d0 + e]; gn8[e] = a.hgrn_out_norm[d0 + e]; }
        f32x4 S[8];
#pragma unroll
        for (int mt = 0; mt < 8; ++mt) S[mt] = (f32x4){0.f, 0.f, 0.f, 0.f};
        const int pre = (FULL && (HGRN_SELF || HGRN_CHECK)) ? seg * NCH : 0;
        float chkbad = 0.f;
        if (FULL && seg > 0 && !HGRN_SELF) {
            const __amdgpu_buffer_rsrc_t rsL = __builtin_amdgcn_make_buffer_rsrc((void*)HLg, (short)0, 256 * 16384 * 4, 0x00020000);
            const __amdgpu_buffer_rsrc_t rsS = __builtin_amdgcn_make_buffer_rsrc((void*)HSg, (short)0, 256 * 128 * 4, 0x00020000);
            f32x4 cum[8];
#pragma unroll
            for (int mt = 0; mt < 8; ++mt) cum[mt] = (f32x4){0.f, 0.f, 0.f, 0.f};
            for (int sp = seg - 1; sp >= 0; --sp) { const int ip = it - seg + sp; const int lo = (ip * 16384 + (Vw0 + r15) * 128 + 4 * g) * 4, so = (ip * 128 + 4 * g) * 4;
#pragma unroll
                for (int mt = 0; mt < 8; ++mt) { const f32x4 l4 = __builtin_bit_cast(f32x4, __builtin_amdgcn_raw_buffer_load_b128(rsL, lo + mt * 64, 0, 16)), h4 = __builtin_bit_cast(f32x4, __builtin_amdgcn_raw_buffer_load_b128(rsS, so + mt * 64, 0, 16));
#pragma unroll
                    for (int r = 0; r < 4; ++r) { S[mt][r] += __expf(cum[mt][r]) * l4[r]; cum[mt][r] += h4[r]; } } }
        }
        if (FULL && HGRN_CHECK) { LAS f32x4* SA = (LAS f32x4*)(L + 73728) + tid * 4;
#pragma unroll
            for (int mt = 0; mt < 4; ++mt) { SA[mt] = S[mt]; }
#pragma unroll
            for (int mt = 0; mt < 8; ++mt) S[mt] = (f32x4){0.f, 0.f, 0.f, 0.f}; }
        if (tid < 128) SUM[tid] = 0.f;
        const bf16_t* zr = Z + (row0 - (size_t)pre * 32 + tok) * ZW + h * ADK + d0;
        u32x4 wq = (u32x4){0u, 0u, 0u, 0u}, wg = wq, wf = *(const u32x4*)(zr + 512), wv = *(const u32x4*)(zr + 1024);
        if (FULL) { wq = *(const u32x4*)zr; wg = *(const u32x4*)(zr + 1536); }
        for (int cc = 0; cc < pre + NCH; ++cc) { const int c = cc - pre; const bool outp = FULL && (c >= 0);
            if (FULL && HGRN_CHECK && c == 0 && seg > 0) { const LAS f32x4* SA = (const LAS f32x4*)(L + 73728) + tid * 4;
#pragma unroll
                for (int mt = 0; mt < 4; ++mt) { const f32x4 sa = SA[mt];
#pragma unroll
                    for (int r = 0; r < 4; ++r) if (!(fabsf(sa[r] - S[mt][r]) <= 1e-3f + 0.02f * fabsf(S[mt][r]))) chkbad = 1.f; } }
            if (FULL && HGRN_CHECK && chkbad != 0.f) { const unsigned long long t0 = __builtin_amdgcn_s_memrealtime(); while (__builtin_amdgcn_s_memrealtime() - t0 < 10000000000ull) __builtin_amdgcn_s_sleep(64); chkbad = 0.f; }
            float kk[8], qq[8];
            { f32x4 f0, f1, q0 = (f32x4){0.f, 0.f, 0.f, 0.f}, q1 = q0; pg8::unpack8(wf, f0, f1); if (FULL) pg8::unpack8(wq, q0, q1);
                f32x4 l0, l1;
#pragma unroll
                for (int e = 0; e < 4; ++e) { const float fa = lb8[e] + (1.f - lb8[e]) * sigmoidf_(f0[e]), fb = lb8[4 + e] + (1.f - lb8[4 + e]) * sigmoidf_(f1[e]);
                    kk[e] = 1.f - fa; kk[4 + e] = 1.f - fb; l0[e] = __logf(fa); l1[e] = __logf(fb); qq[e] = q0[e]; qq[4 + e] = q1[e]; }
                *(LAS f32x4*)(LF + tok * 128 + d0) = l0; *(LAS f32x4*)(LF + tok * 128 + d0 + 4) = l1;
                *(LAS u32x4*)(L + HL_VV + tok * HROW + d0 * 2) = wv; }
            const u32x4 cg = wg;
            if (c + 1 < NCH) { const bf16_t* zn = zr + (size_t)(cc + 1) * 32 * ZW; wf = *(const u32x4*)(zn + 512); wv = *(const u32x4*)(zn + 1024); if (FULL) { wq = *(const u32x4*)zn; wg = *(const u32x4*)(zn + 1536); } }
            __syncthreads();
            { float x[8];
#pragma unroll
                for (int e = 0; e < 8; ++e) x[e] = LF[(8 * tq + e) * 128 + sd];
#pragma unroll
                for (int e = 1; e < 8; ++e) x[e] += x[e - 1];
                TT[tq * 128 + sd] = x[7];
                __syncthreads();
                const float t0 = TT[sd], t1 = TT[128 + sd], t2 = TT[256 + sd];
                const float off = (tq > 0 ? t0 : 0.f) + (tq > 1 ? t1 : 0.f) + (tq > 2 ? t2 : 0.f);
#pragma unroll
                for (int e = 0; e < 8; ++e) LF[(8 * tq + e) * 128 + sd] = x[e] + off; }
            __syncthreads();
            { const f32x4 b0 = *(const LAS f32x4*)(LF + tok * 128 + d0), b1 = *(const LAS f32x4*)(LF + tok * 128 + d0 + 4), e0 = *(const LAS f32x4*)(LF + 31 * 128 + d0), e1 = *(const LAS f32x4*)(LF + 31 * 128 + d0 + 4);
                f32x4 t0, t1, qa, qb, ia, ib;
#pragma unroll
                for (int e = 0; e < 4; ++e) { t0[e] = kk[e] * __expf(e0[e] - b0[e]); t1[e] = kk[4 + e] * __expf(e1[e] - b1[e]);
                    if (FULL) { qa[e] = qq[e] * __expf(b0[e]); qb[e] = qq[4 + e] * __expf(b1[e]); ia[e] = kk[e] * __expf(-b0[e]); ib[e] = kk[4 + e] * __expf(-b1[e]); } }
                *(LAS u32x4*)(L + HL_KT + tok * HROW + d0 * 2) = pg8::pack8(t0, t1);
                if (FULL) { *(LAS u32x4*)(L + HL_QD + tok * HROW + d0 * 2) = pg8::pack8(qa, qb); *(LAS u32x4*)(L + HL_KI + tok * HROW + d0 * 2) = pg8::pack8(ia, ib); }
                if (tok == 31) {
#pragma unroll
                    for (int e = 0; e < 4; ++e) { DEC[d0 + e] = __expf(e0[e]); DEC[d0 + 4 + e] = __expf(e1[e]); if (!FULL) { SUM[d0 + e] += e0[e]; SUM[d0 + 4 + e] += e1[e]; } } } }
            __syncthreads();
            { const bf16x8 bV = cat44(lds_tr(VV + (4 * g + trq) * HROW + (Vw0 + 4 * trp) * 2), lds_tr(VV + (16 + 4 * g + trq) * HROW + (Vw0 + 4 * trp) * 2));
                if (outp) {
                    f32x4 pt00 = (f32x4){0.f, 0.f, 0.f, 0.f}, pt01 = pt00, pt11 = pt00, o0 = pt00, o1 = pt00;
#pragma unroll
                    for (int ks = 0; ks < 4; ++ks) { const int co = (32 * ks + 8 * g) * 2;
                        const bf16x8 aK0 = *(const LAS bf16x8*)(KI + r15 * HROW + co), aK1 = *(const LAS bf16x8*)(KI + (16 + r15) * HROW + co);
                        const bf16x8 bQ0 = *(const LAS bf16x8*)(QD + r15 * HROW + co), bQ1 = *(const LAS bf16x8*)(QD + (16 + r15) * HROW + co);
                        pt00 = MFMA16(aK0, bQ0, pt00); pt01 = MFMA16(aK0, bQ1, pt01); pt11 = MFMA16(aK1, bQ1, pt11); }
#pragma unroll
                    for (int r = 0; r < 4; ++r) if (4 * g + r > r15) { pt00[r] = 0.f; pt11[r] = 0.f; }
                    const bf16x8 pa0 = pk8(pt00, (f32x4){0.f, 0.f, 0.f, 0.f}), pa1 = pk8(pt01, pt11);
#pragma unroll
                    for (int ks = 0; ks < 4; ++ks) { const bf16x8 bS = pk8(S[2 * ks], S[2 * ks + 1]); const int c0 = (32 * ks + 4 * g) * 2;
                        const u32x2 x0 = *(const LAS u32x2*)(QD + r15 * HROW + c0), x1 = *(const LAS u32x2*)(QD + r15 * HROW + c0 + 32), y0 = *(const LAS u32x2*)(QD + (16 + r15) * HROW + c0), y1 = *(const LAS u32x2*)(QD + (16 + r15) * HROW + c0 + 32);
                        const bf16x8 aQ0 = __builtin_bit_cast(bf16x8, (u32x4){x0.x, x0.y, x1.x, x1.y}), aQ1 = __builtin_bit_cast(bf16x8, (u32x4){y0.x, y0.y, y1.x, y1.y});
                        o0 = MFMA16(aQ0, bS, o0); o1 = MFMA16(aQ1, bS, o1); }
                    o0 = MFMA16(pa0, bV, o0); o1 = MFMA16(pa1, bV, o1);
#pragma unroll
                    for (int r = 0; r < 4; ++r) { OB[(4 * g + r) * 128 + Vw0 + r15] = o0[r]; OB[(16 + 4 * g + r) * 128 + Vw0 + r15] = o1[r]; }
                }
#pragma unroll
                for (int mt = 0; mt < 8; ++mt) { const bf16x8 aKT = cat44(lds_tr(KT + (4 * g + trq) * HROW + (16 * mt + 4 * trp) * 2), lds_tr(KT + (16 + 4 * g + trq) * HROW + (16 * mt + 4 * trp) * 2));
                    const f32x4 dec4 = *(const LAS f32x4*)(DEC + 16 * mt + 4 * g);
                    S[mt] = MFMA16(aKT, bV, S[mt] * dec4); } }
            __syncthreads();
            if (outp) { const f32x4 o0 = *(const LAS f32x4*)(OB + tok * 128 + d0), o1 = *(const LAS f32x4*)(OB + tok * 128 + d0 + 4);
                float ss = pg8::sq8(o0, o1); ss += __shfl_xor(ss, 1); ss += __shfl_xor(ss, 2); ss += __shfl_xor(ss, 4); ss += __shfl_xor(ss, 8);
                const float rs = __builtin_amdgcn_rsqf(ss * (1.f / 128.f) + EPS);
                f32x4 g0, g1, r0, r1; pg8::unpack8(cg, g0, g1);
#pragma unroll
                for (int e = 0; e < 4; ++e) { r0[e] = o0[e] * rs * gn8[e] * sigmoidf_(g0[e]) + chkbad; r1[e] = o1[e] * rs * gn8[4 + e] * sigmoidf_(g1[e]); }
                *(u32x4*)(XA + (row0 + (size_t)c * 32 + tok) * D + h * ADK + d0) = pg8::pack8(r0, r1); }
        }
        if (!FULL) {
            const __amdgpu_buffer_rsrc_t rsL = __builtin_amdgcn_make_buffer_rsrc((void*)HLg, (short)0, 256 * 16384 * 4, 0x00020000);
            const __amdgpu_buffer_rsrc_t rsS = __builtin_amdgcn_make_buffer_rsrc((void*)HSg, (short)0, 256 * 128 * 4, 0x00020000);
            const int lo = (it * 16384 + (Vw0 + r15) * 128 + 4 * g) * 4;
#pragma unroll
            for (int mt = 0; mt < 8; ++mt) __builtin_amdgcn_raw_buffer_store_b128(__builtin_bit_cast(u32x4, S[mt]), rsL, lo + mt * 64, 0, 16);
            if (tid < 128) __builtin_amdgcn_raw_buffer_store_b32(__builtin_bit_cast(unsigned, SUM[tid]), rsS, (it * 128 + tid) * 4, 0, 16); }
        __syncthreads();
    }
}
__device__ __forceinline__ void phase_conv(const Frame& F, const Args& a) {
    unsigned char* ws = a.ws; const bf16_t* Z = (const bf16_t*)(ws + WS_Z); bf16_t* XA = (bf16_t*)(ws + WS_XA); const int tid = F.tid;
    const int gt = F.vcu * NTHR + tid, NGT = F.G * NTHR;
    for (int i = gt; i < NT * (512 / 8); i += NGT) {
        const int row = i >> 6, c0 = (i & 63) * 8, t = row & (SEQ - 1);
        const bf16_t* zr = Z + (size_t)row * ZW;
        f32x4 y0a, y0b, y1a = (f32x4){0.f, 0.f, 0.f, 0.f}, y1b = y1a, y2a = y1a, y2b = y1a, ga, gb;
        pg8::unpack8(*(const u32x4*)(zr + 2560 + c0), y0a, y0b); pg8::unpack8(*(const u32x4*)(zr + 2048 + c0), ga, gb);
        if (t >= 1) pg8::unpack8(*(const u32x4*)(zr - ZW + 2560 + c0), y1a, y1b);
        if (t >= 2) pg8::unpack8(*(const u32x4*)(zr - 2 * ZW + 2560 + c0), y2a, y2b);
        const f32x4 w0a = *(const f32x4*)(a.conv_w + c0), w0b = *(const f32x4*)(a.conv_w + c0 + 4), w1a = *(const f32x4*)(a.conv_w + 512 + c0), w1b = *(const f32x4*)(a.conv_w + 512 + c0 + 4),
                    w2a = *(const f32x4*)(a.conv_w + 1024 + c0), w2b = *(const f32x4*)(a.conv_w + 1024 + c0 + 4);
        const f32x4 ra = ga * (w0a * y2a + w1a * y1a + w2a * y0a), rb = gb * (w0b * y2b + w1b * y1b + w2b * y0b);
        u32x4 o; o.x = pk2(ra[0], ra[1]); o.y = pk2(ra[2], ra[3]); o.z = pk2(rb[0], rb[1]); o.w = pk2(rb[2], rb[3]);
        *(u32x4*)(XA + (size_t)row * D + 512 + c0) = o;
    }
}

__device__ __forceinline__ void phase_attn(const Frame& F, const Args& a) {
    const bf16_t* QKV = (const bf16_t*)(a.ws + WS_QKV); bf16_t* XA = (bf16_t*)(a.ws + WS_XA);
    const int gw = F.vcu * NWAVES + F.wave, NGW = F.G * NWAVES, lane = F.lane;
    for (int task = gw; task < NT * NQH; task += NGW) {
        const int m = task >> 4, hq = task & 15, kv = hq >> 3, t = m & (SEQ - 1);
        const bf16_t* qp = QKV + (size_t)m * CIN + hq * HD;
        float q[64];
#pragma unroll
        for (int i = 0; i < 8; ++i) { f32x4 x0, x1; pg8::unpack8(*(const u32x4*)(qp + 8 * i), x0, x1);
#pragma unroll
            for (int j = 0; j < 4; ++j) { q[8 * i + j] = x0[j]; q[8 * i + 4 + j] = x1[j]; } }
        float sc[2];
#pragma unroll
        for (int r = 0; r < 2; ++r) { const int j = lane + 64 * r, tk = t - 127 + j; float s = -INFINITY;
            if (tk >= 0) { const bf16_t* kp = QKV + (size_t)(m - 127 + j) * CIN + 1024 + kv * HD; float d = 0.f;
#pragma unroll
                for (int i = 0; i < 8; ++i) { f32x4 x0, x1; pg8::unpack8(*(const u32x4*)(kp + 8 * i), x0, x1);
#pragma unroll
                    for (int jj = 0; jj < 4; ++jj) d += q[8 * i + jj] * x0[jj] + q[8 * i + 4 + jj] * x1[jj]; }
                s = d * 0.125f; }
            sc[r] = s; }
        const float sink = a.sinks[hq];
        const float mx = fmaxf(wave_max(fmaxf(sc[0], sc[1])), sink);
        const float e0 = __expf(sc[0] - mx), e1 = __expf(sc[1] - mx);
        const float den = wave_sum(e0 + e1) + __expf(sink - mx);
        const float inv = 1.f / den; const float p0 = e0 * inv, p1 = e1 * inv;
        float o = 0.f;
        const int j0 = (t >= 127) ? 0 : 127 - t;
        for (int j = j0; j < 128; ++j) { const float pj = __shfl(j < 64 ? p0 : p1, j & 63); o += pj * bf1(QKV[(size_t)(m - 127 + j) * CIN + 1152 + kv * HD + lane]); }
        XA[(size_t)m * D + hq * HD + lane] = (bf16_t)f2bf(o);
    }
}

typedef float f32x16 __attribute__((ext_vector_type(16)));
#define MFMA32(A, B, C) __builtin_amdgcn_mfma_f32_32x32x16_bf16(A, B, C, 0, 0, 0)
constexpr int AT_ROW = 144, AT_K = 0, AT_V = 256 * AT_ROW;
__device__ __forceinline__ void phase_attn_fast(const Frame& F, const Args& a) {
    const bf16_t* QKV = (const bf16_t*)(a.ws + WS_QKV); bf16_t* XA = (bf16_t*)(a.ws + WS_XA);
    LAS unsigned char* L = F.lds;
    const int tid = F.tid, lane = F.lane, w = F.wave, c32 = lane & 31, hh = lane >> 5, i16 = lane & 15, trq = i16 >> 2, trp = i16 & 3, G1 = (lane >> 4) & 1;
    const float CS = 0.125f * 1.4426950408889634f;
    for (int unit = F.vcu; unit < NB * NKVH * (SEQ / 128); unit += F.G) {
        const int nb = unit & 31, kv = (unit >> 5) & 1, b = unit >> 6;
        const long rowk0 = (long)b * SEQ + 128 * nb - 128;
        __syncthreads();
#pragma unroll
        for (int i = 0; i < 4; ++i) { const int p = tid + NTHR * i, row = p >> 3, sg = p & 7; const bool ok = (nb > 0) || (row >= 128);
            u32x4 kx = (u32x4){0u, 0u, 0u, 0u}, vx = kx;
            if (ok) { const bf16_t* src = QKV + (size_t)(rowk0 + row) * CIN + 1024 + kv * HD + sg * 8; kx = *(const u32x4*)src; vx = *(const u32x4*)(src + 128); }
            *(LAS u32x4*)(L + AT_K + row * AT_ROW + sg * 16) = kx; *(LAS u32x4*)(L + AT_V + row * AT_ROW + sg * 16) = vx; }
        __syncthreads();
        const int hq = kv * 8 + w; const float sink2 = a.sinks[hq] * 1.4426950408889634f;
        for (int qt = 0; qt < 4; ++qt) {
            const size_t qrow = (size_t)b * SEQ + 128 * nb + 32 * qt + c32;
            const bf16_t* qp = QKV + qrow * CIN + hq * HD + 8 * hh;
            bf16x8 bQ[4];
#pragma unroll
            for (int ks = 0; ks < 4; ++ks) bQ[ks] = *(const bf16x8*)(qp + 16 * ks);
            f32x16 st[5]; float mx = sink2;
#pragma unroll
            for (int t = 0; t < 5; ++t) {
                const bool blk_ok = (nb > 0) || (qt + t >= 4);
#pragma unroll
                for (int r = 0; r < 16; ++r) st[t][r] = 0.f;
                if (blk_ok) {
#pragma unroll
                    for (int ks = 0; ks < 4; ++ks) { const bf16x8 aK = *(const LAS bf16x8*)(L + AT_K + (32 * (qt + t) + c32) * AT_ROW + (16 * ks + 8 * hh) * 2); st[t] = MFMA32(aK, bQ[ks], st[t]); } }
#pragma unroll
                for (int r = 0; r < 16; ++r) { const int kk = (r & 3) + 8 * (r >> 2) + 4 * hh;
                    bool ok = blk_ok; if (t == 0) ok = ok && (kk > c32); if (t == 4) ok = ok && (kk <= c32);
                    const float z = ok ? st[t][r] * CS : -INFINITY; st[t][r] = z; mx = fmaxf(mx, z); }
            }
            mx = fmaxf(mx, __shfl_xor(mx, 32));
            float sum = 0.f;
#pragma unroll
            for (int t = 0; t < 5; ++t)
#pragma unroll
                for (int r = 0; r < 16; ++r) { const float p = __builtin_amdgcn_exp2f(st[t][r] - mx); st[t][r] = p; sum += p; }
            sum += __shfl_xor(sum, 32);
            const float inv = 1.f / (sum + __builtin_amdgcn_exp2f(sink2 - mx));
            f32x16 o0, o1;
#pragma unroll
            for (int r = 0; r < 16; ++r) { o0[r] = 0.f; o1[r] = 0.f; }
#pragma unroll
            for (int t = 0; t < 5; ++t)
#pragma unroll
                for (int s2 = 0; s2 < 2; ++s2) {
                    const bf16x8 bP = pk8((f32x4){st[t][8 * s2], st[t][8 * s2 + 1], st[t][8 * s2 + 2], st[t][8 * s2 + 3]}, (f32x4){st[t][8 * s2 + 4], st[t][8 * s2 + 5], st[t][8 * s2 + 6], st[t][8 * s2 + 7]});
                    const LAS unsigned char* vb = L + AT_V + (32 * (qt + t) + 16 * s2 + 4 * hh + trq) * AT_ROW + (16 * G1 + 4 * trp) * 2;
                    const bf16x8 aV0 = cat44(lds_tr(vb), lds_tr(vb + 8 * AT_ROW)), aV1 = cat44(lds_tr(vb + 64), lds_tr(vb + 8 * AT_ROW + 64));
                    o0 = MFMA32(aV0, bP, o0); o1 = MFMA32(aV1, bP, o1); }
            bf16_t* op = XA + qrow * D + hq * HD + 4 * hh;
#pragma unroll
            for (int rg = 0; rg < 4; ++rg) { u32x2 x0, x1;
                x0.x = pg8::cvt_pk_bf16(o0[4 * rg] * inv, o0[4 * rg + 1] * inv); x0.y = pg8::cvt_pk_bf16(o0[4 * rg + 2] * inv, o0[4 * rg + 3] * inv);
                x1.x = pg8::cvt_pk_bf16(o1[4 * rg] * inv, o1[4 * rg + 1] * inv); x1.y = pg8::cvt_pk_bf16(o1[4 * rg + 2] * inv, o1[4 * rg + 3] * inv);
                *(u32x2*)(op + 8 * rg) = x0; *(u32x2*)(op + 32 + 8 * rg) = x1; }
        }
    }
}

constexpr int CNT_STRIDE = 64;
constexpr int RT_WROW = 2064;
constexpr int RT_WH = 0, RT_WL = 16 * RT_WROW, RT_LG = 2 * 16 * RT_WROW, RT_TC = RT_LG + 8 * 1088, RT_TW = RT_TC + 512, RT_LC = RT_TW + 2048, RT_GB = RT_LC + 128;
__device__ __forceinline__ void phase_route(const Frame& F, const Args& a, int l) {
    unsigned char* ws = a.ws; const float* H = a.out;
    gu32* cnt = (gu32*)(ws + WS_CTL) + CW_CNT + l * 32 * CNT_STRIDE; int* list = (int*)(ws + WS_LIST); f32x2* wlist = (f32x2*)(ws + WS_WLIST); float* rlist = (float*)(ws + WS_RLIST);
    LAS unsigned char* L = F.lds;
    LAS float* LG = (LAS float*)(L + RT_LG) + F.wave * 272; LAS int* TC = (LAS int*)(L + RT_TC); LAS f32x4* TW = (LAS f32x4*)(L + RT_TW); LAS int* LC = (LAS int*)(L + RT_LC); LAS int* GB = (LAS int*)(L + RT_GB);
    const float* gn = a.norm_ffn + l * D;
    for (int i = F.tid; i < D * NE; i += NTHR) { const int k = i >> 4, e = i & 15; const float wv = a.w_router[i] * gn[k]; const unsigned hi = f2bf(wv); const unsigned lo = f2bf(wv - bflo(hi));
        *(LAS bf16_t*)(L + RT_WH + e * RT_WROW + k * 2) = (bf16_t)hi; *(LAS bf16_t*)(L + RT_WL + e * RT_WROW + k * 2) = (bf16_t)lo; }
    if (F.tid < 32) LC[F.tid] = 0;
    __syncthreads();
    const int lane = F.lane, r15 = lane & 15, g = lane >> 4;
    for (int blk = F.vcu; blk < NT / 128; blk += F.G) {
        const int tl0 = F.wave * 16, m0 = blk * 128 + tl0;
        const f32x4* xr = (const f32x4*)(H + (size_t)(m0 + r15) * D + 8 * g);
        f32x4 acc = (f32x4){0.f, 0.f, 0.f, 0.f}; float ssq = 0.f;
        const LAS unsigned char* wh = L + RT_WH + r15 * RT_WROW + 16 * g; const LAS unsigned char* wl_ = L + RT_WL + r15 * RT_WROW + 16 * g;
#pragma unroll 1
        for (int k8 = 0; k8 < 4; ++k8) {
            f32x4 xv[16];
#pragma unroll
            for (int q = 0; q < 8; ++q) { xv[2 * q] = xr[(k8 * 8 + q) * 8]; xv[2 * q + 1] = xr[(k8 * 8 + q) * 8 + 1]; }
#pragma unroll
            for (int q = 0; q < 8; ++q) { const f32x4 x0 = xv[2 * q], x1 = xv[2 * q + 1]; ssq += pg8::sq8(x0, x1);
                const u32x4 hp = pg8::pack8(x0, x1); f32x4 h0, h1; pg8::unpack8(hp, h0, h1);
                const bf16x8 xh = __builtin_bit_cast(bf16x8, hp), xl = pk8(x0 - h0, x1 - h1);
                const bf16x8 bh = *(const LAS bf16x8*)(wh + (k8 * 8 + q) * 64), bl = *(const LAS bf16x8*)(wl_ + (k8 * 8 + q) * 64);
                acc = MFMA16(xh, bh, acc); acc = MFMA16(xh, bl, acc); acc = MFMA16(xl, bh, acc); }
        }
        ssq += __shfl_xor(ssq, 16); ssq += __shfl_xor(ssq, 32);
        const float rs = __builtin_amdgcn_rsqf(ssq * (1.f / D) + EPS);
#pragma unroll
        for (int r = 0; r < 4; ++r) LG[(4 * g + r) * 17 + r15] = acc[r];
        LDS_WAIT(); asm volatile("" ::: "memory");
        if (lane < 16) { float ex[16]; float mx = -INFINITY;
#pragma unroll
            for (int e = 0; e < 16; ++e) { ex[e] = LG[lane * 17 + e] * rs; mx = fmaxf(mx, ex[e]); }
#pragma unroll
            for (int e = 0; e < 16; ++e) ex[e] = __expf(ex[e] - mx);
            float gs[4], gv1[4], gv2[4]; int gi1[4], gi2[4];
#pragma unroll
            for (int gq = 0; gq < 4; ++gq) { float m1 = ex[4 * gq]; int i1 = 0;
#pragma unroll
                for (int i = 1; i < 4; ++i) if (ex[4 * gq + i] > m1) { m1 = ex[4 * gq + i]; i1 = i; }
                float m2 = -1.f; int i2 = 0;
#pragma unroll
                for (int i = 0; i < 4; ++i) if (i != i1 && ex[4 * gq + i] > m2) { m2 = ex[4 * gq + i]; i2 = i; }
                gs[gq] = m1 + m2; gv1[gq] = m1; gv2[gq] = m2; gi1[gq] = i1; gi2[gq] = i2; }
            int sel = 0; float best = gs[0], v1 = gv1[0], v2 = gv2[0]; int i1 = gi1[0], i2 = gi2[0];
#pragma unroll
            for (int gq = 1; gq < 4; ++gq) if (gs[gq] > best) { best = gs[gq]; sel = gq; v1 = gv1[gq]; v2 = gv2[gq]; i1 = gi1[gq]; i2 = gi2[gq]; }
            const float wsum = 1.f / (v1 + v2); const float w1 = v1 * wsum, w2 = v2 * wsum;
            const int ea = i1 < i2 ? i1 : i2, eb = i1 < i2 ? i2 : i1; const float wa = i1 < i2 ? w1 : w2, wb = i1 < i2 ? w2 : w1;
            const int pr = (ea == 0) ? eb - 1 : ((ea == 1) ? eb + 1 : 5);
            TC[tl0 + lane] = sel * 6 + pr; TW[tl0 + lane] = (f32x4){wa, wb, rs, 0.f}; }
        __syncthreads();
        int myc = 0, lp = 0;
        if (F.tid < 128) { myc = TC[F.tid]; lp = __hip_atomic_fetch_add(LC + myc, 1, __ATOMIC_RELAXED, __HIP_MEMORY_SCOPE_WORKGROUP); }
        __syncthreads();
        if (F.tid < NCLS) { const int n = LC[F.tid]; GB[F.tid] = n ? (int)__hip_atomic_fetch_add(cnt + F.tid * CNT_STRIDE, (unsigned)n, __ATOMIC_RELAXED, __HIP_MEMORY_SCOPE_AGENT) : 0; }
        __syncthreads();
        if (F.tid < 128) { const size_t pos = (size_t)myc * LCAP + GB[myc] + lp; const f32x4 tw = TW[F.tid]; list[pos] = blk * 128 + F.tid; wlist[pos] = (f32x2){tw[0], tw[1]}; rlist[pos] = tw[2]; }
        if (F.tid < 32) LC[F.tid] = 0;
        __syncthreads();
    }
}

constexpr int LX_UT = LX_OFF + 2048;
template <int NP>
__device__ __forceinline__ void moe_tables(const Frame& F, unsigned char* ws, int l) {
    const gu32* cnt = (const gu32*)(ws + WS_CTL) + CW_CNT + l * 32 * CNT_STRIDE;
    volatile LAS int* TB = (volatile LAS int*)(F.lds + LX_TB); volatile LAS int* CN = (volatile LAS int*)(F.lds + LX_CNT); volatile LAS int* CL = (volatile LAS int*)(F.lds + LX_CLS);
    volatile LAS unsigned long long* UT = (volatile LAS unsigned long long*)(F.lds + LX_UT);
    __syncthreads();
    if (F.tid < NCLS) CN[F.tid] = (int)__hip_atomic_load(cnt + F.tid * CNT_STRIDE, __ATOMIC_RELAXED, __HIP_MEMORY_SCOPE_AGENT);
    __syncthreads();
    if (F.tid == 0) { int tb = 0;
#pragma unroll 1
        for (int c = 0; c < NCLS; ++c) { TB[c] = tb; const int n = (CN[c] + 255) >> 8;
#pragma unroll 1
            for (int i = 0; i < n; ++i) CL[tb + i] = c;
            tb += n; }
        TB[NCLS] = tb; }
    __syncthreads();
    if (F.tid < 8) { const int i = F.tid; const int L = i * F.G + F.vcu; const int TT = TB[NCLS];
        unsigned long long w0 = ~0ull, w1 = 0, w2 = 0, w3 = 0, w4 = 0;
        if (L < TT * NP) { const int tau = L / NP, pn = L % NP; const int c = CL[tau]; const int ti = tau - TB[c], rem = CN[c] - ti * 256;
            const int g = c / 6, pr = c % 6; const int ea = pr < 3 ? 0 : (pr < 5 ? 1 : 2), eb = pr < 3 ? pr + 1 : (pr < 5 ? pr - 1 : 3);
            const int nv = rem < 256 ? rem : 256, aux = c * LCAP + ti * 256;
            const char *pA, *pB, *pB2;
            if (NP == 8) { const int e = g * 4 + (pn < 4 ? ea : eb); pA = (const char*)(ws + WS_XA2); pB = (const char*)(ws + WS_W1) + ((size_t)(l * NE + e) * D * D + (size_t)(pn & 3) * 256 * D) * 2; pB2 = pB; }
            else { pA = (const char*)(ws + WS_HID) + (size_t)tau * 256 * 1024 * 2; pB = (const char*)(ws + WS_W2) + ((size_t)(l * NE + g * 4 + ea) * D * DE + (size_t)pn * 256 * DE) * 2;
                pB2 = (const char*)(ws + WS_W2) + ((size_t)(l * NE + g * 4 + eb) * D * DE + (size_t)pn * 256 * DE) * 2; }
            w0 = (unsigned long long)(unsigned)tau | ((unsigned long long)(unsigned)pn << 32); w1 = (unsigned long long)pA; w2 = (unsigned long long)pB; w3 = (unsigned long long)pB2;
            w4 = (unsigned long long)(unsigned)nv | ((unsigned long long)(unsigned)aux << 32); }
        UT[i * 8 + 0] = w0; UT[i * 8 + 1] = w1; UT[i * 8 + 2] = w2; UT[i * 8 + 3] = w3; UT[i * 8 + 4] = w4; }
    __syncthreads();
}
__device__ __forceinline__ unsigned long long rfl64(unsigned long long v) { const unsigned lo = __builtin_amdgcn_readfirstlane((unsigned)v), hi = __builtin_amdgcn_readfirstlane((unsigned)(v >> 32)); return ((unsigned long long)hi << 32) | lo; }
struct MoeSched {
    const LAS unsigned long long* UT; const int* list;
    __device__ __forceinline__ bool next(int i, pg8::Unit& u) const {
        if (i >= 8) return false;
        const unsigned long long w0 = rfl64(UT[i * 8 + 0]); if ((int)(unsigned)w0 < 0) return false;
        const unsigned long long w1 = rfl64(UT[i * 8 + 1]), w2 = rfl64(UT[i * 8 + 2]), w3 = rfl64(UT[i * 8 + 3]), w4 = rfl64(UT[i * 8 + 4]);
        u.pm = (int)(unsigned)w0; u.pn = (int)(unsigned)(w0 >> 32); u.pA = (const char*)w1; u.pB = (const char*)w2; u.pB2 = (const char*)w3; u.nv = (int)(unsigned)w4; u.aux = (int)(unsigned)(w4 >> 32); u.lst = list + u.aux;
        return true;
    }
};

__device__ __forceinline__ void phase_final(const Frame& F, const Args& a) {
    const int gw = F.vcu * NWAVES + F.wave, NGW = F.G * NWAVES, lane = F.lane;
    f32x4 gv[4];
#pragma unroll
    for (int j = 0; j < 4; ++j) gv[j] = *((const f32x4*)a.norm_final + lane + 64 * j);
    for (int m = gw; m < NT; m += NGW) { f32x4* xr = (f32x4*)(a.out + (size_t)m * D) + lane; f32x4 v[4]; float s = 0.f;
#pragma unroll
        for (int j = 0; j < 4; ++j) { v[j] = xr[64 * j]; s += (v[j][0] * v[j][0] + v[j][1] * v[j][1]) + (v[j][2] * v[j][2] + v[j][3] * v[j][3]); }
        const float rs = __builtin_amdgcn_rsqf(wave_sum(s) * (1.f / D) + EPS);
#pragma unroll
        for (int j = 0; j < 4; ++j) xr[64 * j] = v[j] * rs * gv[j]; }
}

constexpr int N_PHASES = 18;
#ifndef HGRN_NAIVE
#define HGRN_NAIVE 0
#endif
#ifndef ATTN_NAIVE
#define ATTN_NAIVE 0
#endif
#if defined(__HIP_DEVICE_COMPILE__)
#define LOAD_ARGS(a) Args a; { const __attribute__((address_space(4))) char* _kp = (const __attribute__((address_space(4))) char*)__builtin_amdgcn_kernarg_segment_ptr(); asm volatile("" : "+s"(_kp)); a = *(const Args*)(const char*)_kp; } unsigned char* ws = a.ws
#else
#define LOAD_ARGS(a) Args a = args; unsigned char* ws = a.ws
#endif

#if !MK_PER_PHASE
#define GRID_BAR() xcd_barrier(bar)
#else
#define GRID_BAR() do { } while (0)
#endif
#ifndef PHMASK
#define PHMASK 0x3FFFF
#endif
#if MK_PER_PHASE
#define IN(k) (((PHMASK >> (k)) & 1) && lo <= (k) && (k) < hi)
#else
#define IN(k) ((PHMASK >> (k)) & 1)
#endif
#define BOTH(k) (IN(k) && IN((k) + 1))
#define SITE_FRAME(Fp) Frame Fp; { int _w = wave0; asm volatile("" : "+s"(_w)); int _t = _w * 64 + (int)__builtin_amdgcn_mbcnt_hi(~0u, __builtin_amdgcn_mbcnt_lo(~0u, 0u)); asm volatile("" : "+v"(_t)); unsigned _z = 0; asm volatile("" : "+s"(_z)); int _b = blockIdx.x; asm volatile("" : "+s"(_b)); int _G = gridDim.x; asm volatile("" : "+s"(_G)); Fp.tid = _t; Fp.lane = _t & 63; Fp.wave = __builtin_amdgcn_readfirstlane(_t >> 6); Fp.lds = (LAS unsigned char*)lds_raw + _z; Fp.G = _G; Fp.vcu = (_G % 8 == 0) ? (_b % 8) * (_G / 8) + _b / 8 : _b; } int bx = (int)blockIdx.x; asm volatile("" : "+s"(bx))
template <int l> __device__ __forceinline__ void layer_body(unsigned char* lds_raw, const Args& args, const XcdBarrier& bar, const int wave0, const int lo, const int hi) {
    (void)args; (void)bar; (void)lo; (void)hi;
        const int pb = 1 + 8 * l;
        if (IN(pb + 0)) { LOAD_ARGS(a); SITE_FRAME(Fp);
#ifndef NO_S1A
            if (l == 0) { pg8::DenseSched S; S.init(ws + WS_XA, ws + WS_WINAB, NT, ABIN, D, D, Fp.G, bx); pg8::EpiInAb E{(bf16_t*)(ws + WS_Z)};
                pg8::gemm_phase<pg8::EpiInAb, pg8::DenseSched, false, false>(Fp.lds, Fp.tid, D, D, D, S, E); }
#endif
#ifndef NO_S1B
            if (l == 1) { pg8::DenseSched S; S.init(ws + WS_XA, ws + WS_WINC, NT, CIN, D, D, Fp.G, bx); pg8::rstd_table(Fp.lds, Fp.tid, S, (const float*)(ws + WS_SSB)); pg8::EpiQkv E{(bf16_t*)(ws + WS_QKV), a.b_in_c, (const LAS float*)(Fp.lds + pg8::RSL_OFF)};
                pg8::gemm_phase<pg8::EpiQkv, pg8::DenseSched, false, false>(Fp.lds, Fp.tid, D, D, D, S, E); }
#endif
#ifndef NO_S1C
            { pg8::DenseSched S; S.init(ws + WS_PB + (size_t)l * NT * PLE * 2, ws + WS_WPP + (size_t)l * D * PLE * 2, NT, D, PLE, PLE, Fp.G, bx); pg8::EpiBf16 E{(bf16_t*)(ws + WS_PP), D};
                pg8::gemm_phase<pg8::EpiBf16, pg8::DenseSched, false, false>(Fp.lds, Fp.tid, PLE, PLE, PLE, S, E); }
#endif
            if (BOTH(pb + 0)) GRID_BAR();
        }
#if HGRN_NAIVE
        if (IN(pb + 1)) { LOAD_ARGS(a); (void)ws; SITE_FRAME(Fp); if (l == 0) { phase_hgrn_conv(Fp, a); phase_conv(Fp, a); } else phase_attn(Fp, a); if (BOTH(pb + 1)) GRID_BAR(); }
#else
        if (IN(pb + 1)) { LOAD_ARGS(a); (void)ws; SITE_FRAME(Fp); if (l == 0) { hgrn_pass<false>(Fp, a); phase_conv(Fp, a); } else { if (ATTN_NAIVE) phase_attn(Fp, a); else phase_attn_fast(Fp, a); } if (BOTH(pb + 1)) GRID_BAR(); }
        if (IN(pb + 2) && l == 0) { LOAD_ARGS(a); (void)ws; SITE_FRAME(Fp); hgrn_pass<true>(Fp, a); if (BOTH(pb + 2)) GRID_BAR(); }
#endif
        if (IN(pb + 3)) { LOAD_ARGS(a); SITE_FRAME(Fp);
            pg8::DenseSched S; S.init(ws + WS_XA, ws + (l == 0 ? WS_WOUTAB : WS_WOUTC), NT, D, D, D, Fp.G, bx);
            pg8::EpiRes E{l == 0 ? a.x : a.out, a.out, l == 0 ? nullptr : a.b_out_c, (bf16_t*)(ws + WS_XA2)};
            pg8::gemm_phase<pg8::EpiRes, pg8::DenseSched, false, false>(Fp.lds, Fp.tid, D, D, D, S, E);
            if (BOTH(pb + 3)) GRID_BAR();
        }
        if (IN(pb + 4)) { LOAD_ARGS(a); (void)ws; SITE_FRAME(Fp); phase_route(Fp, a, l); if (BOTH(pb + 4)) GRID_BAR(); }
        if (IN(pb + 5)) { LOAD_ARGS(a); SITE_FRAME(Fp); moe_tables<8>(Fp, ws, l);
            MoeSched S{(const LAS unsigned long long*)(Fp.lds + LX_UT), (const int*)(ws + WS_LIST)};
            pg8::EpiG1 E{(bf16_t*)(ws + WS_HID), (const f32x2*)(ws + WS_WLIST), (const float*)(ws + WS_RLIST)};
            pg8::gemm_phase<pg8::EpiG1, MoeSched, true, false>(Fp.lds, Fp.tid, D, D, D, S, E);
            if (BOTH(pb + 5)) GRID_BAR(); }
        if (IN(pb + 6)) { LOAD_ARGS(a); SITE_FRAME(Fp); moe_tables<4>(Fp, ws, l);
            MoeSched S{(const LAS unsigned long long*)(Fp.lds + LX_UT), (const int*)(ws + WS_LIST)};
            pg8::EpiG2 E{a.out, (bf16_t*)(ws + WS_XA2), (float*)(ws + WS_SSA)};
            pg8::gemm_phase<pg8::EpiG2, MoeSched, false, true>(Fp.lds, Fp.tid, 1024, 1024, DE, S, E);
            if (BOTH(pb + 6)) GRID_BAR(); }
        if (IN(pb + 7)) { LOAD_ARGS(a); SITE_FRAME(Fp);
            pg8::DenseSched S; S.init(ws + WS_XA2, ws + WS_WPG + (size_t)l * D * D * 2, NT, D, D, D, Fp.G, bx);
            pg8::rstd_table(Fp.lds, Fp.tid, S, (const float*)(ws + WS_SSA));
            pg8::EpiPle E{a.out, (bf16_t*)(ws + WS_XA), (const bf16_t*)(ws + WS_PP), (const LAS float*)(Fp.lds + pg8::RSL_OFF), (float*)(ws + WS_SSB)};
            pg8::gemm_phase<pg8::EpiPle, pg8::DenseSched, false, false>(Fp.lds, Fp.tid, D, D, D, S, E);
            if (BOTH(pb + 7)) GRID_BAR();
        }
}
__global__ void __launch_bounds__(NTHR, 2) mega_fwd(Args args) {
    extern __shared__ __attribute__((aligned(16))) unsigned char lds_raw[];
    Frame F; F.lds = (LAS unsigned char*)lds_raw; F.tid = threadIdx.x; F.lane = F.tid & 63; F.wave = __builtin_amdgcn_readfirstlane(F.tid >> 6);
    F.G = gridDim.x; { const int bx = blockIdx.x; F.vcu = (F.G % 8 == 0) ? (bx % 8) * (F.G / 8) + bx / 8 : bx; }
    for (int u = F.tid; u < (LDS_BYTES - LX_OFF) / 4; u += NTHR) ((LAS unsigned*)(F.lds + LX_OFF))[u] = 0u;
    __syncthreads();
#if !MK_PER_PHASE
    XcdBarrier bar = xcd_barrier_post((unsigned*)((gu32*)(args.ws + WS_CTL) + CW_BAR), (volatile LAS unsigned*)(F.lds + LX_BAR), __builtin_amdgcn_readfirstlane((int)threadIdx.x >> 6));
#else
    XcdBarrier bar; bar.bar = nullptr; bar.x = 0u; bar.st = nullptr; bar.w0 = 0;
#endif
    const int lo = args.ph_lo, hi = args.ph_hi; (void)lo; (void)hi;
    const int wave0 = __builtin_amdgcn_readfirstlane((int)threadIdx.x >> 6);

    if (IN(0)) { LOAD_ARGS(a); (void)ws; SITE_FRAME(Fp); phase_prep(Fp, a); if (BOTH(0)) GRID_BAR(); }

    layer_body<0>(lds_raw, args, bar, wave0, lo, hi);
    layer_body<1>(lds_raw, args, bar, wave0, lo, hi);
    if (IN(17)) { LOAD_ARGS(a); (void)ws; SITE_FRAME(Fp); phase_final(Fp, a); }
#undef IN
#undef BOTH
}

extern "C" void kernel_launch(void* const* d_in, const int* in_sizes, int n_in, void* d_out, int out_size, void* d_ws, size_t ws_size, hipStream_t stream) {
    static int grid = 0;
    if (grid == 0) {
        if (n_in != 22 || out_size != NT * D || ws_size < WS_END) { fprintf(stderr, "kernel_launch: unexpected shapes (n_in %d, out %d, ws %zu)\n", n_in, out_size, ws_size); grid = -1; return; }
        int dev = 0, cus = 0, per_cu = 0;
        if (hipGetDevice(&dev) != hipSuccess || hipDeviceGetAttribute(&cus, hipDeviceAttributeMultiprocessorCount, dev) != hipSuccess) { grid = -1; return; }
        if (hipFuncSetAttribute((const void*)mega_fwd, hipFuncAttributeMaxDynamicSharedMemorySize, LDS_BYTES) != hipSuccess) { fprintf(stderr, "kernel_launch: hipFuncSetAttribute failed\n"); grid = -1; return; }
        if (hipOccupancyMaxActiveBlocksPerMultiprocessor(&per_cu, (const void*)mega_fwd, NTHR, LDS_BYTES) != hipSuccess || per_cu < 1) fprintf(stderr, "kernel_launch: occupancy query says %d\n", per_cu);
        (void)hipGetLastError();
        grid = cus;
    }
    if (grid < 0) return;
    (void)hipMemsetAsync((char*)d_ws + WS_CTL, 0, CTL_ZERO_BYTES, stream);
    Args a{};
    a.x = (const float*)d_in[0]; a.p = (const float*)d_in[1]; a.norm_mix = (const float*)d_in[2]; a.norm_ffn = (const float*)d_in[3]; a.norm_ple = (const float*)d_in[4]; a.norm_final = (const float*)d_in[5];
    a.w_in_ab = (const float*)d_in[6]; a.lb_logits = (const float*)d_in[7]; a.hgrn_out_norm = (const float*)d_in[8]; a.conv_w = (const float*)d_in[9]; a.w_out_ab = (const float*)d_in[10];
    a.w_in_c = (const float*)d_in[11]; a.b_in_c = (const float*)d_in[12]; a.sinks = (const float*)d_in[13]; a.w_out_c = (const float*)d_in[14]; a.b_out_c = (const float*)d_in[15];
    a.w_router = (const float*)d_in[16]; a.w_gate_e = (const float*)d_in[17]; a.w_up_e = (const float*)d_in[18]; a.w_down_e = (const float*)d_in[19]; a.w_ple_gate = (const float*)d_in[20]; a.w_ple_proj = (const float*)d_in[21];
    a.out = (float*)d_out; a.ws = (unsigned char*)d_ws;
#if MK_PER_PHASE
#ifndef RP
#define RP (-1)
#define RN 0
#endif
    for (int ph = 0; ph < N_PHASES; ++ph) { a.ph_lo = ph; a.ph_hi = ph + 1; const int reps = (ph == RP) ? RN + 1 : 1;
        for (int r = 0; r < reps; ++r) { if (r > 0 && (ph == 5 || ph == 13)) (void)hipMemsetAsync((char*)d_ws + WS_CTL, 0, CTL_ZERO_BYTES, stream); hipLaunchKernelGGL(mega_fwd, dim3(grid), dim3(NTHR), LDS_BYTES, stream, a); } }
#else
    a.ph_lo = 0; a.ph_hi = N_PHASES; hipLaunchKernelGGL(mega_fwd, dim3(grid), dim3(NTHR), LDS_BYTES, stream, a);
#endif
}
```

```cpp
#include <hip/hip_runtime.h>
#include <cstdio>
#include <cstdint>

#ifndef MK_PER_PHASE
#define MK_PER_PHASE 0
#endif

#define LAS __attribute__((address_space(3)))
#define GAS __attribute__((address_space(1)))
typedef unsigned short bf16_t;
typedef short bf16x8 __attribute__((ext_vector_type(8)));
typedef float f32x4 __attribute__((ext_vector_type(4)));
typedef float f32x2 __attribute__((ext_vector_type(2)));
typedef unsigned u32x4 __attribute__((ext_vector_type(4)));
typedef unsigned u32x2 __attribute__((ext_vector_type(2)));
typedef GAS unsigned gu32;

constexpr int NB = 8, SEQ = 4096, D = 1024, NT = NB * SEQ;
constexpr int PLE = 256;
constexpr int AW = 512, AH = 4, ADK = 128;
constexpr int ABIN = 3584, ZW = 3072;
constexpr int CIN = 1280, HD = 64, NQH = 16, NKVH = 2, WIN = 128;
constexpr int NE = 16, DE = 512;
constexpr int NCLS = 24, LCAP = NT;
constexpr int HIDROWS = NT + NCLS * 256;
constexpr float EPS = 1e-6f;

constexpr size_t MiB = 1u << 20;
constexpr size_t WS_CTL = 0, CTL_ZERO_BYTES = 1 * MiB;
constexpr size_t WS_WINAB = 1 * MiB;
constexpr size_t WS_WOUTAB = 8 * MiB;
constexpr size_t WS_WINC = 10 * MiB;
constexpr size_t WS_WOUTC = 13 * MiB;
constexpr size_t WS_WPG = 15 * MiB;
constexpr size_t WS_WPP = 19 * MiB;
constexpr size_t WS_W1 = 20 * MiB;
constexpr size_t WS_W2 = 84 * MiB;
constexpr size_t WS_PB = 116 * MiB;
constexpr size_t WS_XA = 148 * MiB;
constexpr size_t WS_Z = 212 * MiB;
constexpr size_t WS_XA2 = WS_Z;
constexpr size_t WS_HID = WS_Z + 64 * MiB;
constexpr size_t WS_QKV = WS_Z + 64 * MiB;
constexpr size_t WS_PP = 404 * MiB;
constexpr size_t WS_LIST = 468 * MiB;
constexpr size_t WS_WLIST = 471 * MiB;
constexpr size_t WS_SSA = 477 * MiB;
constexpr size_t WS_SSB = 479 * MiB;
constexpr size_t WS_LB = 481 * MiB;
constexpr size_t WS_HL = 484 * MiB;
constexpr size_t WS_HSUM = 500 * MiB;
constexpr size_t WS_RLIST = 502 * MiB;
constexpr size_t WS_END = 505 * MiB;
constexpr int CW_BAR = 4096;
constexpr int CW_CNT = 16384;

constexpr int RING_BYTES = 131072;
constexpr int LX_OFF = RING_BYTES;
constexpr int LX_BAR = LX_OFF + 0;
constexpr int LX_TB = LX_OFF + 64;
constexpr int LX_CNT = LX_OFF + 64 + 128;
constexpr int LX_CLS = LX_OFF + 512;
constexpr int LDS_BYTES = 147456;
constexpr int NWAVES = 8, NTHR = 512;

__device__ __forceinline__ unsigned f2bf(float f) { unsigned u = __builtin_bit_cast(unsigned, f); return (u + 0x7fffu + ((u >> 16) & 1u)) >> 16; }
__device__ __forceinline__ unsigned pk2(float lo, float hi) { return f2bf(lo) | (f2bf(hi) << 16); }
__device__ __forceinline__ float bflo(unsigned w) { return __builtin_bit_cast(float, w << 16); }
__device__ __forceinline__ float bfhi(unsigned w) { return __builtin_bit_cast(float, w & 0xffff0000u); }
__device__ __forceinline__ float bf1(bf16_t h) { return __builtin_bit_cast(float, (unsigned)h << 16); }
__device__ __forceinline__ float sigmoidf_(float x) { return __builtin_amdgcn_rcpf(1.f + __expf(-x)); }
__device__ __forceinline__ float siluf_(float x) { return x * sigmoidf_(x); }
__device__ __forceinline__ float wave_sum(float v) {
#pragma unroll
    for (int o = 1; o < 64; o <<= 1) v += __shfl_xor(v, o);
    return v;
}
__device__ __forceinline__ float wave_max(float v) {
#pragma unroll
    for (int o = 1; o < 64; o <<= 1) v = fmaxf(v, __shfl_xor(v, o));
    return v;
}
#define LDS_WAIT() asm volatile("s_waitcnt lgkmcnt(0)" ::: "memory")

namespace pg8 {
constexpr int BM = 256, BK = 64, HALF = 128, HTB = HALF * BK * 2, NXCD = 8, WGM = 8;
__host__ __device__ __forceinline__ int lds_byte(int r, int c) { const int st = (r >> 4) * 2 + (c >> 5), rr = r & 15, cc = c & 31, ob = rr * 64 + cc * 2; return st * 1024 + (ob ^ (((ob >> 9) & 1) << 5)); }
__host__ __device__ __forceinline__ void stage_rc(int b, int& R, int& C) { const int st = b / 1024, sb = b % 1024, swz = sb ^ (((sb >> 9) & 1) << 5); R = (st >> 1) * 16 + swz / 64; C = (st & 1) * 32 + (swz % 64) / 2; }
__host__ __device__ __forceinline__ int perm32(int rho) { const int n = rho >> 4, i = rho & 15; return 8 * (i >> 2) + 4 * n + (i & 3); }

struct Unit { int pm, pn; const char* pA; const char* pB; const char* pB2; const int* lst; int nv; int aux; };

struct StaticOrder {
    int nM, nN, nwg, G, c;
    __device__ void init(int M, int N, int G_, int c_) { nM = M / BM; nN = N / BM; nwg = nM * nN; G = G_; c = c_; }
    __device__ bool next(int i, int& pm, int& pn) const {
        const long L = (long)i * G + c; if (L >= nwg) return false;
        int wgid = (int)L; { const int q = nwg / NXCD, r = nwg % NXCD, xcd = wgid % NXCD, off = wgid / NXCD; wgid = (xcd < r ? xcd * (q + 1) : r * (q + 1) + (xcd - r) * q) + off; }
        const int nig = WGM * nN, gid = wgid / nig, fm = gid * WGM, gsz = (nM - fm) < WGM ? (nM - fm) : WGM;
        pm = fm + ((wgid % nig) % gsz); pn = (wgid % nig) / gsz; return true;
    }
};
struct DenseSched {
    StaticOrder so; const char* A; const char* B; size_t tA, tB;
    __device__ void init(const void* A_, const void* B_, int M, int N, int lda, int ldb, int G, int c) { so.init(M, N, G, c); A = (const char*)A_; B = (const char*)B_; tA = (size_t)BM * lda * 2; tB = (size_t)BM * ldb * 2; }
    __device__ __forceinline__ bool next(int i, Unit& u) const {
        int pm, pn; if (!so.next(i, pm, pn)) return false;
        u.pm = pm; u.pn = pn; u.pA = A + (size_t)pm * tA; u.pB = B + (size_t)pn * tB; u.pB2 = u.pB; u.lst = nullptr; u.nv = BM; u.aux = i; return true;
    }
};

typedef __bf16 bf16x2_t __attribute__((ext_vector_type(2)));
__device__ __forceinline__ unsigned cvt_pk_bf16(float lo, float hi) { const f32x2 v = {lo, hi}; const bf16x2_t b = __builtin_convertvector(v, bf16x2_t); return __builtin_bit_cast(unsigned, b); }

template <class Epi, class Sched, bool GATHER, bool SPLITB>
__device__ __forceinline__ void gemm_phase(LAS unsigned char* lds, const int tid_in, const int K, const int lda, const int ldb, const Sched& S, const Epi& E) {
    int tid = tid_in; asm volatile("" : "+v"(tid));
    const int wid = __builtin_amdgcn_readfirstlane(tid >> 6), lane = tid & 63, wr = wid >> 2, wc = wid & 3, fr = lane & 15, fq = lane >> 4;
    int nt = K / BK; asm volatile("" : "+s"(nt));
    const int ntB = nt >> 1;
    unsigned voffA[2], voffB[2];
#pragma unroll
    for (int i = 0; i < 2; ++i) { int R, C; stage_rc(tid * 16 + i * 8192, R, C); const int Rb = (R & ~31) + perm32(R & 31); voffA[i] = (unsigned)(R * lda + C) * 2u; voffB[i] = (unsigned)(Rb * ldb + C) * 2u; }
    const size_t kstep = (size_t)(BK * 2);
    const size_t hstepB = (size_t)HALF * ldb * 2;
    const size_t hstepA = (size_t)HALF * lda * 2;
    const unsigned ldsw = (unsigned)wid * 1024u;
    const int aoff = lds_byte(wr * 64 + fr, fq * 8), boff = lds_byte(wc * 32 + fr, fq * 8);
#define PG8_SA(b, h) (((b) * 2 + (h)) * HTB)
#define PG8_SB(b, h) ((4 + (b) * 2 + (h)) * HTB)
#define PG8_STAGE(bufoff, gbase, voff) do { _Pragma("unroll") for (int _i = 0; _i < 2; ++_i) \
        __builtin_amdgcn_global_load_lds((const unsigned*)((const char*)(gbase) + (voff)[_i]), (LAS unsigned*)(lds + (bufoff) + ldsw + _i * 8192), 16, 0, 0); } while (0)
#define PG8_LDA(dst, b, h) do { _Pragma("unroll") for (int m = 0; m < 4; ++m) _Pragma("unroll") for (int k = 0; k < 2; ++k) dst[m][k] = *(const LAS bf16x8*)(lds + PG8_SA(b, h) + aoff + m * 2048 + k * 1024); } while (0)
#define PG8_LDB(dst, b, h) do { _Pragma("unroll") for (int n = 0; n < 2; ++n) _Pragma("unroll") for (int k = 0; k < 2; ++k) dst[n][k] = *(const LAS bf16x8*)(lds + PG8_SB(b, h) + boff + n * 2048 + k * 1024); } while (0)
#define PG8_MMA(ai, bj, At, Bt) do { __builtin_amdgcn_s_setprio(1); _Pragma("unroll") for (int m = 0; m < 4; ++m) _Pragma("unroll") for (int n = 0; n < 2; ++n) _Pragma("unroll") for (int k = 0; k < 2; ++k) \
        acc[ai][bj][m][n] = __builtin_amdgcn_mfma_f32_16x16x32_bf16(Bt[n][k], At[m][k], acc[ai][bj][m][n], 0, 0, 0); __builtin_amdgcn_s_setprio(0); } while (0)
#define PG8_WAIT_V(n) asm volatile("s_waitcnt vmcnt(" #n ")" ::: "memory")
#define PG8_WAIT_L(n) asm volatile("s_waitcnt lgkmcnt(" #n ")" ::: "memory")
#define PG8_BAR __builtin_amdgcn_s_barrier()
#define PG8_SCHED __builtin_amdgcn_sched_barrier(0)
#define PG8_GOFF(G, u) do { if constexpr (GATHER) { _Pragma("unroll") for (int _h = 0; _h < 2; ++_h) _Pragma("unroll") for (int _i = 0; _i < 2; ++_i) { \
        int _R, _C; stage_rc(tid * 16 + _i * 8192, _R, _C); int _ix = _h * HALF + _R; _ix = _ix < (u).nv ? _ix : (u).nv - 1; const int _tok = (u).lst[_ix]; G[_h][_i] = (unsigned)_tok * (unsigned)(lda * 2) + (unsigned)(_C * 2); } } } while (0)
#define PG8_STAGE_A(bufoff, gbase, half, G) do { if constexpr (GATHER) { PG8_STAGE(bufoff, gbase, G[half]); } else { PG8_STAGE(bufoff, (gbase) + (half) * hstepA, voffA); } } while (0)
#define PG8_BPTR(u, tt) ((SPLITB && (tt) >= ntB) ? (u).pB2 + (size_t)((tt) - ntB) * kstep : (u).pB + (size_t)(tt) * kstep)
    Unit cur; int ui = 0;
    if (!S.next(0, cur)) return;
    f32x4 acc[2][2][4][2];
#pragma unroll
    for (int a = 0; a < 2; ++a)
#pragma unroll
        for (int b = 0; b < 2; ++b)
#pragma unroll
            for (int m = 0; m < 4; ++m)
#pragma unroll
                for (int n = 0; n < 2; ++n) acc[a][b][m][n] = (f32x4){0.f, 0.f, 0.f, 0.f};
    bf16x8 At[4][2], B0[2][2], B1[2][2];
    unsigned cG[2][2];
    LAS u32x4* gstash = (LAS u32x4*)(lds + 135168) + tid;
    PG8_GOFF(cG, cur);
    const char* cA = cur.pA; const char* cB = cur.pB;
    PG8_STAGE(PG8_SB(0, 0), cB, voffB); PG8_STAGE(PG8_SB(0, 1), cB + hstepB, voffB); PG8_STAGE_A(PG8_SA(0, 0), cA, 0, cG); PG8_STAGE_A(PG8_SA(0, 1), cA, 1, cG);
    if (wr == 1) PG8_BAR;
    PG8_WAIT_V(2); PG8_BAR;
    PG8_STAGE(PG8_SB(1, 0), cB + kstep, voffB); PG8_STAGE_A(PG8_SA(1, 0), cA + kstep, 0, cG); PG8_STAGE(PG8_SB(1, 1), cB + hstepB + kstep, voffB);
    PG8_WAIT_V(6); PG8_BAR;
    for (;;) {
        Unit nxt; const bool has_next = S.next(ui + 1, nxt);
        if constexpr (GATHER) { unsigned nG[2][2];
            if (has_next) { PG8_GOFF(nG, nxt); } else {
#pragma unroll
            for (int h = 0; h < 2; ++h)
#pragma unroll
                for (int i = 0; i < 2; ++i) nG[h][i] = cG[h][i]; }
            *gstash = (u32x4){nG[0][0], nG[0][1], nG[1][0], nG[1][1]}; }
        const char* nA = has_next ? nxt.pA : cA; const char* nB = has_next ? nxt.pB : cB;
        for (int t = 0; t < nt; t += 2) {
            const bool last = (t == nt - 2);
            const char* a1 = cA + (size_t)(t + 1) * kstep;
            const char* a2 = last ? nA : cA + (size_t)(t + 2) * kstep; const char* a3 = a2 + kstep;
            const char* b2 = last ? nB : PG8_BPTR(cur, t + 2); const char* b3 = b2 + kstep;
            unsigned g2[2][2];
            if constexpr (GATHER) {
                if (last) { const u32x4 st = *gstash; g2[0][0] = st.x; g2[0][1] = st.y; g2[1][0] = st.z; g2[1][1] = st.w; }
                else {
#pragma unroll
                for (int h = 0; h < 2; ++h)
#pragma unroll
                    for (int i = 0; i < 2; ++i) g2[h][i] = cG[h][i]; } }
            PG8_LDB(B0, 0, 0); PG8_LDB(B1, 0, 1); PG8_SCHED; PG8_LDA(At, 0, 0); PG8_STAGE_A(PG8_SA(1, 1), a1, 1, cG);
            PG8_WAIT_V(8); PG8_WAIT_L(0); PG8_BAR; PG8_MMA(0, 0, At, B0); PG8_MMA(0, 1, At, B1); PG8_BAR; PG8_SCHED;
            PG8_LDA(At, 0, 1); PG8_STAGE(PG8_SB(0, 0), b2, voffB); PG8_STAGE(PG8_SB(0, 1), b2 + hstepB, voffB); PG8_STAGE_A(PG8_SA(0, 0), a2, 0, g2);
            PG8_WAIT_V(8); PG8_WAIT_L(0); PG8_BAR; PG8_MMA(1, 0, At, B0); PG8_MMA(1, 1, At, B1); PG8_BAR; PG8_SCHED;
            PG8_LDB(B0, 1, 0); PG8_LDB(B1, 1, 1); PG8_SCHED; PG8_LDA(At, 1, 0); PG8_STAGE_A(PG8_SA(0, 1), a2, 1, g2);
            PG8_WAIT_V(8); PG8_WAIT_L(0); PG8_BAR; PG8_MMA(0, 0, At, B0); PG8_MMA(0, 1, At, B1); PG8_BAR; PG8_SCHED;
            PG8_LDA(At, 1, 1); PG8_STAGE(PG8_SB(1, 0), b3, voffB); PG8_STAGE(PG8_SB(1, 1), b3 + hstepB, voffB); PG8_STAGE_A(PG8_SA(1, 0), a3, 0, g2);
            PG8_WAIT_V(8); PG8_WAIT_L(0); PG8_BAR; PG8_MMA(1, 0, At, B0); PG8_MMA(1, 1, At, B1); PG8_BAR; PG8_SCHED;
        }
        if (wr == 0) PG8_BAR;
        E(acc, cur, wr, wc, fr, fq);
        if (!has_next) break;
#pragma unroll
        for (int a = 0; a < 2; ++a)
#pragma unroll
            for (int b = 0; b < 2; ++b)
#pragma unroll
                for (int m = 0; m < 4; ++m)
#pragma unroll
                    for (int n = 0; n < 2; ++n) acc[a][b][m][n] = (f32x4){0.f, 0.f, 0.f, 0.f};
        ++ui; (void)S.next(ui, cur); cA = nA; cB = nB;
        if constexpr (GATHER) { const u32x4 st = *gstash; cG[0][0] = st.x; cG[0][1] = st.y; cG[1][0] = st.z; cG[1][1] = st.w; }
        if (wr == 1) PG8_BAR;
    }
    PG8_WAIT_V(0);
    PG8_BAR;
#undef PG8_SA
#undef PG8_SB
#undef PG8_STAGE
#undef PG8_LDA
#undef PG8_LDB
#undef PG8_MMA
#undef PG8_WAIT_V
#undef PG8_WAIT_L
#undef PG8_BAR
#undef PG8_SCHED
#undef PG8_GOFF
#undef PG8_STAGE_A
#undef PG8_BPTR
}

typedef const f32x4 (&AccRef)[2][2][4][2];
#define EPI_ROW(u, ai, m) ((u).pm * BM + (ai) * HALF + wr * 64 + (m) * 16 + fr)
#define EPI_COL(u, bj) ((u).pn * BM + (bj) * HALF + wc * 32 + fq * 8)
__device__ __forceinline__ u32x4 pack8(const f32x4& a, const f32x4& b) { u32x4 w; w.x = cvt_pk_bf16(a[0], a[1]); w.y = cvt_pk_bf16(a[2], a[3]); w.z = cvt_pk_bf16(b[0], b[1]); w.w = cvt_pk_bf16(b[2], b[3]); return w; }
__device__ __forceinline__ float sq8(const f32x4& a, const f32x4& b) { return (a[0] * a[0] + a[1] * a[1]) + (a[2] * a[2] + a[3] * a[3]) + (b[0] * b[0] + b[1] * b[1]) + (b[2] * b[2] + b[3] * b[3]); }
__device__ __forceinline__ void unpack8(const u32x4& w, f32x4& a, f32x4& b) { a = (f32x4){bflo(w.x), bfhi(w.x), bflo(w.y), bfhi(w.y)}; b = (f32x4){bflo(w.z), bfhi(w.z), bflo(w.w), bfhi(w.w)}; }

struct EpiBf16 {
    bf16_t* O; int ldc;
    __device__ __forceinline__ void operator()(AccRef acc, const Unit& u, int wr, int wc, int fr, int fq) const {
#pragma unroll
        for (int ai = 0; ai < 2; ++ai)
#pragma unroll
            for (int m = 0; m < 4; ++m) { bf16_t* rowp = O + (size_t)EPI_ROW(u, ai, m) * ldc;
#pragma unroll
                for (int bj = 0; bj < 2; ++bj) *(u32x4*)(rowp + EPI_COL(u, bj)) = pack8(acc[ai][bj][m][0], acc[ai][bj][m][1]); }
    }
};
struct EpiInAb {
    bf16_t* Z;
    __device__ __forceinline__ void operator()(AccRef acc, const Unit& u, int wr, int wc, int fr, int fq) const {
        if (u.pn >= 10) {
#pragma unroll
            for (int ai = 0; ai < 2; ++ai)
#pragma unroll
                for (int m = 0; m < 4; ++m) { bf16_t* rowp = Z + (size_t)EPI_ROW(u, ai, m) * ZW;
                    const f32x4 a = acc[ai][0][m][0] * acc[ai][1][m][0], b = acc[ai][0][m][1] * acc[ai][1][m][1];
                    *(u32x4*)(rowp + 2560 + (u.pn - 10) * HALF + wc * 32 + fq * 8) = pack8(a, b); }
        } else if (u.pn < 2) {
#pragma unroll
            for (int ai = 0; ai < 2; ++ai)
#pragma unroll
                for (int m = 0; m < 4; ++m) { bf16_t* rowp = Z + (size_t)EPI_ROW(u, ai, m) * ZW;
#pragma unroll
                    for (int bj = 0; bj < 2; ++bj) { f32x4 a = acc[ai][bj][m][0], b = acc[ai][bj][m][1];
#pragma unroll
                        for (int j = 0; j < 4; ++j) { a[j] = siluf_(a[j]); b[j] = siluf_(b[j]); }
                        *(u32x4*)(rowp + EPI_COL(u, bj)) = pack8(a, b); }
                    asm volatile("" ::: "memory"); }
        } else {
#pragma unroll
            for (int ai = 0; ai < 2; ++ai)
#pragma unroll
                for (int m = 0; m < 4; ++m) { bf16_t* rowp = Z + (size_t)EPI_ROW(u, ai, m) * ZW;
#pragma unroll
                    for (int bj = 0; bj < 2; ++bj) *(u32x4*)(rowp + EPI_COL(u, bj)) = pack8(acc[ai][bj][m][0], acc[ai][bj][m][1]); }
        }
    }
};
struct EpiRes {
    const float* X; float* O; const float* bias; bf16_t* HB;
    __device__ __forceinline__ void operator()(AccRef acc, const Unit& u, int wr, int wc, int fr, int fq) const {
        f32x4 bv[2][2];
#pragma unroll
        for (int bj = 0; bj < 2; ++bj) { const int c = EPI_COL(u, bj); bv[bj][0] = bias ? *(const f32x4*)(bias + c) : (f32x4){0.f, 0.f, 0.f, 0.f}; bv[bj][1] = bias ? *(const f32x4*)(bias + c + 4) : (f32x4){0.f, 0.f, 0.f, 0.f}; }
#pragma unroll
        for (int ai = 0; ai < 2; ++ai) { f32x4 xv[4][2][2];
#pragma unroll
            for (int m = 0; m < 4; ++m) { const size_t ro = (size_t)EPI_ROW(u, ai, m) * D;
#pragma unroll
                for (int bj = 0; bj < 2; ++bj) { const int c = EPI_COL(u, bj); xv[m][bj][0] = *(const f32x4*)(X + ro + c); xv[m][bj][1] = *(const f32x4*)(X + ro + c + 4); } }
#pragma unroll
            for (int m = 0; m < 4; ++m) { const size_t ro = (size_t)EPI_ROW(u, ai, m) * D;
#pragma unroll
                for (int bj = 0; bj < 2; ++bj) { const int c = EPI_COL(u, bj);
                    const f32x4 h0 = xv[m][bj][0] + bv[bj][0] + acc[ai][bj][m][0], h1 = xv[m][bj][1] + bv[bj][1] + acc[ai][bj][m][1];
                    *(f32x4*)(O + ro + c) = h0; *(f32x4*)(O + ro + c + 4) = h1; *(u32x4*)(HB + ro + c) = pack8(h0, h1); } }
            asm volatile("" ::: "memory"); }
    }
};
__device__ __forceinline__ float rstd16(const float* ss, int row) {
    const f32x4* p = (const f32x4*)(ss + (size_t)row * 16); const f32x4 a = p[0], b = p[1], c = p[2], d = p[3];
    const float s = ((a[0] + a[1]) + (a[2] + a[3])) + ((b[0] + b[1]) + (b[2] + b[3])) + ((c[0] + c[1]) + (c[2] + c[3])) + ((d[0] + d[1]) + (d[2] + d[3]));
    return __builtin_amdgcn_rsqf(s * (1.f / D) + EPS);
}
constexpr int RSL_OFF = 135168;
template <class Sched> __device__ __forceinline__ void rstd_table(LAS unsigned char* lds, const int tid_in, const Sched& S, const float* ss) {
    LAS float* RSL = (LAS float*)(lds + RSL_OFF); int tid = tid_in; asm volatile("" : "+v"(tid));
    for (int i = tid >> 8; i < 8; i += 2) { Unit u; if (!S.next(i, u)) break; RSL[i * 256 + (tid & 255)] = rstd16(ss, u.pm * BM + (tid & 255)); }
    __syncthreads();
}
struct EpiQkv {
    bf16_t* O; const float* bias; const LAS float* RSL;
    __device__ __forceinline__ void operator()(AccRef acc, const Unit& u, int wr, int wc, int fr, int fq) const {
        float rs[2][4];
#pragma unroll
        for (int ai = 0; ai < 2; ++ai)
#pragma unroll
            for (int m = 0; m < 4; ++m) rs[ai][m] = RSL[u.aux * 256 + ai * HALF + wr * 64 + m * 16 + fr];
        f32x4 bv[2][2];
#pragma unroll
        for (int bj = 0; bj < 2; ++bj) { const int c = EPI_COL(u, bj); bv[bj][0] = *(const f32x4*)(bias + c); bv[bj][1] = *(const f32x4*)(bias + c + 4); }
#pragma unroll
        for (int ai = 0; ai < 2; ++ai)
#pragma unroll
            for (int m = 0; m < 4; ++m) { bf16_t* rowp = O + (size_t)EPI_ROW(u, ai, m) * CIN;
#pragma unroll
                for (int bj = 0; bj < 2; ++bj) *(u32x4*)(rowp + EPI_COL(u, bj)) = pack8(acc[ai][bj][m][0] * rs[ai][m] + bv[bj][0], acc[ai][bj][m][1] * rs[ai][m] + bv[bj][1]); }
    }
};
struct EpiG1 {
    bf16_t* HID; const f32x2* wl; const float* rl;
    __device__ __forceinline__ void operator()(AccRef acc, const Unit& u, int wr, int wc, int fr, int fq) const {
        float wv[2][4], rv[2][4];
#pragma unroll
        for (int ai = 0; ai < 2; ++ai)
#pragma unroll
            for (int m = 0; m < 4; ++m) { const int rit = ai * HALF + wr * 64 + m * 16 + fr; const f32x2 w2 = wl[(size_t)u.aux + rit]; wv[ai][m] = (u.pn < 4) ? w2.x : w2.y; rv[ai][m] = rl[(size_t)u.aux + rit]; }
#pragma unroll
        for (int ai = 0; ai < 2; ++ai)
#pragma unroll
            for (int m = 0; m < 4; ++m) { const int rit = ai * HALF + wr * 64 + m * 16 + fr;
                const float rs = rv[ai][m], wrs = wv[ai][m] * rs;
                bf16_t* rowp = HID + (size_t)(u.pm * BM + rit) * 1024 + (u.pn >> 2) * 512 + (u.pn & 3) * HALF + wc * 32 + fq * 8;
                f32x4 a, b;
#pragma unroll
                for (int j = 0; j < 4; ++j) { a[j] = siluf_(acc[ai][0][m][0][j] * rs) * acc[ai][1][m][0][j] * wrs; b[j] = siluf_(acc[ai][0][m][1][j] * rs) * acc[ai][1][m][1][j] * wrs; }
                *(u32x4*)rowp = pack8(a, b); }
    }
};
struct EpiG2 {
    float* H; bf16_t* HB; float* SS;
    __device__ __forceinline__ void operator()(AccRef acc, const Unit& u, int wr, int wc, int fr, int fq) const {
        int tk[2][4];
#pragma unroll
        for (int ai = 0; ai < 2; ++ai)
#pragma unroll
            for (int m = 0; m < 4; ++m) { const int rit = ai * HALF + wr * 64 + m * 16 + fr; tk[ai][m] = (rit < u.nv) ? u.lst[rit] : -1; }
#pragma unroll
        for (int ai = 0; ai < 2; ++ai) { f32x4 hv[4][2][2];
#pragma unroll
            for (int m = 0; m < 4; ++m) { const int tok = tk[ai][m]; const size_t ro = (size_t)(tok < 0 ? 0 : tok) * D;
#pragma unroll
                for (int bj = 0; bj < 2; ++bj) { const int c = EPI_COL(u, bj); hv[m][bj][0] = *(const f32x4*)(H + ro + c); hv[m][bj][1] = *(const f32x4*)(H + ro + c + 4); } }
#pragma unroll
            for (int m = 0; m < 4; ++m) { const int tok = tk[ai][m]; const bool ok = tok >= 0; const size_t ro = (size_t)(ok ? tok : 0) * D; float part = 0.f;
#pragma unroll
                for (int bj = 0; bj < 2; ++bj) { const int c = EPI_COL(u, bj);
                    const f32x4 h0 = hv[m][bj][0] + acc[ai][bj][m][0], h1 = hv[m][bj][1] + acc[ai][bj][m][1];
                    if (ok) { *(f32x4*)(H + ro + c) = h0; *(f32x4*)(H + ro + c + 4) = h1; *(u32x4*)(HB + ro + c) = pack8(h0, h1); } part += sq8(h0, h1); }
                part += __shfl_xor(part, 16); part += __shfl_xor(part, 32);
                if (ok && fq == 0) SS[(size_t)tok * 16 + u.pn * 4 + wc] = part; }
            asm volatile("" ::: "memory"); }
    }
};
struct EpiPle {
    float* H; bf16_t* HB; const bf16_t* PP; const LAS float* RSL; float* sso;
    __device__ __forceinline__ void operator()(AccRef acc, const Unit& u, int wr, int wc, int fr, int fq) const {
#pragma unroll
        for (int ai = 0; ai < 2; ++ai)
#pragma unroll
            for (int mp = 0; mp < 2; ++mp) { f32x4 hv[2][2][2]; u32x4 pv[2][2];
#pragma unroll
                for (int mm = 0; mm < 2; ++mm) { const size_t ro = (size_t)EPI_ROW(u, ai, 2 * mp + mm) * D;
#pragma unroll
                    for (int bj = 0; bj < 2; ++bj) { const int c = EPI_COL(u, bj); hv[mm][bj][0] = *(const f32x4*)(H + ro + c); hv[mm][bj][1] = *(const f32x4*)(H + ro + c + 4); pv[mm][bj] = *(const u32x4*)(PP + ro + c); } }
#pragma unroll
                for (int mm = 0; mm < 2; ++mm) { const int m = 2 * mp + mm; const int row = EPI_ROW(u, ai, m); const size_t ro = (size_t)row * D; const float r_ = RSL[u.aux * 256 + ai * HALF + wr * 64 + m * 16 + fr]; float part = 0.f;
#pragma unroll
                    for (int bj = 0; bj < 2; ++bj) { const int c = EPI_COL(u, bj);
                        f32x4 p0, p1; unpack8(pv[mm][bj], p0, p1); f32x4 h0 = hv[mm][bj][0], h1 = hv[mm][bj][1];
#pragma unroll
                        for (int j = 0; j < 4; ++j) { h0[j] += sigmoidf_(acc[ai][bj][m][0][j] * r_) * p0[j]; h1[j] += sigmoidf_(acc[ai][bj][m][1][j] * r_) * p1[j]; }
                        *(f32x4*)(H + ro + c) = h0; *(f32x4*)(H + ro + c + 4) = h1; *(u32x4*)(HB + ro + c) = pack8(h0, h1); part += sq8(h0, h1); }
                    part += __shfl_xor(part, 16); part += __shfl_xor(part, 32);
                    if (fq == 0) sso[(size_t)row * 16 + u.pn * 4 + wc] = part; }
                asm volatile("" ::: "memory"); }
    }
};
}

#define XB_TMO      128
#define XB_XCNT(j)  (256  + 64 * (j))
#define XB_XSUB(j)  (1280 + 64 * (j))
#define XB_XGEN(j)  (2304 + 64 * (j))
#define XB_TOP      3328
#define XB_TOPGEN   3392
#define XCD_BAR_WORDS 3456
#define XB_SPIN_CAP (1u << 18)
__device__ __forceinline__ unsigned xb_ld(unsigned* p)              { return __hip_atomic_load(p, __ATOMIC_RELAXED, __HIP_MEMORY_SCOPE_AGENT); }
__device__ __forceinline__ unsigned xb_add(unsigned* p, unsigned v) { return __hip_atomic_fetch_add(p, v, __ATOMIC_RELAXED, __HIP_MEMORY_SCOPE_AGENT); }
__device__ __forceinline__ unsigned xb_xcc_id() { return (unsigned)__builtin_amdgcn_s_getreg((3 << 11) | 20) & 0xFu; }
#define XB_SPIN(cond, bar) do { unsigned _sp = 0; while (cond) { __builtin_amdgcn_s_sleep(1); \
    if ((++_sp & 255u) == 0u) { if (xb_ld(&(bar)[XB_TMO])) break; if (_sp > XB_SPIN_CAP) { atomicAdd(&(bar)[XB_TMO], 1u); break; } } } } while (0)
struct XcdBarrier { unsigned* bar; unsigned x; volatile LAS unsigned* st; int w0; };
__device__ __forceinline__ bool xb_tid0(int w0) { (void)w0; return threadIdx.x == 0; }
__device__ __forceinline__ XcdBarrier xcd_barrier_post(unsigned* bar, volatile LAS unsigned* st, int w0) {
    XcdBarrier b; b.bar = bar; b.x = (unsigned)__builtin_amdgcn_readfirstlane((int)xb_xcc_id()); b.st = st; b.w0 = w0;
    if (xb_tid0(w0)) (void)xb_add(&bar[XB_XCNT(b.x)], 1u);
    return b;
}
__device__ __forceinline__ void xcd_barrier_complete(unsigned* bar, unsigned x, unsigned& nloc, unsigned& nx) {
    const unsigned G = gridDim.x * gridDim.y * gridDim.z;
    unsigned sum, cnt, mine, sp = 0u;
    for (;;) {
        sum = 0u; cnt = 0u; mine = 0u;
#pragma unroll
        for (unsigned j = 0; j < 16; ++j) { const unsigned c = xb_ld(&bar[XB_XCNT(j)]); sum += c; cnt += (c > 0u) ? 1u : 0u; mine = (j == x) ? c : mine; }
        if (sum == G) break;
        __builtin_amdgcn_s_sleep(1);
        if ((++sp & 255u) == 0u) { if (xb_ld(&bar[XB_TMO])) break; if (sp > XB_SPIN_CAP) { atomicAdd(&bar[XB_TMO], 1u); break; } }
    }
    nloc = mine > 0u ? mine : 1u; nx = cnt > 0u ? cnt : 1u;
}
__device__ __forceinline__ void xcd_barrier(const XcdBarrier& b) {
    asm volatile("s_waitcnt vmcnt(0)" ::: "memory");
    __syncthreads();
    if (xb_tid0(b.w0)) {
        unsigned* bar = b.bar; asm volatile("" : "+s"(bar));
        __builtin_amdgcn_s_waitcnt(0);
        unsigned nloc = b.st[0], nx = b.st[1];
        if (nloc == 0u) { xcd_barrier_complete(bar, b.x, nloc, nx); b.st[0] = nloc; b.st[1] = nx; }
        const unsigned old = xb_add(&bar[XB_XSUB(b.x)], 1u);
        const unsigned gen = old / nloc;
        if (old + 1u == (gen + 1u) * nloc) {
            __builtin_amdgcn_fence(__ATOMIC_RELEASE, "agent");
            asm volatile("s_waitcnt vmcnt(0)" ::: "memory");
            const unsigned og = xb_add(&bar[XB_TOP], 1u);
            const unsigned tg = og / nx;
            if (og + 1u == (tg + 1u) * nx) xb_add(&bar[XB_TOPGEN], 1u);
            else XB_SPIN(xb_ld(&bar[XB_TOPGEN]) == tg, bar);
            __builtin_amdgcn_fence(__ATOMIC_ACQUIRE, "agent");
            xb_add(&bar[XB_XGEN(b.x)], 1u);
            asm volatile("s_waitcnt vmcnt(0)" ::: "memory");
        } else {
            XB_SPIN(xb_ld(&bar[XB_XGEN(b.x)]) == gen, bar);
            __builtin_amdgcn_fence(__ATOMIC_ACQUIRE, "agent");
            asm volatile("s_waitcnt vmcnt(0)" ::: "memory");
        }
    }
    __syncthreads();
}

struct Args {
    const float* x; const float* p; const float* norm_mix; const float* norm_ffn; const float* norm_ple; const float* norm_final;
    const float* w_in_ab; const float* lb_logits; const float* hgrn_out_norm; const float* conv_w; const float* w_out_ab;
    const float* w_in_c; const float* b_in_c; const float* sinks; const float* w_out_c; const float* b_out_c;
    const float* w_router; const float* w_gate_e; const float* w_up_e; const float* w_down_e; const float* w_ple_gate; const float* w_ple_proj;
    float* out; unsigned char* ws; int ph_lo, ph_hi;
};
struct Frame { LAS unsigned char* lds; int tid, lane, wave, vcu, G; };

__device__ __forceinline__ void transpose_item(const float* W, int N, int src_n0, int k0, bf16_t* dst  , int ldk, const float* gs, LAS float* scr, int lane) {
#pragma unroll 8
    for (int i = 0; i < 32; ++i) { const int kk = 2 * i + (lane >> 5); scr[kk * 33 + (lane & 31)] = W[(size_t)(k0 + kk) * N + src_n0 + (lane & 31)]; }
    LDS_WAIT(); asm volatile("" ::: "memory");
    const int c = lane & 7;
    float g8[8];
#pragma unroll
    for (int q = 0; q < 8; ++q) g8[q] = gs ? gs[k0 + 8 * c + q] : 1.f;
#pragma unroll
    for (int j = 0; j < 4; ++j) { const int n = (lane >> 3) + 8 * j; const LAS float* s = scr + (8 * c) * 33 + n;
        u32x4 o; o.x = pk2(s[0 * 33] * g8[0], s[1 * 33] * g8[1]); o.y = pk2(s[2 * 33] * g8[2], s[3 * 33] * g8[3]); o.z = pk2(s[4 * 33] * g8[4], s[5 * 33] * g8[5]); o.w = pk2(s[6 * 33] * g8[6], s[7 * 33] * g8[7]);
        *(u32x4*)(dst + (size_t)n * ldk + k0 + 8 * c) = o; }
    LDS_WAIT(); asm volatile("" ::: "memory");
}
__device__ __forceinline__ void phase_prep(const Frame& F, const Args& a) {
    unsigned char* ws = a.ws;
    LAS float* scr = (LAS float*)(F.lds + F.wave * 16384);
    const int gw = F.vcu * NWAVES + F.wave, NGW = F.G * NWAVES;
    constexpr int I_INAB = 16 * (ABIN / 32), I_SQ = 16 * 32, I_INC = 16 * (CIN / 32), I_PP = 4 * 32, I_W1 = 16 * 32, I_W2 = 8 * 32;
    constexpr int T0 = I_INAB, T1 = T0 + I_SQ, T2 = T1 + I_INC, T3 = T2 + I_SQ, T4 = T3 + 2 * I_SQ, T5 = T4 + 2 * I_PP, T6 = T5 + 32 * I_W1, T7 = T6 + 32 * I_W2;
    for (int it = gw; it < T7; it += NGW) {
        if (it < T0) { const int kb = it / (ABIN / 32), nb = it % (ABIN / 32), n0 = nb * 32; int src;
            if (n0 < 2560) src = n0; else { const int q = (n0 - 2560) >> 8, r = (n0 - 2560) & 255; src = (r < 128) ? 2560 + q * 128 + r : 3072 + q * 128 + (r - 128); }
            transpose_item(a.w_in_ab, ABIN, src, kb * 64, (bf16_t*)(ws + WS_WINAB) + (size_t)n0 * D, D, a.norm_mix, scr, F.lane); }
        else if (it < T1) { const int r = it - T0, kb = r / 32, nb = r % 32; transpose_item(a.w_out_ab, D, nb * 32, kb * 64, (bf16_t*)(ws + WS_WOUTAB) + (size_t)nb * 32 * D, D, nullptr, scr, F.lane); }
        else if (it < T2) { const int r = it - T1, kb = r / (CIN / 32), nb = r % (CIN / 32); transpose_item(a.w_in_c, CIN, nb * 32, kb * 64, (bf16_t*)(ws + WS_WINC) + (size_t)nb * 32 * D, D, a.norm_mix + D, scr, F.lane); }
        else if (it < T3) { const int r = it - T2, kb = r / 32, nb = r % 32; transpose_item(a.w_out_c, D, nb * 32, kb * 64, (bf16_t*)(ws + WS_WOUTC) + (size_t)nb * 32 * D, D, nullptr, scr, F.lane); }
        else if (it < T4) { const int r = it - T3, l = r / I_SQ, q = r % I_SQ, kb = q / 32, nb = q % 32;
            transpose_item(a.w_ple_gate + (size_t)l * D * D, D, nb * 32, kb * 64, (bf16_t*)(ws + WS_WPG) + (size_t)l * D * D + (size_t)nb * 32 * D, D, a.norm_ple + l * D, scr, F.lane); }
        else if (it < T5) { const int r = it - T4, l = r / I_PP, q = r % I_PP, kb = q / 32, nb = q % 32;
            transpose_item(a.w_ple_proj + (size_t)l * PLE * D, D, nb * 32, kb * 64, (bf16_t*)(ws + WS_WPP) + (size_t)l * D * PLE + (size_t)nb * 32 * PLE, PLE, nullptr, scr, F.lane); }
        else if (it < T6) { const int r = it - T5, le = r / I_W1, q = r % I_W1, kb = q / 32, nb = q % 32, n0 = nb * 32, uq = n0 >> 8, rr = n0 & 255;
            const float* src = (rr < 128) ? a.w_gate_e + (size_t)le * D * DE : a.w_up_e + (size_t)le * D * DE; const int sn = uq * 128 + (rr & 127);
            transpose_item(src, DE, sn, kb * 64, (bf16_t*)(ws + WS_W1) + (size_t)le * D * D + (size_t)n0 * D, D, a.norm_ffn + (le >> 4) * D, scr, F.lane); }
        else { const int r = it - T6, le = r / I_W2, q = r % I_W2, kb = q / 32, nb = q % 32;
            transpose_item(a.w_down_e + (size_t)le * DE * D, D, nb * 32, kb * 64, (bf16_t*)(ws + WS_W2) + (size_t)le * D * DE + (size_t)nb * 32 * DE, DE, nullptr, scr, F.lane); }
    }
    const int gt = F.vcu * NTHR + F.tid, NGT = F.G * NTHR;
    if (gt < AW) { const float l0 = a.lb_logits[gt], l1 = a.lb_logits[AW + gt], l2 = a.lb_logits[2 * AW + gt]; const float mx = fmaxf(l0, fmaxf(l1, l2));
        const float e0 = __expf(l0 - mx), e1 = __expf(l1 - mx), e2 = __expf(l2 - mx); ((float*)(ws + WS_LB))[gt] = e0 / (e0 + e1 + e2); }
    { const f32x4* src = (const f32x4*)a.p; u32x4* dst = (u32x4*)(ws + WS_PB); const int n8 = 2 * NT * PLE / 8;
        for (int i = gt; i < n8; i += NGT) { const f32x4 v0 = src[2 * i], v1 = src[2 * i + 1]; u32x4 o; o.x = pk2(v0[0], v0[1]); o.y = pk2(v0[2], v0[3]); o.z = pk2(v1[0], v1[1]); o.w = pk2(v1[2], v1[3]); dst[i] = o; } }
    for (int m = gw; m < NT; m += NGW) { const f32x4* xr = (const f32x4*)(a.x + (size_t)m * D) + F.lane; f32x4 v[4]; float s = 0.f;
#pragma unroll
        for (int j = 0; j < 4; ++j) { v[j] = xr[64 * j]; s += (v[j][0] * v[j][0] + v[j][1] * v[j][1]) + (v[j][2] * v[j][2] + v[j][3] * v[j][3]); }
        const float rs = __builtin_amdgcn_rsqf(wave_sum(s) * (1.f / D) + EPS);
        u32x2* o8 = (u32x2*)((bf16_t*)(ws + WS_XA) + (size_t)m * D) + F.lane;
#pragma unroll
        for (int j = 0; j < 4; ++j) { u32x2 o; o.x = pk2(v[j][0] * rs, v[j][1] * rs); o.y = pk2(v[j][2] * rs, v[j][3] * rs); o8[64 * j] = o; } }
}

__device__ __forceinline__ void phase_hgrn_conv(const Frame& F, const Args& a) {
    unsigned char* ws = a.ws; const bf16_t* Z = (const bf16_t*)(ws + WS_Z); bf16_t* XA = (bf16_t*)(ws + WS_XA); const float* lbv = (const float*)(ws + WS_LB);
    LAS float* FG = (LAS float*)F.lds; LAS float* KK = FG + 4096; LAS float* QQ = KK + 4096; LAS float* VV = QQ + 4096; LAS float* OB = VV + 4096;
    const int tid = F.tid, lane = F.lane, w = F.wave;
    for (int it = F.vcu; it < NB * AH; it += F.G) {
        const int b = it >> 2, h = it & 3; const size_t row0 = (size_t)b * SEQ;
        const int vi = lane & 15, dq = lane >> 4, v = 16 * w + vi;
        float s[32];
#pragma unroll
        for (int i = 0; i < 32; ++i) s[i] = 0.f;
        const int ltt = tid >> 4, ldd = (tid & 15) * 8;
        float lb8[8], gn8[8];
#pragma unroll
        for (int j = 0; j < 8; ++j) { lb8[j] = lbv[h * ADK + ldd + j]; gn8[j] = a.hgrn_out_norm[ldd + j]; }
        for (int c = 0; c < SEQ / 32; ++c) {
            { const bf16_t* zr = Z + (row0 + c * 32 + ltt) * ZW + h * ADK + ldd;
                const u32x4 wq = *(const u32x4*)zr, wf = *(const u32x4*)(zr + 512), wv = *(const u32x4*)(zr + 1024);
                f32x4 q0, q1, f0, f1, v0, v1; pg8::unpack8(wq, q0, q1); pg8::unpack8(wf, f0, f1); pg8::unpack8(wv, v0, v1);
                f32x4 g0, g1, k0, k1;
#pragma unroll
                for (int j = 0; j < 4; ++j) { g0[j] = lb8[j] + (1.f - lb8[j]) * sigmoidf_(f0[j]); g1[j] = lb8[4 + j] + (1.f - lb8[4 + j]) * sigmoidf_(f1[j]); k0[j] = 1.f - g0[j]; k1[j] = 1.f - g1[j]; }
                const int o = ltt * 128 + ldd;
                *(LAS f32x4*)(FG + o) = g0; *(LAS f32x4*)(FG + o + 4) = g1; *(LAS f32x4*)(KK + o) = k0; *(LAS f32x4*)(KK + o + 4) = k1;
                *(LAS f32x4*)(QQ + o) = q0; *(LAS f32x4*)(QQ + o + 4) = q1; *(LAS f32x4*)(VV + o) = v0; *(LAS f32x4*)(VV + o + 4) = v1; }
            __syncthreads();
            for (int tt = 0; tt < 32; ++tt) {
                const float vt = VV[tt * 128 + v]; float acc = 0.f;
                const LAS f32x4* fg = (const LAS f32x4*)(FG + tt * 128 + dq * 32); const LAS f32x4* kk = (const LAS f32x4*)(KK + tt * 128 + dq * 32); const LAS f32x4* qq = (const LAS f32x4*)(QQ + tt * 128 + dq * 32);
#pragma unroll
                for (int d4 = 0; d4 < 8; ++d4) { const f32x4 f4 = fg[d4], k4 = kk[d4], q4 = qq[d4];
#pragma unroll
                    for (int j = 0; j < 4; ++j) { s[d4 * 4 + j] = f4[j] * s[d4 * 4 + j] + k4[j] * vt; acc += s[d4 * 4 + j] * q4[j]; } }
                acc += __shfl_xor(acc, 16); acc += __shfl_xor(acc, 32);
                if (dq == 0) OB[tt * 128 + v] = acc;
            }
            __syncthreads();
            { const f32x4 o0 = *(const LAS f32x4*)(OB + ltt * 128 + ldd), o1 = *(const LAS f32x4*)(OB + ltt * 128 + ldd + 4);
                float ss = pg8::sq8(o0, o1); ss += __shfl_xor(ss, 1); ss += __shfl_xor(ss, 2); ss += __shfl_xor(ss, 4); ss += __shfl_xor(ss, 8);
                const float rs = __builtin_amdgcn_rsqf(ss * (1.f / 128.f) + EPS);
                const size_t row = row0 + c * 32 + ltt; f32x4 g0, g1; pg8::unpack8(*(const u32x4*)(Z + row * ZW + 1536 + h * ADK + ldd), g0, g1);
                f32x4 r0, r1;
#pragma unroll
                for (int j = 0; j < 4; ++j) { r0[j] = o0[j] * rs * gn8[j] * sigmoidf_(g0[j]); r1[j] = o1[j] * rs * gn8[4 + j] * sigmoidf_(g1[j]); }
                u32x4 o; o.x = pk2(r0[0], r0[1]); o.y = pk2(r0[2], r0[3]); o.z = pk2(r1[0], r1[1]); o.w = pk2(r1[2], r1[3]);
                *(u32x4*)(XA + row * D + h * ADK + ldd) = o; }
        }
        __syncthreads();
    }
}

typedef short s16x4 __attribute__((ext_vector_type(4)));
constexpr int SEGT = 512, NSEG = SEQ / SEGT, NCH = SEGT / 32;
constexpr int HROW = 272, HL_TS = 32 * HROW;
constexpr int HL_LF = 0, HL_T = 16384, HL_DEC = 18432, HL_SUM = 18944, HL_QD = 20480, HL_KI = HL_QD + HL_TS, HL_KT = HL_KI + HL_TS, HL_VV = HL_KT + HL_TS, HL_OB = HL_VV + HL_TS;
__device__ __forceinline__ s16x4 lds_tr(const LAS unsigned char* p) { return __builtin_bit_cast(s16x4, __builtin_amdgcn_ds_read_tr16_b64_v4i16((LAS s16x4*)p)); }
__device__ __forceinline__ bf16x8 cat44(s16x4 a, s16x4 b) { return (bf16x8){a[0], a[1], a[2], a[3], b[0], b[1], b[2], b[3]}; }
__device__ __forceinline__ bf16x8 pk8(const f32x4& a, const f32x4& b) { return __builtin_bit_cast(bf16x8, pg8::pack8(a, b)); }
#define MFMA16(A, B, C) __builtin_amdgcn_mfma_f32_16x16x32_bf16(A, B, C, 0, 0, 0)
#ifndef HGRN_SELF
#define HGRN_SELF 0
#endif
#ifndef HGRN_CHECK
#define HGRN_CHECK 0
#endif
template <bool FULL>
__device__ __forceinline__ void hgrn_pass(const Frame& F, const Args& a) {
    unsigned char* ws = a.ws; const bf16_t* Z = (const bf16_t*)(ws + WS_Z); bf16_t* XA = (bf16_t*)(ws + WS_XA); const float* lbv = (const float*)(ws + WS_LB);
    float* HLg = (float*)(ws + WS_HL); float* HSg = (float*)(ws + WS_HSUM);
    LAS unsigned char* L = F.lds;
    LAS float* LF = (LAS float*)(L + HL_LF); LAS float* TT = (LAS float*)(L + HL_T); LAS float* DEC = (LAS float*)(L + HL_DEC); LAS float* SUM = (LAS float*)(L + HL_SUM); LAS float* OB = (LAS float*)(L + HL_OB);
    const LAS unsigned char* QD = L + HL_QD; const LAS unsigned char* KI = L + HL_KI; const LAS unsigned char* KT = L + HL_KT; const LAS unsigned char* VV = L + HL_VV;
    const int tid = F.tid, lane = F.lane, w = F.wave, r15 = lane & 15, g = lane >> 4, trq = r15 >> 2, trp = r15 & 3;
    const int tok = tid >> 4, d0 = (tid & 15) * 8, sd = tid & 127, tq = tid >> 7, Vw0 = 16 * w;
    for (int it = F.vcu; it < NB * AH * NSEG; it += F.G) {
        const int seg = it & (NSEG - 1), h = (it >> 3) & 3, b = it >> 5;
        if (!FULL && seg == NSEG - 1) continue;
        const size_t row0 = (size_t)b * SEQ + (size_t)seg * SEGT;
        float lb8[8], gn8[8];
#pragma unroll
        for (int e = 0; e < 8; ++e) { lb8[e] = lbv[h * ADK + d0 + e]; gn8[e] = a.hgrn_out_norm[d0 + e]; }
        f32x4 S[8];
#pragma unroll
        for (int mt = 0; mt < 8; ++mt) S[mt] = (f32x4){0.f, 0.f, 0.f, 0.f};
        const int pre = (FULL && (HGRN_SELF || HGRN_CHECK)) ? seg * NCH : 0;
        float chkbad = 0.f;
        if (FULL && seg > 0 && !HGRN_SELF) {
            const __amdgpu_buffer_rsrc_t rsL = __builtin_amdgcn_make_buffer_rsrc((void*)HLg, (short)0, 256 * 16384 * 4, 0x00020000);
            const __amdgpu_buffer_rsrc_t rsS = __builtin_amdgcn_make_buffer_rsrc((void*)HSg, (short)0, 256 * 128 * 4, 0x00020000);
            f32x4 cum[8];
#pragma unroll
            for (int mt = 0; mt < 8; ++mt) cum[mt] = (f32x4){0.f, 0.f, 0.f, 0.f};
            for (int sp = seg - 1; sp >= 0; --sp) { const int ip = it - seg + sp; const int lo = (ip * 16384 + (Vw0 + r15) * 128 + 4 * g) * 4, so = (ip * 128 + 4 * g) * 4;
#pragma unroll
                for (int mt = 0; mt < 8; ++mt) { const f32x4 l4 = __builtin_bit_cast(f32x4, __builtin_amdgcn_raw_buffer_load_b128(rsL, lo + mt * 64, 0, 16)), h4 = __builtin_bit_cast(f32x4, __builtin_amdgcn_raw_buffer_load_b128(rsS, so + mt * 64, 0, 16));
#pragma unroll
                    for (int r = 0; r < 4; ++r) { S[mt][r] += __expf(cum[mt][r]) * l4[r]; cum[mt][r] += h4[r]; } } }
        }
        if (FULL && HGRN_CHECK) { LAS f32x4* SA = (LAS f32x4*)(L + 73728) + tid * 4;
#pragma unroll
            for (int mt = 0; mt < 4; ++mt) { SA[mt] = S[mt]; }
#pragma unroll
            for (int mt = 0; mt < 8; ++mt) S[mt] = (f32x4){0.f, 0.f, 0.f, 0.f}; }
        if (tid < 128) SUM[tid] = 0.f;
        const bf16_t* zr = Z + (row0 - (size_t)pre * 32 + tok) * ZW + h * ADK + d0;
        u32x4 wq = (u32x4){0u, 0u, 0u, 0u}, wg = wq, wf = *(const u32x4*)(zr + 512), wv = *(const u32x4*)(zr + 1024);
        if (FULL) { wq = *(const u32x4*)zr; wg = *(const u32x4*)(zr + 1536); }
        for (int cc = 0; cc < pre + NCH; ++cc) { const int c = cc - pre; const bool outp = FULL && (c >= 0);
            if (FULL && HGRN_CHECK && c == 0 && seg > 0) { const LAS f32x4* SA = (const LAS f32x4*)(L + 73728) + tid * 4;
#pragma unroll
                for (int mt = 0; mt < 4; ++mt) { const f32x4 sa = SA[mt];
#pragma unroll
                    for (int r = 0; r < 4; ++r) if (!(fabsf(sa[r] - S[mt][r]) <= 1e-3f + 0.02f * fabsf(S[mt][r]))) chkbad = 1.f; } }
            if (FULL && HGRN_CHECK && chkbad != 0.f) { const unsigned long long t0 = __builtin_amdgcn_s_memrealtime(); while (__builtin_amdgcn_s_memrealtime() - t0 < 10000000000ull) __builtin_amdgcn_s_sleep(64); chkbad = 0.f; }
            float kk[8], qq[8];
            { f32x4 f0, f1, q0 = (f32x4){0.f, 0.f, 0.f, 0.f}, q1 = q0; pg8::unpack8(wf, f0, f1); if (FULL) pg8::unpack8(wq, q0, q1);
                f32x4 l0, l1;
#pragma unroll
                for (int e = 0; e < 4; ++e) { const float fa = lb8[e] + (1.f - lb8[e]) * sigmoidf_(f0[e]), fb = lb8[4 + e] + (1.f - lb8[4 + e]) * sigmoidf_(f1[e]);
                    kk[e] = 1.f - fa; kk[4 + e] = 1.f - fb; l0[e] = __logf(fa); l1[e] = __logf(fb); qq[e] = q0[e]; qq[4 + e] = q1[e]; }
                *(LAS f32x4*)(LF + tok * 128 + d0) = l0; *(LAS f32x4*)(LF + tok * 128 + d0 + 4) = l1;
                *(LAS u32x4*)(L + HL_VV + tok * HROW + d0 * 2) = wv; }
            const u32x4 cg = wg;
            if (c + 1 < NCH) { const bf16_t* zn = zr + (size_t)(cc + 1) * 32 * ZW; wf = *(const u32x4*)(zn + 512); wv = *(const u32x4*)(zn + 1024); if (FULL) { wq = *(const u32x4*)zn; wg = *(const u32x4*)(zn + 1536); } }
            __syncthreads();
            { float x[8];
#pragma unroll
                for (int e = 0; e < 8; ++e) x[e] = LF[(8 * tq + e) * 128 + sd];
#pragma unroll
                for (int e = 1; e < 8; ++e) x[e] += x[e - 1];
                TT[tq * 128 + sd] = x[7];
                __syncthreads();
                const float t0 = TT[sd], t1 = TT[128 + sd], t2 = TT[256 + sd];
                const float off = (tq > 0 ? t0 : 0.f) + (tq > 1 ? t1 : 0.f) + (tq > 2 ? t2 : 0.f);
#pragma unroll
                for (int e = 0; e < 8; ++e) LF[(8 * tq + e) * 128 + sd] = x[e] + off; }
            __syncthreads();
            { const f32x4 b0 = *(const LAS f32x4*)(LF + tok * 128 + d0), b1 = *(const LAS f32x4*)(LF + tok * 128 + d0 + 4), e0 = *(const LAS f32x4*)(LF + 31 * 128 + d0), e1 = *(const LAS f32x4*)(LF + 31 * 128 + d0 + 4);
                f32x4 t0, t1, qa, qb, ia, ib;
#pragma unroll
                for (int e = 0; e < 4; ++e) { t0[e] = kk[e] * __expf(e0[e] - b0[e]); t1[e] = kk[4 + e] * __expf(e1[e] - b1[e]);
                    if (FULL) { qa[e] = qq[e] * __expf(b0[e]); qb[e] = qq[4 + e] * __expf(b1[e]); ia[e] = kk[e] * __expf(-b0[e]); ib[e] = kk[4 + e] * __expf(-b1[e]); } }
                *(LAS u32x4*)(L + HL_KT + tok * HROW + d0 * 2) = pg8::pack8(t0, t1);
                if (FULL) { *(LAS u32x4*)(L + HL_QD + tok * HROW + d0 * 2) = pg8::pack8(qa, qb); *(LAS u32x4*)(L + HL_KI + tok * HROW + d0 * 2) = pg8::pack8(ia, ib); }
                if (tok == 31) {
#pragma unroll
                    for (int e = 0; e < 4; ++e) { DEC[d0 + e] = __expf(e0[e]); DEC[d0 + 4 + e] = __expf(e1[e]); if (!FULL) { SUM[d0 + e] += e0[e]; SUM[d0 + 4 + e] += e1[e]; } } } }
            __syncthreads();
            { const bf16x8 bV = cat44(lds_tr(VV + (4 * g + trq) * HROW + (Vw0 + 4 * trp) * 2), lds_tr(VV + (16 + 4 * g + trq) * HROW + (Vw0 + 4 * trp) * 2));
                if (outp) {
                    f32x4 pt00 = (f32x4){0.f, 0.f, 0.f, 0.f}, pt01 = pt00, pt11 = pt00, o0 = pt00, o1 = pt00;
#pragma unroll
                    for (int ks = 0; ks < 4; ++ks) { const int co = (32 * ks + 8 * g) * 2;
                        const bf16x8 aK0 = *(const LAS bf16x8*)(KI + r15 * HROW + co), aK1 = *(const LAS bf16x8*)(KI + (16 + r15) * HROW + co);
                        const bf16x8 bQ0 = *(const LAS bf16x8*)(QD + r15 * HROW + co), bQ1 = *(const LAS bf16x8*)(QD + (16 + r15) * HROW + co);
                        pt00 = MFMA16(aK0, bQ0, pt00); pt01 = MFMA16(aK0, bQ1, pt01); pt11 = MFMA16(aK1, bQ1, pt11); }
#pragma unroll
                    for (int r = 0; r < 4; ++r) if (4 * g + r > r15) { pt00[r] = 0.f; pt11[r] = 0.f; }
                    const bf16x8 pa0 = pk8(pt00, (f32x4){0.f, 0.f, 0.f, 0.f}), pa1 = pk8(pt01, pt11);
#pragma unroll
                    for (int ks = 0; ks < 4; ++ks) { const bf16x8 bS = pk8(S[2 * ks], S[2 * ks + 1]); const int c0 = (32 * ks + 4 * g) * 2;
                        const u32x2 x0 = *(const LAS u32x2*)(QD + r15 * HROW + c0), x1 = *(const LAS u32x2*)(QD + r15 * HROW + c0 + 32), y0 = *(const LAS u32x2*)(QD + (16 + r15) * HROW + c0), y1 = *(const LAS u32x2*)(QD + (16 + r15) * HROW + c0 + 32);
                        const bf16x8 aQ0 = __builtin_bit_cast(bf16x8, (u32x4){x0.x, x0.y, x1.x, x1.y}), aQ1 = __builtin_bit_cast(bf16x8, (u32x4){y0.x, y0.y, y1.x, y1.y});
                        o0 = MFMA16(aQ0, bS, o0); o1 = MFMA16(aQ1, bS, o1); }
                    o0 = MFMA16(pa0, bV, o0); o1 = MFMA16(pa1, bV, o1);
#pragma unroll
                    for (int r = 0; r < 4; ++r) { OB[(4 * g + r) * 128 + Vw0 + r15] = o0[r]; OB[(16 + 4 * g + r) * 128 + Vw0 + r15] = o1[r]; }
                }
#pragma unroll
                for (int mt = 0; mt < 8; ++mt) { const bf16x8 aKT = cat44(lds_tr(KT + (4 * g + trq) * HROW + (16 * mt + 4 * trp) * 2), lds_tr(KT + (16 + 4 * g + trq) * HROW + (16 * mt + 4 * trp) * 2));
                    const f32x4 dec4 = *(const LAS f32x4*)(DEC + 16 * mt + 4 * g);
                    S[mt] = MFMA16(aKT, bV, S[mt] * dec4); } }
            __syncthreads();
            if (outp) { const f32x4 o0 = *(const LAS f32x4*)(OB + tok * 128 + d0), o1 = *(const LAS f32x4*)(OB + tok * 128 + d0 + 4);
                float ss = pg8::sq8(o0, o1); ss += __shfl_xor(ss, 1); ss += __shfl_xor(ss, 2); ss += __shfl_xor(ss, 4); ss += __shfl_xor(ss, 8);
                const float rs = __builtin_amdgcn_rsqf(ss * (1.f / 128.f) + EPS);
                f32x4 g0, g1, r0, r1; pg8::unpack8(cg, g0, g1);
#pragma unroll
                for (int e = 0; e < 4; ++e) { r0[e] = o0[e] * rs * gn8[e] * sigmoidf_(g0[e]) + chkbad; r1[e] = o1[e] * rs * gn8[4 + e] * sigmoidf_(g1[e]); }
                *(u32x4*)(XA + (row0 + (size_t)c * 32 + tok) * D + h * ADK + d0) = pg8::pack8(r0, r1); }
        }
        if (!FULL) {
            const __amdgpu_buffer_rsrc_t rsL = __builtin_amdgcn_make_buffer_rsrc((void*)HLg, (short)0, 256 * 16384 * 4, 0x00020000);
            const __amdgpu_buffer_rsrc_t rsS = __builtin_amdgcn_make_buffer_rsrc((void*)HSg, (short)0, 256 * 128 * 4, 0x00020000);
            const int lo = (it * 16384 + (Vw0 + r15) * 128 + 4 * g) * 4;
#pragma unroll
            for (int mt = 0; mt < 8; ++mt) __builtin_amdgcn_raw_buffer_store_b128(__builtin_bit_cast(u32x4, S[mt]), rsL, lo + mt * 64, 0, 16);
            if (tid < 128) __builtin_amdgcn_raw_buffer_store_b32(__builtin_bit_cast(unsigned, SUM[tid]), rsS, (it * 128 + tid) * 4, 0, 16); }
        __syncthreads();
    }
}
__device__ __forceinline__ void phase_conv(const Frame& F, const Args& a) {
    unsigned char* ws = a.ws; const bf16_t* Z = (const bf16_t*)(ws + WS_Z); bf16_t* XA = (bf16_t*)(ws + WS_XA); const int tid = F.tid;
    const int gt = F.vcu * NTHR + tid, NGT = F.G * NTHR;
    for (int i = gt; i < NT * (512 / 8); i += NGT) {
        const int row = i >> 6, c0 = (i & 63) * 8, t = row & (SEQ - 1);
        const bf16_t* zr = Z + (size_t)row * ZW;
        f32x4 y0a, y0b, y1a = (f32x4){0.f, 0.f, 0.f, 0.f}, y1b = y1a, y2a = y1a, y2b = y1a, ga, gb;
        pg8::unpack8(*(const u32x4*)(zr + 2560 + c0), y0a, y0b); pg8::unpack8(*(const u32x4*)(zr + 2048 + c0), ga, gb);
        if (t >= 1) pg8::unpack8(*(const u32x4*)(zr - ZW + 2560 + c0), y1a, y1b);
        if (t >= 2) pg8::unpack8(*(const u32x4*)(zr - 2 * ZW + 2560 + c0), y2a, y2b);
        const f32x4 w0a = *(const f32x4*)(a.conv_w + c0), w0b = *(const f32x4*)(a.conv_w + c0 + 4), w1a = *(const f32x4*)(a.conv_w + 512 + c0), w1b = *(const f32x4*)(a.conv_w + 512 + c0 + 4),
                    w2a = *(const f32x4*)(a.conv_w + 1024 + c0), w2b = *(const f32x4*)(a.conv_w + 1024 + c0 + 4);
        const f32x4 ra = ga * (w0a * y2a + w1a * y1a + w2a * y0a), rb = gb * (w0b * y2b + w1b * y1b + w2b * y0b);
        u32x4 o; o.x = pk2(ra[0], ra[1]); o.y = pk2(ra[2], ra[3]); o.z = pk2(rb[0], rb[1]); o.w = pk2(rb[2], rb[3]);
        *(u32x4*)(XA + (size_t)row * D + 512 + c0) = o;
    }
}

__device__ __forceinline__ void phase_attn(const Frame& F, const Args& a) {
    const bf16_t* QKV = (const bf16_t*)(a.ws + WS_QKV); bf16_t* XA = (bf16_t*)(a.ws + WS_XA);
    const int gw = F.vcu * NWAVES + F.wave, NGW = F.G * NWAVES, lane = F.lane;
    for (int task = gw; task < NT * NQH; task += NGW) {
        const int m = task >> 4, hq = task & 15, kv = hq >> 3, t = m & (SEQ - 1);
        const bf16_t* qp = QKV + (size_t)m * CIN + hq * HD;
        float q[64];
#pragma unroll
        for (int i = 0; i < 8; ++i) { f32x4 x0, x1; pg8::unpack8(*(const u32x4*)(qp + 8 * i), x0, x1);
#pragma unroll
            for (int j = 0; j < 4; ++j) { q[8 * i + j] = x0[j]; q[8 * i + 4 + j] = x1[j]; } }
        float sc[2];
#pragma unroll
        for (int r = 0; r < 2; ++r) { const int j = lane + 64 * r, tk = t - 127 + j; float s = -INFINITY;
            if (tk >= 0) { const bf16_t* kp = QKV + (size_t)(m - 127 + j) * CIN + 1024 + kv * HD; float d = 0.f;
#pragma unroll
                for (int i = 0; i < 8; ++i) { f32x4 x0, x1; pg8::unpack8(*(const u32x4*)(kp + 8 * i), x0, x1);
#pragma unroll
                    for (int jj = 0; jj < 4; ++jj) d += q[8 * i + jj] * x0[jj] + q[8 * i + 4 + jj] * x1[jj]; }
                s = d * 0.125f; }
            sc[r] = s; }
        const float sink = a.sinks[hq];
        const float mx = fmaxf(wave_max(fmaxf(sc[0], sc[1])), sink);
        const float e0 = __expf(sc[0] - mx), e1 = __expf(sc[1] - mx);
        const float den = wave_sum(e0 + e1) + __expf(sink - mx);
        const float inv = 1.f / den; const float p0 = e0 * inv, p1 = e1 * inv;
        float o = 0.f;
        const int j0 = (t >= 127) ? 0 : 127 - t;
        for (int j = j0; j < 128; ++j) { const float pj = __shfl(j < 64 ? p0 : p1, j & 63); o += pj * bf1(QKV[(size_t)(m - 127 + j) * CIN + 1152 + kv * HD + lane]); }
        XA[(size_t)m * D + hq * HD + lane] = (bf16_t)f2bf(o);
    }
}

typedef float f32x16 __attribute__((ext_vector_type(16)));
#define MFMA32(A, B, C) __builtin_amdgcn_mfma_f32_32x32x16_bf16(A, B, C, 0, 0, 0)
constexpr int AT_ROW = 144, AT_K = 0, AT_V = 256 * AT_ROW;
__device__ __forceinline__ void phase_attn_fast(const Frame& F, const Args& a) {
    const bf16_t* QKV = (const bf16_t*)(a.ws + WS_QKV); bf16_t* XA = (bf16_t*)(a.ws + WS_XA);
    LAS unsigned char* L = F.lds;
    const int tid = F.tid, lane = F.lane, w = F.wave, c32 = lane & 31, hh = lane >> 5, i16 = lane & 15, trq = i16 >> 2, trp = i16 & 3, G1 = (lane >> 4) & 1;
    const float CS = 0.125f * 1.4426950408889634f;
    for (int unit = F.vcu; unit < NB * NKVH * (SEQ / 128); unit += F.G) {
        const int nb = unit & 31, kv = (unit >> 5) & 1, b = unit >> 6;
        const long rowk0 = (long)b * SEQ + 128 * nb - 128;
        __syncthreads();
#pragma unroll
        for (int i = 0; i < 4; ++i) { const int p = tid + NTHR * i, row = p >> 3, sg = p & 7; const bool ok = (nb > 0) || (row >= 128);
            u32x4 kx = (u32x4){0u, 0u, 0u, 0u}, vx = kx;
            if (ok) { const bf16_t* src = QKV + (size_t)(rowk0 + row) * CIN + 1024 + kv * HD + sg * 8; kx = *(const u32x4*)src; vx = *(const u32x4*)(src + 128); }
            *(LAS u32x4*)(L + AT_K + row * AT_ROW + sg * 16) = kx; *(LAS u32x4*)(L + AT_V + row * AT_ROW + sg * 16) = vx; }
        __syncthreads();
        const int hq = kv * 8 + w; const float sink2 = a.sinks[hq] * 1.4426950408889634f;
        for (int qt = 0; qt < 4; ++qt) {
            const size_t qrow = (size_t)b * SEQ + 128 * nb + 32 * qt + c32;
            const bf16_t* qp = QKV + qrow * CIN + hq * HD + 8 * hh;
            bf16x8 bQ[4];
#pragma unroll
            for (int ks = 0; ks < 4; ++ks) bQ[ks] = *(const bf16x8*)(qp + 16 * ks);
            f32x16 st[5]; float mx = sink2;
#pragma unroll
            for (int t = 0; t < 5; ++t) {
                const bool blk_ok = (nb > 0) || (qt + t >= 4);
#pragma unroll
                for (int r = 0; r < 16; ++r) st[t][r] = 0.f;
                if (blk_ok) {
#pragma unroll
                    for (int ks = 0; ks < 4; ++ks) { const bf16x8 aK = *(const LAS bf16x8*)(L + AT_K + (32 * (qt + t) + c32) * AT_ROW + (16 * ks + 8 * hh) * 2); st[t] = MFMA32(aK, bQ[ks], st[t]); } }
#pragma unroll
                for (int r = 0; r < 16; ++r) { const int kk = (r & 3) + 8 * (r >> 2) + 4 * hh;
                    bool ok = blk_ok; if (t == 0) ok = ok && (kk > c32); if (t == 4) ok = ok && (kk <= c32);
                    const float z = ok ? st[t][r] * CS : -INFINITY; st[t][r] = z; mx = fmaxf(mx, z); }
            }
            mx = fmaxf(mx, __shfl_xor(mx, 32));
            float sum = 0.f;
#pragma unroll
            for (int t = 0; t < 5; ++t)
#pragma unroll
                for (int r = 0; r < 16; ++r) { const float p = __builtin_amdgcn_exp2f(st[t][r] - mx); st[t][r] = p; sum += p; }
            sum += __shfl_xor(sum, 32);
            const float inv = 1.f / (sum + __builtin_amdgcn_exp2f(sink2 - mx));
            f32x16 o0, o1;
#pragma unroll
            for (int r = 0; r < 16; ++r) { o0[r] = 0.f; o1[r] = 0.f; }
#pragma unroll
            for (int t = 0; t < 5; ++t)
#pragma unroll
                for (int s2 = 0; s2 < 2; ++s2) {
                    const bf16x8 bP = pk8((f32x4){st[t][8 * s2], st[t][8 * s2 + 1], st[t][8 * s2 + 2], st[t][8 * s2 + 3]}, (f32x4){st[t][8 * s2 + 4], st[t][8 * s2 + 5], st[t][8 * s2 + 6], st[t][8 * s2 + 7]});
                    const LAS unsigned char* vb = L + AT_V + (32 * (qt + t) + 16 * s2 + 4 * hh + trq) * AT_ROW + (16 * G1 + 4 * trp) * 2;
                    const bf16x8 aV0 = cat44(lds_tr(vb), lds_tr(vb + 8 * AT_ROW)), aV1 = cat44(lds_tr(vb + 64), lds_tr(vb + 8 * AT_ROW + 64));
                    o0 = MFMA32(aV0, bP, o0); o1 = MFMA32(aV1, bP, o1); }
            bf16_t* op = XA + qrow * D + hq * HD + 4 * hh;
#pragma unroll
            for (int rg = 0; rg < 4; ++rg) { u32x2 x0, x1;
                x0.x = pg8::cvt_pk_bf16(o0[4 * rg] * inv, o0[4 * rg + 1] * inv); x0.y = pg8::cvt_pk_bf16(o0[4 * rg + 2] * inv, o0[4 * rg + 3] * inv);
                x1.x = pg8::cvt_pk_bf16(o1[4 * rg] * inv, o1[4 * rg + 1] * inv); x1.y = pg8::cvt_pk_bf16(o1[4 * rg + 2] * inv, o1[4 * rg + 3] * inv);
                *(u32x2*)(op + 8 * rg) = x0; *(u32x2*)(op + 32 + 8 * rg) = x1; }
        }
    }
}

constexpr int CNT_STRIDE = 64;
constexpr int RT_WROW = 2064;
constexpr int RT_WH = 0, RT_WL = 16 * RT_WROW, RT_LG = 2 * 16 * RT_WROW, RT_TC = RT_LG + 8 * 1088, RT_TW = RT_TC + 512, RT_LC = RT_TW + 2048, RT_GB = RT_LC + 128;
__device__ __forceinline__ void phase_route(const Frame& F, const Args& a, int l) {
    unsigned char* ws = a.ws; const float* H = a.out;
    gu32* cnt = (gu32*)(ws + WS_CTL) + CW_CNT + l * 32 * CNT_STRIDE; int* list = (int*)(ws + WS_LIST); f32x2* wlist = (f32x2*)(ws + WS_WLIST); float* rlist = (float*)(ws + WS_RLIST);
    LAS unsigned char* L = F.lds;
    LAS float* LG = (LAS float*)(L + RT_LG) + F.wave * 272; LAS int* TC = (LAS int*)(L + RT_TC); LAS f32x4* TW = (LAS f32x4*)(L + RT_TW); LAS int* LC = (LAS int*)(L + RT_LC); LAS int* GB = (LAS int*)(L + RT_GB);
    const float* gn = a.norm_ffn + l * D;
    for (int i = F.tid; i < D * NE; i += NTHR) { const int k = i >> 4, e = i & 15; const float wv = a.w_router[i] * gn[k]; const unsigned hi = f2bf(wv); const unsigned lo = f2bf(wv - bflo(hi));
        *(LAS bf16_t*)(L + RT_WH + e * RT_WROW + k * 2) = (bf16_t)hi; *(LAS bf16_t*)(L + RT_WL + e * RT_WROW + k * 2) = (bf16_t)lo; }
    if (F.tid < 32) LC[F.tid] = 0;
    __syncthreads();
    const int lane = F.lane, r15 = lane & 15, g = lane >> 4;
    for (int blk = F.vcu; blk < NT / 128; blk += F.G) {
        const int tl0 = F.wave * 16, m0 = blk * 128 + tl0;
        const f32x4* xr = (const f32x4*)(H + (size_t)(m0 + r15) * D + 8 * g);
        f32x4 acc = (f32x4){0.f, 0.f, 0.f, 0.f}; float ssq = 0.f;
        const LAS unsigned char* wh = L + RT_WH + r15 * RT_WROW + 16 * g; const LAS unsigned char* wl_ = L + RT_WL + r15 * RT_WROW + 16 * g;
#pragma unroll 1
        for (int k8 = 0; k8 < 4; ++k8) {
            f32x4 xv[16];
#pragma unroll
            for (int q = 0; q < 8; ++q) { xv[2 * q] = xr[(k8 * 8 + q) * 8]; xv[2 * q + 1] = xr[(k8 * 8 + q) * 8 + 1]; }
#pragma unroll
            for (int q = 0; q < 8; ++q) { const f32x4 x0 = xv[2 * q], x1 = xv[2 * q + 1]; ssq += pg8::sq8(x0, x1);
                const u32x4 hp = pg8::pack8(x0, x1); f32x4 h0, h1; pg8::unpack8(hp, h0, h1);
                const bf16x8 xh = __builtin_bit_cast(bf16x8, hp), xl = pk8(x0 - h0, x1 - h1);
                const bf16x8 bh = *(const LAS bf16x8*)(wh + (k8 * 8 + q) * 64), bl = *(const LAS bf16x8*)(wl_ + (k8 * 8 + q) * 64);
                acc = MFMA16(xh, bh, acc); acc = MFMA16(xh, bl, acc); acc = MFMA16(xl, bh, acc); }
        }
        ssq += __shfl_xor(ssq, 16); ssq += __shfl_xor(ssq, 32);
        const float rs = __builtin_amdgcn_rsqf(ssq * (1.f / D) + EPS);
#pragma unroll
        for (int r = 0; r < 4; ++r) LG[(4 * g + r) * 17 + r15] = acc[r];
        LDS_WAIT(); asm volatile("" ::: "memory");
        if (lane < 16) { float ex[16]; float mx = -INFINITY;
#pragma unroll
            for (int e = 0; e < 16; ++e) { ex[e] = LG[lane * 17 + e] * rs; mx = fmaxf(mx, ex[e]); }
#pragma unroll
            for (int e = 0; e < 16; ++e) ex[e] = __expf(ex[e] - mx);
            float gs[4], gv1[4], gv2[4]; int gi1[4], gi2[4];
#pragma unroll
            for (int gq = 0; gq < 4; ++gq) { float m1 = ex[4 * gq]; int i1 = 0;
#pragma unroll
                for (int i = 1; i < 4; ++i) if (ex[4 * gq + i] > m1) { m1 = ex[4 * gq + i]; i1 = i; }
                float m2 = -1.f; int i2 = 0;
#pragma unroll
                for (int i = 0; i < 4; ++i) if (i != i1 && ex[4 * gq + i] > m2) { m2 = ex[4 * gq + i]; i2 = i; }
                gs[gq] = m1 + m2; gv1[gq] = m1; gv2[gq] = m2; gi1[gq] = i1; gi2[gq] = i2; }
            int sel = 0; float best = gs[0], v1 = gv1[0], v2 = gv2[0]; int i1 = gi1[0], i2 = gi2[0];
#pragma unroll
            for (int gq = 1; gq < 4; ++gq) if (gs[gq] > best) { best = gs[gq]; sel = gq; v1 = gv1[gq]; v2 = gv2[gq]; i1 = gi1[gq]; i2 = gi2[gq]; }
            const float wsum = 1.f / (v1 + v2); const float w1 = v1 * wsum, w2 = v2 * wsum;
            const int ea = i1 < i2 ? i1 : i2, eb = i1 < i2 ? i2 : i1; const float wa = i1 < i2 ? w1 : w2, wb = i1 < i2 ? w2 : w1;
            const int pr = (ea == 0) ? eb - 1 : ((ea == 1) ? eb + 1 : 5);
            TC[tl0 + lane] = sel * 6 + pr; TW[tl0 + lane] = (f32x4){wa, wb, rs, 0.f}; }
        __syncthreads();
        int myc = 0, lp = 0;
        if (F.tid < 128) { myc = TC[F.tid]; lp = __hip_atomic_fetch_add(LC + myc, 1, __ATOMIC_RELAXED, __HIP_MEMORY_SCOPE_WORKGROUP); }
        __syncthreads();
        if (F.tid < NCLS) { const int n = LC[F.tid]; GB[F.tid] = n ? (int)__hip_atomic_fetch_add(cnt + F.tid * CNT_STRIDE, (unsigned)n, __ATOMIC_RELAXED, __HIP_MEMORY_SCOPE_AGENT) : 0; }
        __syncthreads();
        if (F.tid < 128) { const size_t pos = (size_t)myc * LCAP + GB[myc] + lp; const f32x4 tw = TW[F.tid]; list[pos] = blk * 128 + F.tid; wlist[pos] = (f32x2){tw[0], tw[1]}; rlist[pos] = tw[2]; }
        if (F.tid < 32) LC[F.tid] = 0;
        __syncthreads();
    }
}

constexpr int LX_UT = LX_OFF + 2048;
template <int NP>
__device__ __forceinline__ void moe_tables(const Frame& F, unsigned char* ws, int l) {
    const gu32* cnt = (const gu32*)(ws + WS_CTL) + CW_CNT + l * 32 * CNT_STRIDE;
    volatile LAS int* TB = (volatile LAS int*)(F.lds + LX_TB); volatile LAS int* CN = (volatile LAS int*)(F.lds + LX_CNT); volatile LAS int* CL = (volatile LAS int*)(F.lds + LX_CLS);
    volatile LAS unsigned long long* UT = (volatile LAS unsigned long long*)(F.lds + LX_UT);
    __syncthreads();
    if (F.tid < NCLS) CN[F.tid] = (int)__hip_atomic_load(cnt + F.tid * CNT_STRIDE, __ATOMIC_RELAXED, __HIP_MEMORY_SCOPE_AGENT);
    __syncthreads();
    if (F.tid == 0) { int tb = 0;
#pragma unroll 1
        for (int c = 0; c < NCLS; ++c) { TB[c] = tb; const int n = (CN[c] + 255) >> 8;
#pragma unroll 1
            for (int i = 0; i < n; ++i) CL[tb + i] = c;
            tb += n; }
        TB[NCLS] = tb; }
    __syncthreads();
    if (F.tid < 8) { const int i = F.tid; const int L = i * F.G + F.vcu; const int TT = TB[NCLS];
        unsigned long long w0 = ~0ull, w1 = 0, w2 = 0, w3 = 0, w4 = 0;
        if (L < TT * NP) { const int tau = L / NP, pn = L % NP; const int c = CL[tau]; const int ti = tau - TB[c], rem = CN[c] - ti * 256;
            const int g = c / 6, pr = c % 6; const int ea = pr < 3 ? 0 : (pr < 5 ? 1 : 2), eb = pr < 3 ? pr + 1 : (pr < 5 ? pr - 1 : 3);
            const int nv = rem < 256 ? rem : 256, aux = c * LCAP + ti * 256;
            const char *pA, *pB, *pB2;
            if (NP == 8) { const int e = g * 4 + (pn < 4 ? ea : eb); pA = (const char*)(ws + WS_XA2); pB = (const char*)(ws + WS_W1) + ((size_t)(l * NE + e) * D * D + (size_t)(pn & 3) * 256 * D) * 2; pB2 = pB; }
            else { pA = (const char*)(ws + WS_HID) + (size_t)tau * 256 * 1024 * 2; pB = (const char*)(ws + WS_W2) + ((size_t)(l * NE + g * 4 + ea) * D * DE + (size_t)pn * 256 * DE) * 2;
                pB2 = (const char*)(ws + WS_W2) + ((size_t)(l * NE + g * 4 + eb) * D * DE + (size_t)pn * 256 * DE) * 2; }
            w0 = (unsigned long long)(unsigned)tau | ((unsigned long long)(unsigned)pn << 32); w1 = (unsigned long long)pA; w2 = (unsigned long long)pB; w3 = (unsigned long long)pB2;
            w4 = (unsigned long long)(unsigned)nv | ((unsigned long long)(unsigned)aux << 32); }
        UT[i * 8 + 0] = w0; UT[i * 8 + 1] = w1; UT[i * 8 + 2] = w2; UT[i * 8 + 3] = w3; UT[i * 8 + 4] = w4; }
    __syncthreads();
}
__device__ __forceinline__ unsigned long long rfl64(unsigned long long v) { const unsigned lo = __builtin_amdgcn_readfirstlane((unsigned)v), hi = __builtin_amdgcn_readfirstlane((unsigned)(v >> 32)); return ((unsigned long long)hi << 32) | lo; }
struct MoeSched {
    const LAS unsigned long long* UT; const int* list;
    __device__ __forceinline__ bool next(int i, pg8::Unit& u) const {
        if (i >= 8) return false;
        const unsigned long long w0 = rfl64(UT[i * 8 + 0]); if ((int)(unsigned)w0 < 0) return false;
        const unsigned long long w1 = rfl64(UT[i * 8 + 1]), w2 = rfl64(UT[i * 8 + 2]), w3 = rfl64(UT[i * 8 + 3]), w4 = rfl64(UT[i * 8 + 4]);
        u.pm = (int)(unsigned)w0; u.pn = (int)(unsigned)(w0 >> 32); u.pA = (const char*)w1; u.pB = (const char*)w2; u.pB2 = (const char*)w3; u.nv = (int)(unsigned)w4; u.aux = (int)(unsigned)(w4 >> 32); u.lst = list + u.aux;
        return true;
    }
};

__device__ __forceinline__ void phase_final(const Frame& F, const Args& a) {
    const int gw = F.vcu * NWAVES + F.wave, NGW = F.G * NWAVES, lane = F.lane;
    f32x4 gv[4];
#pragma unroll
    for (int j = 0; j < 4; ++j) gv[j] = *((const f32x4*)a.norm_final + lane + 64 * j);
    for (int m = gw; m < NT; m += NGW) { f32x4* xr = (f32x4*)(a.out + (size_t)m * D) + lane; f32x4 v[4]; float s = 0.f;
#pragma unroll
        for (int j = 0; j < 4; ++j) { v[j] = xr[64 * j]; s += (v[j][0] * v[j][0] + v[j][1] * v[j][1]) + (v[j][2] * v[j][2] + v[j][3] * v[j][3]); }
        const float rs = __builtin_amdgcn_rsqf(wave_sum(s) * (1.f / D) + EPS);
#pragma unroll
        for (int j = 0; j < 4; ++j) xr[64 * j] = v[j] * rs * gv[j]; }
}

constexpr int N_PHASES = 18;
#ifndef HGRN_NAIVE
#define HGRN_NAIVE 0
#endif
#ifndef ATTN_NAIVE
#define ATTN_NAIVE 0
#endif
#if defined(__HIP_DEVICE_COMPILE__)
#define LOAD_ARGS(a) Args a; { const __attribute__((address_space(4))) char* _kp = (const __attribute__((address_space(4))) char*)__builtin_amdgcn_kernarg_segment_ptr(); asm volatile("" : "+s"(_kp)); a = *(const Args*)(const char*)_kp; } unsigned char* ws = a.ws
#else
#define LOAD_ARGS(a) Args a = args; unsigned char* ws = a.ws
#endif

#if !MK_PER_PHASE
#define GRID_BAR() xcd_barrier(bar)
#else
#define GRID_BAR() do { } while (0)
#endif
#ifndef PHMASK
#define PHMASK 0x3FFFF
#endif
#if MK_PER_PHASE
#define IN(k) (((PHMASK >> (k)) & 1) && lo <= (k) && (k) < hi)
#else
#define IN(k) ((PHMASK >> (k)) & 1)
#endif
#define BOTH(k) (IN(k) && IN((k) + 1))
#ifndef MBMASK
#define MBMASK 0
#endif
#define SITE_FRAME(Fp, PHK) Frame Fp; { int _w = wave0; asm volatile("" : "+s"(_w)); int _t = ((MBMASK >> (PHK)) & 1) ? _w * 64 + (int)__builtin_amdgcn_mbcnt_hi(~0u, __builtin_amdgcn_mbcnt_lo(~0u, 0u)) : (int)threadIdx.x; asm volatile("" : "+v"(_t)); unsigned _z = 0; asm volatile("" : "+s"(_z)); int _b = blockIdx.x; asm volatile("" : "+s"(_b)); int _G = gridDim.x; asm volatile("" : "+s"(_G)); Fp.tid = _t; Fp.lane = _t & 63; Fp.wave = __builtin_amdgcn_readfirstlane(_t >> 6); Fp.lds = (LAS unsigned char*)lds_raw + _z; Fp.G = _G; Fp.vcu = (_G % 8 == 0) ? (_b % 8) * (_G / 8) + _b / 8 : _b; } int bx = (int)blockIdx.x; asm volatile("" : "+s"(bx))
template <int l> __device__ __forceinline__ void layer_body(unsigned char* lds_raw, const Args& args, const XcdBarrier& bar, const int wave0, const int lo, const int hi) {
    (void)args; (void)bar; (void)lo; (void)hi;
        const int pb = 1 + 8 * l;
        if (IN(pb + 0)) { LOAD_ARGS(a); SITE_FRAME(Fp, pb + 0);
#ifndef NO_S1A
            if (l == 0) { pg8::DenseSched S; S.init(ws + WS_XA, ws + WS_WINAB, NT, ABIN, D, D, Fp.G, bx); pg8::EpiInAb E{(bf16_t*)(ws + WS_Z)};
                pg8::gemm_phase<pg8::EpiInAb, pg8::DenseSched, false, false>(Fp.lds, Fp.tid, D, D, D, S, E); }
#endif
#ifndef NO_S1B
            if (l == 1) { pg8::DenseSched S; S.init(ws + WS_XA, ws + WS_WINC, NT, CIN, D, D, Fp.G, bx); pg8::rstd_table(Fp.lds, Fp.tid, S, (const float*)(ws + WS_SSB)); pg8::EpiQkv E{(bf16_t*)(ws + WS_QKV), a.b_in_c, (const LAS float*)(Fp.lds + pg8::RSL_OFF)};
                pg8::gemm_phase<pg8::EpiQkv, pg8::DenseSched, false, false>(Fp.lds, Fp.tid, D, D, D, S, E); }
#endif
#ifndef NO_S1C
            { pg8::DenseSched S; S.init(ws + WS_PB + (size_t)l * NT * PLE * 2, ws + WS_WPP + (size_t)l * D * PLE * 2, NT, D, PLE, PLE, Fp.G, bx); pg8::EpiBf16 E{(bf16_t*)(ws + WS_PP), D};
                pg8::gemm_phase<pg8::EpiBf16, pg8::DenseSched, false, false>(Fp.lds, Fp.tid, PLE, PLE, PLE, S, E); }
#endif
            if (BOTH(pb + 0)) GRID_BAR();
        }
#if HGRN_NAIVE
        if (IN(pb + 1)) { LOAD_ARGS(a); (void)ws; SITE_FRAME(Fp, pb + 1); if (l == 0) { phase_hgrn_conv(Fp, a); phase_conv(Fp, a); } else phase_attn(Fp, a); if (BOTH(pb + 1)) GRID_BAR(); }
#else
        if (IN(pb + 1)) { LOAD_ARGS(a); (void)ws; SITE_FRAME(Fp, pb + 1); if (l == 0) { hgrn_pass<false>(Fp, a); phase_conv(Fp, a); } else { if (ATTN_NAIVE) phase_attn(Fp, a); else phase_attn_fast(Fp, a); } if (BOTH(pb + 1)) GRID_BAR(); }
        if (IN(pb + 2) && l == 0) { LOAD_ARGS(a); (void)ws; SITE_FRAME(Fp, pb + 2); hgrn_pass<true>(Fp, a); if (BOTH(pb + 2)) GRID_BAR(); }
#endif
        if (IN(pb + 3)) { LOAD_ARGS(a); SITE_FRAME(Fp, pb + 3);
            pg8::DenseSched S; S.init(ws + WS_XA, ws + (l == 0 ? WS_WOUTAB : WS_WOUTC), NT, D, D, D, Fp.G, bx);
            pg8::EpiRes E{l == 0 ? a.x : a.out, a.out, l == 0 ? nullptr : a.b_out_c, (bf16_t*)(ws + WS_XA2)};
            pg8::gemm_phase<pg8::EpiRes, pg8::DenseSched, false, false>(Fp.lds, Fp.tid, D, D, D, S, E);
            if (BOTH(pb + 3)) GRID_BAR();
        }
        if (IN(pb + 4)) { LOAD_ARGS(a); (void)ws; SITE_FRAME(Fp, pb + 4); phase_route(Fp, a, l); if (BOTH(pb + 4)) GRID_BAR(); }
        if (IN(pb + 5)) { LOAD_ARGS(a); SITE_FRAME(Fp, pb + 5); moe_tables<8>(Fp, ws, l);
            MoeSched S{(const LAS unsigned long long*)(Fp.lds + LX_UT), (const int*)(ws + WS_LIST)};
            pg8::EpiG1 E{(bf16_t*)(ws + WS_HID), (const f32x2*)(ws + WS_WLIST), (const float*)(ws + WS_RLIST)};
            pg8::gemm_phase<pg8::EpiG1, MoeSched, true, false>(Fp.lds, Fp.tid, D, D, D, S, E);
            if (BOTH(pb + 5)) GRID_BAR(); }
        if (IN(pb + 6)) { LOAD_ARGS(a); SITE_FRAME(Fp, pb + 6); moe_tables<4>(Fp, ws, l);
            MoeSched S{(const LAS unsigned long long*)(Fp.lds + LX_UT), (const int*)(ws + WS_LIST)};
            pg8::EpiG2 E{a.out, (bf16_t*)(ws + WS_XA2), (float*)(ws + WS_SSA)};
            pg8::gemm_phase<pg8::EpiG2, MoeSched, false, true>(Fp.lds, Fp.tid, 1024, 1024, DE, S, E);
            if (BOTH(pb + 6)) GRID_BAR(); }
        if (IN(pb + 7)) { LOAD_ARGS(a); SITE_FRAME(Fp, pb + 7);
            pg8::DenseSched S; S.init(ws + WS_XA2, ws + WS_WPG + (size_t)l * D * D * 2, NT, D, D, D, Fp.G, bx);
            pg8::rstd_table(Fp.lds, Fp.tid, S, (const float*)(ws + WS_SSA));
            pg8::EpiPle E{a.out, (bf16_t*)(ws + WS_XA), (const bf16_t*)(ws + WS_PP), (const LAS float*)(Fp.lds + pg8::RSL_OFF), (float*)(ws + WS_SSB)};
            pg8::gemm_phase<pg8::EpiPle, pg8::DenseSched, false, false>(Fp.lds, Fp.tid, D, D, D, S, E);
            if (BOTH(pb + 7)) GRID_BAR();
        }
}
__global__ void __launch_bounds__(NTHR, 2) mega_fwd(Args args) {
    extern __shared__ __attribute__((aligned(16))) unsigned char lds_raw[];
    Frame F; F.lds = (LAS unsigned char*)lds_raw; F.tid = threadIdx.x; F.lane = F.tid & 63; F.wave = __builtin_amdgcn_readfirstlane(F.tid >> 6);
    F.G = gridDim.x; { const int bx = blockIdx.x; F.vcu = (F.G % 8 == 0) ? (bx % 8) * (F.G / 8) + bx / 8 : bx; }
    for (int u = F.tid; u < (LDS_BYTES - LX_OFF) / 4; u += NTHR) ((LAS unsigned*)(F.lds + LX_OFF))[u] = 0u;
    __syncthreads();
#if !MK_PER_PHASE
    XcdBarrier bar = xcd_barrier_post((unsigned*)((gu32*)(args.ws + WS_CTL) + CW_BAR), (volatile LAS unsigned*)(F.lds + LX_BAR), __builtin_amdgcn_readfirstlane((int)threadIdx.x >> 6));
#else
    XcdBarrier bar; bar.bar = nullptr; bar.x = 0u; bar.st = nullptr; bar.w0 = 0;
#endif
    const int lo = args.ph_lo, hi = args.ph_hi; (void)lo; (void)hi;
    const int wave0 = __builtin_amdgcn_readfirstlane((int)threadIdx.x >> 6);

    if (IN(0)) { LOAD_ARGS(a); (void)ws; SITE_FRAME(Fp, 0); phase_prep(Fp, a); if (BOTH(0)) GRID_BAR(); }

    layer_body<0>(lds_raw, args, bar, wave0, lo, hi);
    layer_body<1>(lds_raw, args, bar, wave0, lo, hi);
    if (IN(17)) { LOAD_ARGS(a); (void)ws; SITE_FRAME(Fp, 17); phase_final(Fp, a); }
#undef IN
#undef BOTH
}

extern "C" void kernel_launch(void* const* d_in, const int* in_sizes, int n_in, void* d_out, int out_size, void* d_ws, size_t ws_size, hipStream_t stream) {
    static int grid = 0;
    if (grid == 0) {
        if (n_in != 22 || out_size != NT * D || ws_size < WS_END) { fprintf(stderr, "kernel_launch: unexpected shapes (n_in %d, out %d, ws %zu)\n", n_in, out_size, ws_size); grid = -1; return; }
        int dev = 0, cus = 0, per_cu = 0;
        if (hipGetDevice(&dev) != hipSuccess || hipDeviceGetAttribute(&cus, hipDeviceAttributeMultiprocessorCount, dev) != hipSuccess) { grid = -1; return; }
        if (hipFuncSetAttribute((const void*)mega_fwd, hipFuncAttributeMaxDynamicSharedMemorySize, LDS_BYTES) != hipSuccess) { fprintf(stderr, "kernel_launch: hipFuncSetAttribute failed\n"); grid = -1; return; }
        if (hipOccupancyMaxActiveBlocksPerMultiprocessor(&per_cu, (const void*)mega_fwd, NTHR, LDS_BYTES) != hipSuccess || per_cu < 1) fprintf(stderr, "kernel_launch: occupancy query says %d\n", per_cu);
        (void)hipGetLastError();
        grid = cus;
    }
    if (grid < 0) return;
    (void)hipMemsetAsync((char*)d_ws + WS_CTL, 0, CTL_ZERO_BYTES, stream);
    Args a{};
    a.x = (const float*)d_in[0]; a.p = (const float*)d_in[1]; a.norm_mix = (const float*)d_in[2]; a.norm_ffn = (const float*)d_in[3]; a.norm_ple = (const float*)d_in[4]; a.norm_final = (const float*)d_in[5];
    a.w_in_ab = (const float*)d_in[6]; a.lb_logits = (const float*)d_in[7]; a.hgrn_out_norm = (const float*)d_in[8]; a.conv_w = (const float*)d_in[9]; a.w_out_ab = (const float*)d_in[10];
    a.w_in_c = (const float*)d_in[11]; a.b_in_c = (const float*)d_in[12]; a.sinks = (const float*)d_in[13]; a.w_out_c = (const float*)d_in[14]; a.b_out_c = (const float*)d_in[15];
    a.w_router = (const float*)d_in[16]; a.w_gate_e = (const float*)d_in[17]; a.w_up_e = (const float*)d_in[18]; a.w_down_e = (const float*)d_in[19]; a.w_ple_gate = (const float*)d_in[20]; a.w_ple_proj = (const float*)d_in[21];
    a.out = (float*)d_out; a.ws = (unsigned char*)d_ws;
#if MK_PER_PHASE
#ifndef RP
#define RP (-1)
#define RN 0
#endif
    for (int ph = 0; ph < N_PHASES; ++ph) { a.ph_lo = ph; a.ph_hi = ph + 1; const int reps = (ph == RP) ? RN + 1 : 1;
        for (int r = 0; r < reps; ++r) { if (r > 0 && (ph == 5 || ph == 13)) (void)hipMemsetAsync((char*)d_ws + WS_CTL, 0, CTL_ZERO_BYTES, stream); hipLaunchKernelGGL(mega_fwd, dim3(grid), dim3(NTHR), LDS_BYTES, stream, a); } }
#else
    a.ph_lo = 0; a.ph_hi = N_PHASES; hipLaunchKernelGGL(mega_fwd, dim3(grid), dim3(NTHR), LDS_BYTES, stream, a);
#endif
}
```

```cpp
#include <hip/hip_runtime.h>
#include <cstdio>
#include <cstdint>

#ifndef MK_PER_PHASE
#define MK_PER_PHASE 0
#endif

#define LAS __attribute__((address_space(3)))
#define GAS __attribute__((address_space(1)))
typedef unsigned short bf16_t;
typedef short bf16x8 __attribute__((ext_vector_type(8)));
typedef float f32x4 __attribute__((ext_vector_type(4)));
typedef float f32x2 __attribute__((ext_vector_type(2)));
typedef unsigned u32x4 __attribute__((ext_vector_type(4)));
typedef unsigned u32x2 __attribute__((ext_vector_type(2)));
typedef GAS unsigned gu32;

constexpr int NB = 8, SEQ = 4096, D = 1024, NT = NB * SEQ;
constexpr int PLE = 256;
constexpr int AW = 512, AH = 4, ADK = 128;
constexpr int ABIN = 3584, ZW = 3072;
constexpr int CIN = 1280, HD = 64, NQH = 16, NKVH = 2, WIN = 128;
constexpr int NE = 16, DE = 512;
constexpr int NCLS = 24, LCAP = NT;
constexpr int HIDROWS = NT + NCLS * 256;
constexpr float EPS = 1e-6f;

constexpr size_t MiB = 1u << 20;
constexpr size_t WS_CTL = 0, CTL_ZERO_BYTES = 1 * MiB;
constexpr size_t WS_WINAB = 1 * MiB;
constexpr size_t WS_WOUTAB = 8 * MiB;
constexpr size_t WS_WINC = 10 * MiB;
constexpr size_t WS_WOUTC = 13 * MiB;
constexpr size_t WS_WPG = 15 * MiB;
constexpr size_t WS_WPP = 19 * MiB;
constexpr size_t WS_W1 = 20 * MiB;
constexpr size_t WS_W2 = 84 * MiB;
constexpr size_t WS_PB = 116 * MiB;
constexpr size_t WS_XA = 148 * MiB;
constexpr size_t WS_Z = 212 * MiB;
constexpr size_t WS_XA2 = WS_Z;
constexpr size_t WS_HID = WS_Z + 64 * MiB;
constexpr size_t WS_QKV = WS_Z + 64 * MiB;
constexpr size_t WS_PP = 404 * MiB;
constexpr size_t WS_LIST = 468 * MiB;
constexpr size_t WS_WLIST = 471 * MiB;
constexpr size_t WS_SSA = 477 * MiB;
constexpr size_t WS_SSB = 479 * MiB;
constexpr size_t WS_LB = 481 * MiB;
constexpr size_t WS_HL = 484 * MiB;
constexpr size_t WS_HSUM = 500 * MiB;
constexpr size_t WS_RLIST = 502 * MiB;
constexpr size_t WS_END = 505 * MiB;
constexpr int CW_BAR = 4096;
constexpr int CW_CNT = 16384;

constexpr int RING_BYTES = 131072;
constexpr int LX_OFF = RING_BYTES;
constexpr int LX_BAR = LX_OFF + 0;
constexpr int LX_TB = LX_OFF + 64;
constexpr int LX_CNT = LX_OFF + 64 + 128;
constexpr int LX_CLS = LX_OFF + 512;
constexpr int LDS_BYTES = 147456;
constexpr int NWAVES = 8, NTHR = 512;

__device__ __forceinline__ unsigned f2bf(float f) { unsigned u = __builtin_bit_cast(unsigned, f); return (u + 0x7fffu + ((u >> 16) & 1u)) >> 16; }
__device__ __forceinline__ unsigned pk2(float lo, float hi) { return f2bf(lo) | (f2bf(hi) << 16); }
__device__ __forceinline__ float bflo(unsigned w) { return __builtin_bit_cast(float, w << 16); }
__device__ __forceinline__ float bfhi(unsigned w) { return __builtin_bit_cast(float, w & 0xffff0000u); }
__device__ __forceinline__ float bf1(bf16_t h) { return __builtin_bit_cast(float, (unsigned)h << 16); }
__device__ __forceinline__ float sigmoidf_(float x) { return __builtin_amdgcn_rcpf(1.f + __expf(-x)); }
__device__ __forceinline__ float siluf_(float x) { return x * sigmoidf_(x); }
__device__ __forceinline__ float wave_sum(float v) {
#pragma unroll
    for (int o = 1; o < 64; o <<= 1) v += __shfl_xor(v, o);
    return v;
}
__device__ __forceinline__ float wave_max(float v) {
#pragma unroll
    for (int o = 1; o < 64; o <<= 1) v = fmaxf(v, __shfl_xor(v, o));
    return v;
}
#define LDS_WAIT() asm volatile("s_waitcnt lgkmcnt(0)" ::: "memory")

namespace pg8 {
constexpr int BM = 256, BK = 64, HALF = 128, HTB = HALF * BK * 2, NXCD = 8, WGM = 8;
__host__ __device__ __forceinline__ int lds_byte(int r, int c) { const int st = (r >> 4) * 2 + (c >> 5), rr = r & 15, cc = c & 31, ob = rr * 64 + cc * 2; return st * 1024 + (ob ^ (((ob >> 9) & 1) << 5)); }
__host__ __device__ __forceinline__ void stage_rc(int b, int& R, int& C) { const int st = b / 1024, sb = b % 1024, swz = sb ^ (((sb >> 9) & 1) << 5); R = (st >> 1) * 16 + swz / 64; C = (st & 1) * 32 + (swz % 64) / 2; }
__host__ __device__ __forceinline__ int perm32(int rho) { const int n = rho >> 4, i = rho & 15; return 8 * (i >> 2) + 4 * n + (i & 3); }

struct Unit { int pm, pn; const char* pA; const char* pB; const char* pB2; const int* lst; int nv; int aux; };

struct StaticOrder {
    int nM, nN, nwg, G, c;
    __device__ void init(int M, int N, int G_, int c_) { nM = M / BM; nN = N / BM; nwg = nM * nN; G = G_; c = c_; }
    __device__ bool next(int i, int& pm, int& pn) const {
        const long L = (long)i * G + c; if (L >= nwg) return false;
        int wgid = (int)L; { const int q = nwg / NXCD, r = nwg % NXCD, xcd = wgid % NXCD, off = wgid / NXCD; wgid = (xcd < r ? xcd * (q + 1) : r * (q + 1) + (xcd - r) * q) + off; }
        const int nig = WGM * nN, gid = wgid / nig, fm = gid * WGM, gsz = (nM - fm) < WGM ? (nM - fm) : WGM;
        pm = fm + ((wgid % nig) % gsz); pn = (wgid % nig) / gsz; return true;
    }
};
struct DenseSched {
    StaticOrder so; const char* A; const char* B; size_t tA, tB;
    __device__ void init(const void* A_, const void* B_, int M, int N, int lda, int ldb, int G, int c) { so.init(M, N, G, c); A = (const char*)A_; B = (const char*)B_; tA = (size_t)BM * lda * 2; tB = (size_t)BM * ldb * 2; }
    __device__ __forceinline__ bool next(int i, Unit& u) const {
        int pm, pn; if (!so.next(i, pm, pn)) return false;
        u.pm = pm; u.pn = pn; u.pA = A + (size_t)pm * tA; u.pB = B + (size_t)pn * tB; u.pB2 = u.pB; u.lst = nullptr; u.nv = BM; u.aux = i; return true;
    }
};

typedef __bf16 bf16x2_t __attribute__((ext_vector_type(2)));
__device__ __forceinline__ unsigned cvt_pk_bf16(float lo, float hi) { const f32x2 v = {lo, hi}; const bf16x2_t b = __builtin_convertvector(v, bf16x2_t); return __builtin_bit_cast(unsigned, b); }

template <class Epi, class Sched, bool GATHER, bool SPLITB>
__device__ __forceinline__ void gemm_phase(LAS unsigned char* lds, const int tid_in, const int K, const int lda, const int ldb, const Sched& S, const Epi& E) {
    int tid = tid_in; asm volatile("" : "+v"(tid));
    const int wid = __builtin_amdgcn_readfirstlane(tid >> 6), lane = tid & 63, wr = wid >> 2, wc = wid & 3, fr = lane & 15, fq = lane >> 4;
    int nt = K / BK; asm volatile("" : "+s"(nt));
    const int ntB = nt >> 1;
    unsigned voffA[2], voffB[2];
#pragma unroll
    for (int i = 0; i < 2; ++i) { int R, C; stage_rc(tid * 16 + i * 8192, R, C); const int Rb = (R & ~31) + perm32(R & 31); voffA[i] = (unsigned)(R * lda + C) * 2u; voffB[i] = (unsigned)(Rb * ldb + C) * 2u; }
    const size_t kstep = (size_t)(BK * 2);
    const size_t hstepB = (size_t)HALF * ldb * 2;
    const size_t hstepA = (size_t)HALF * lda * 2;
    const unsigned ldsw = (unsigned)wid * 1024u;
    const int aoff = lds_byte(wr * 64 + fr, fq * 8), boff = lds_byte(wc * 32 + fr, fq * 8);
#define PG8_SA(b, h) (((b) * 2 + (h)) * HTB)
#define PG8_SB(b, h) ((4 + (b) * 2 + (h)) * HTB)
#define PG8_STAGE(bufoff, gbase, voff) do { _Pragma("unroll") for (int _i = 0; _i < 2; ++_i) \
        __builtin_amdgcn_global_load_lds((const unsigned*)((const char*)(gbase) + (voff)[_i]), (LAS unsigned*)(lds + (bufoff) + ldsw + _i * 8192), 16, 0, 0); } while (0)
#define PG8_LDA(dst, b, h) do { _Pragma("unroll") for (int m = 0; m < 4; ++m) _Pragma("unroll") for (int k = 0; k < 2; ++k) dst[m][k] = *(const LAS bf16x8*)(lds + PG8_SA(b, h) + aoff + m * 2048 + k * 1024); } while (0)
#define PG8_LDB(dst, b, h) do { _Pragma("unroll") for (int n = 0; n < 2; ++n) _Pragma("unroll") for (int k = 0; k < 2; ++k) dst[n][k] = *(const LAS bf16x8*)(lds + PG8_SB(b, h) + boff + n * 2048 + k * 1024); } while (0)
#define PG8_MMA(ai, bj, At, Bt) do { __builtin_amdgcn_s_setprio(1); _Pragma("unroll") for (int m = 0; m < 4; ++m) _Pragma("unroll") for (int n = 0; n < 2; ++n) _Pragma("unroll") for (int k = 0; k < 2; ++k) \
        acc[ai][bj][m][n] = __builtin_amdgcn_mfma_f32_16x16x32_bf16(Bt[n][k], At[m][k], acc[ai][bj][m][n], 0, 0, 0); __builtin_amdgcn_s_setprio(0); } while (0)
#define PG8_WAIT_V(n) asm volatile("s_waitcnt vmcnt(" #n ")" ::: "memory")
#define PG8_WAIT_L(n) asm volatile("s_waitcnt lgkmcnt(" #n ")" ::: "memory")
#define PG8_BAR __builtin_amdgcn_s_barrier()
#define PG8_SCHED __builtin_amdgcn_sched_barrier(0)
#define PG8_GOFF(G, u) do { if constexpr (GATHER) { _Pragma("unroll") for (int _h = 0; _h < 2; ++_h) _Pragma("unroll") for (int _i = 0; _i < 2; ++_i) { \
        int _R, _C; stage_rc(tid * 16 + _i * 8192, _R, _C); int _ix = _h * HALF + _R; _ix = _ix < (u).nv ? _ix : (u).nv - 1; const int _tok = (u).lst[_ix]; G[_h][_i] = (unsigned)_tok * (unsigned)(lda * 2) + (unsigned)(_C * 2); } } } while (0)
#define PG8_STAGE_A(bufoff, gbase, half, G) do { if constexpr (GATHER) { PG8_STAGE(bufoff, gbase, G[half]); } else { PG8_STAGE(bufoff, (gbase) + (half) * hstepA, voffA); } } while (0)
#define PG8_BPTR(u, tt) ((SPLITB && (tt) >= ntB) ? (u).pB2 + (size_t)((tt) - ntB) * kstep : (u).pB + (size_t)(tt) * kstep)
    Unit cur; int ui = 0;
    if (!S.next(0, cur)) return;
    f32x4 acc[2][2][4][2];
#pragma unroll
    for (int a = 0; a < 2; ++a)
#pragma unroll
        for (int b = 0; b < 2; ++b)
#pragma unroll
            for (int m = 0; m < 4; ++m)
#pragma unroll
                for (int n = 0; n < 2; ++n) acc[a][b][m][n] = (f32x4){0.f, 0.f, 0.f, 0.f};
    bf16x8 At[4][2], B0[2][2], B1[2][2];
    unsigned cG[2][2];
    LAS u32x4* gstash = (LAS u32x4*)(lds + 135168) + tid;
    PG8_GOFF(cG, cur);
    const char* cA = cur.pA; const char* cB = cur.pB;
    PG8_STAGE(PG8_SB(0, 0), cB, voffB); PG8_STAGE(PG8_SB(0, 1), cB + hstepB, voffB); PG8_STAGE_A(PG8_SA(0, 0), cA, 0, cG); PG8_STAGE_A(PG8_SA(0, 1), cA, 1, cG);
    if (wr == 1) PG8_BAR;
    PG8_WAIT_V(2); PG8_BAR;
    PG8_STAGE(PG8_SB(1, 0), cB + kstep, voffB); PG8_STAGE_A(PG8_SA(1, 0), cA + kstep, 0, cG); PG8_STAGE(PG8_SB(1, 1), cB + hstepB + kstep, voffB);
    PG8_WAIT_V(6); PG8_BAR;
    for (;;) {
        Unit nxt; const bool has_next = S.next(ui + 1, nxt);
        if constexpr (GATHER) { unsigned nG[2][2];
            if (has_next) { PG8_GOFF(nG, nxt); } else {
#pragma unroll
            for (int h = 0; h < 2; ++h)
#pragma unroll
                for (int i = 0; i < 2; ++i) nG[h][i] = cG[h][i]; }
            *gstash = (u32x4){nG[0][0], nG[0][1], nG[1][0], nG[1][1]}; }
        const char* nA = has_next ? nxt.pA : cA; const char* nB = has_next ? nxt.pB : cB;
        for (int t = 0; t < nt; t += 2) {
            const bool last = (t == nt - 2);
            const char* a1 = cA + (size_t)(t + 1) * kstep;
            const char* a2 = last ? nA : cA + (size_t)(t + 2) * kstep; const char* a3 = a2 + kstep;
            const char* b2 = last ? nB : PG8_BPTR(cur, t + 2); const char* b3 = b2 + kstep;
            unsigned g2[2][2];
            if constexpr (GATHER) {
                if (last) { const u32x4 st = *gstash; g2[0][0] = st.x; g2[0][1] = st.y; g2[1][0] = st.z; g2[1][1] = st.w; }
                else {
#pragma unroll
                for (int h = 0; h < 2; ++h)
#pragma unroll
                    for (int i = 0; i < 2; ++i) g2[h][i] = cG[h][i]; } }
            PG8_LDB(B0, 0, 0); PG8_LDB(B1, 0, 1); PG8_SCHED; PG8_LDA(At, 0, 0); PG8_STAGE_A(PG8_SA(1, 1), a1, 1, cG);
            PG8_WAIT_V(8); PG8_WAIT_L(0); PG8_BAR; PG8_MMA(0, 0, At, B0); PG8_MMA(0, 1, At, B1); PG8_BAR; PG8_SCHED;
            PG8_LDA(At, 0, 1); PG8_STAGE(PG8_SB(0, 0), b2, voffB); PG8_STAGE(PG8_SB(0, 1), b2 + hstepB, voffB); PG8_STAGE_A(PG8_SA(0, 0), a2, 0, g2);
            PG8_WAIT_V(8); PG8_WAIT_L(0); PG8_BAR; PG8_MMA(1, 0, At, B0); PG8_MMA(1, 1, At, B1); PG8_BAR; PG8_SCHED;
            PG8_LDB(B0, 1, 0); PG8_LDB(B1, 1, 1); PG8_SCHED; PG8_LDA(At, 1, 0); PG8_STAGE_A(PG8_SA(0, 1), a2, 1, g2);
            PG8_WAIT_V(8); PG8_WAIT_L(0); PG8_BAR; PG8_MMA(0, 0, At, B0); PG8_MMA(0, 1, At, B1); PG8_BAR; PG8_SCHED;
            PG8_LDA(At, 1, 1); PG8_STAGE(PG8_SB(1, 0), b3, voffB); PG8_STAGE(PG8_SB(1, 1), b3 + hstepB, voffB); PG8_STAGE_A(PG8_SA(1, 0), a3, 0, g2);
            PG8_WAIT_V(8); PG8_WAIT_L(0); PG8_BAR; PG8_MMA(1, 0, At, B0); PG8_MMA(1, 1, At, B1); PG8_BAR; PG8_SCHED;
        }
        if (wr == 0) PG8_BAR;
        E(acc, cur, wr, wc, fr, fq);
        if (!has_next) break;
#pragma unroll
        for (int a = 0; a < 2; ++a)
#pragma unroll
            for (int b = 0; b < 2; ++b)
#pragma unroll
                for (int m = 0; m < 4; ++m)
#pragma unroll
                    for (int n = 0; n < 2; ++n) acc[a][b][m][n] = (f32x4){0.f, 0.f, 0.f, 0.f};
        ++ui; (void)S.next(ui, cur); cA = nA; cB = nB;
        if constexpr (GATHER) { const u32x4 st = *gstash; cG[0][0] = st.x; cG[0][1] = st.y; cG[1][0] = st.z; cG[1][1] = st.w; }
        if (wr == 1) PG8_BAR;
    }
    PG8_WAIT_V(0);
    PG8_BAR;
#undef PG8_SA
#undef PG8_SB
#undef PG8_STAGE
#undef PG8_LDA
#undef PG8_LDB
#undef PG8_MMA
#undef PG8_WAIT_V
#undef PG8_WAIT_L
#undef PG8_BAR
#undef PG8_SCHED
#undef PG8_GOFF
#undef PG8_STAGE_A
#undef PG8_BPTR
}

typedef const f32x4 (&AccRef)[2][2][4][2];
#define EPI_ROW(u, ai, m) ((u).pm * BM + (ai) * HALF + wr * 64 + (m) * 16 + fr)
#define EPI_COL(u, bj) ((u).pn * BM + (bj) * HALF + wc * 32 + fq * 8)
__device__ __forceinline__ u32x4 pack8(const f32x4& a, const f32x4& b) { u32x4 w; w.x = cvt_pk_bf16(a[0], a[1]); w.y = cvt_pk_bf16(a[2], a[3]); w.z = cvt_pk_bf16(b[0], b[1]); w.w = cvt_pk_bf16(b[2], b[3]); return w; }
__device__ __forceinline__ float sq8(const f32x4& a, const f32x4& b) { return (a[0] * a[0] + a[1] * a[1]) + (a[2] * a[2] + a[3] * a[3]) + (b[0] * b[0] + b[1] * b[1]) + (b[2] * b[2] + b[3] * b[3]); }
__device__ __forceinline__ void unpack8(const u32x4& w, f32x4& a, f32x4& b) { a = (f32x4){bflo(w.x), bfhi(w.x), bflo(w.y), bfhi(w.y)}; b = (f32x4){bflo(w.z), bfhi(w.z), bflo(w.w), bfhi(w.w)}; }

struct EpiBf16 {
    bf16_t* O; int ldc;
    __device__ __forceinline__ void operator()(AccRef acc, const Unit& u, int wr, int wc, int fr, int fq) const {
#pragma unroll
        for (int ai = 0; ai < 2; ++ai)
#pragma unroll
            for (int m = 0; m < 4; ++m) { bf16_t* rowp = O + (size_t)EPI_ROW(u, ai, m) * ldc;
#pragma unroll
                for (int bj = 0; bj < 2; ++bj) *(u32x4*)(rowp + EPI_COL(u, bj)) = pack8(acc[ai][bj][m][0], acc[ai][bj][m][1]); }
    }
};
struct EpiInAb {
    bf16_t* Z;
    __device__ __forceinline__ void operator()(AccRef acc, const Unit& u, int wr, int wc, int fr, int fq) const {
        if (u.pn >= 10) {
#pragma unroll
            for (int ai = 0; ai < 2; ++ai)
#pragma unroll
                for (int m = 0; m < 4; ++m) { bf16_t* rowp = Z + (size_t)EPI_ROW(u, ai, m) * ZW;
                    const f32x4 a = acc[ai][0][m][0] * acc[ai][1][m][0], b = acc[ai][0][m][1] * acc[ai][1][m][1];
                    *(u32x4*)(rowp + 2560 + (u.pn - 10) * HALF + wc * 32 + fq * 8) = pack8(a, b); }
        } else if (u.pn < 2) {
#pragma unroll
            for (int ai = 0; ai < 2; ++ai)
#pragma unroll
                for (int m = 0; m < 4; ++m) { bf16_t* rowp = Z + (size_t)EPI_ROW(u, ai, m) * ZW;
#pragma unroll
                    for (int bj = 0; bj < 2; ++bj) { f32x4 a = acc[ai][bj][m][0], b = acc[ai][bj][m][1];
#pragma unroll
                        for (int j = 0; j < 4; ++j) { a[j] = siluf_(a[j]); b[j] = siluf_(b[j]); }
                        *(u32x4*)(rowp + EPI_COL(u, bj)) = pack8(a, b); }
                    asm volatile("" ::: "memory"); }
        } else {
#pragma unroll
            for (int ai = 0; ai < 2; ++ai)
#pragma unroll
                for (int m = 0; m < 4; ++m) { bf16_t* rowp = Z + (size_t)EPI_ROW(u, ai, m) * ZW;
#pragma unroll
                    for (int bj = 0; bj < 2; ++bj) *(u32x4*)(rowp + EPI_COL(u, bj)) = pack8(acc[ai][bj][m][0], acc[ai][bj][m][1]); }
        }
    }
};
template <bool XF32> struct EpiRes {
    const float* XF; const bf16_t* XB; const float* bias; bf16_t* HB;
    __device__ __forceinline__ void operator()(AccRef acc, const Unit& u, int wr, int wc, int fr, int fq) const {
        f32x4 bv[2][2];
#pragma unroll
        for (int bj = 0; bj < 2; ++bj) { const int c = EPI_COL(u, bj); bv[bj][0] = bias ? *(const f32x4*)(bias + c) : (f32x4){0.f, 0.f, 0.f, 0.f}; bv[bj][1] = bias ? *(const f32x4*)(bias + c + 4) : (f32x4){0.f, 0.f, 0.f, 0.f}; }
#pragma unroll
        for (int ai = 0; ai < 2; ++ai) { f32x4 xv[4][2][2];
#pragma unroll
            for (int m = 0; m < 4; ++m) { const size_t ro = (size_t)EPI_ROW(u, ai, m) * D;
#pragma unroll
                for (int bj = 0; bj < 2; ++bj) { const int c = EPI_COL(u, bj);
                    if (XF32) { xv[m][bj][0] = *(const f32x4*)(XF + ro + c); xv[m][bj][1] = *(const f32x4*)(XF + ro + c + 4); }
                    else unpack8(*(const u32x4*)(XB + ro + c), xv[m][bj][0], xv[m][bj][1]); } }
#pragma unroll
            for (int m = 0; m < 4; ++m) { const size_t ro = (size_t)EPI_ROW(u, ai, m) * D;
#pragma unroll
                for (int bj = 0; bj < 2; ++bj) { const int c = EPI_COL(u, bj);
                    *(u32x4*)(HB + ro + c) = pack8(xv[m][bj][0] + bv[bj][0] + acc[ai][bj][m][0], xv[m][bj][1] + bv[bj][1] + acc[ai][bj][m][1]); } }
            asm volatile("" ::: "memory"); }
    }
};
__device__ __forceinline__ float rstd16(const float* ss, int row) {
    const f32x4* p = (const f32x4*)(ss + (size_t)row * 16); const f32x4 a = p[0], b = p[1], c = p[2], d = p[3];
    const float s = ((a[0] + a[1]) + (a[2] + a[3])) + ((b[0] + b[1]) + (b[2] + b[3])) + ((c[0] + c[1]) + (c[2] + c[3])) + ((d[0] + d[1]) + (d[2] + d[3]));
    return __builtin_amdgcn_rsqf(s * (1.f / D) + EPS);
}
constexpr int RSL_OFF = 135168;
template <class Sched> __device__ __forceinline__ void rstd_table(LAS unsigned char* lds, const int tid_in, const Sched& S, const float* ss) {
    LAS float* RSL = (LAS float*)(lds + RSL_OFF); int tid = tid_in; asm volatile("" : "+v"(tid));
    for (int i = tid >> 8; i < 8; i += 2) { Unit u; if (!S.next(i, u)) break; RSL[i * 256 + (tid & 255)] = rstd16(ss, u.pm * BM + (tid & 255)); }
    __syncthreads();
}
struct EpiQkv {
    bf16_t* O; const float* bias; const LAS float* RSL;
    __device__ __forceinline__ void operator()(AccRef acc, const Unit& u, int wr, int wc, int fr, int fq) const {
        float rs[2][4];
#pragma unroll
        for (int ai = 0; ai < 2; ++ai)
#pragma unroll
            for (int m = 0; m < 4; ++m) rs[ai][m] = RSL[u.aux * 256 + ai * HALF + wr * 64 + m * 16 + fr];
        f32x4 bv[2][2];
#pragma unroll
        for (int bj = 0; bj < 2; ++bj) { const int c = EPI_COL(u, bj); bv[bj][0] = *(const f32x4*)(bias + c); bv[bj][1] = *(const f32x4*)(bias + c + 4); }
#pragma unroll
        for (int ai = 0; ai < 2; ++ai)
#pragma unroll
            for (int m = 0; m < 4; ++m) { bf16_t* rowp = O + (size_t)EPI_ROW(u, ai, m) * CIN;
#pragma unroll
                for (int bj = 0; bj < 2; ++bj) *(u32x4*)(rowp + EPI_COL(u, bj)) = pack8(acc[ai][bj][m][0] * rs[ai][m] + bv[bj][0], acc[ai][bj][m][1] * rs[ai][m] + bv[bj][1]); }
    }
};
struct EpiG1 {
    bf16_t* HID; const f32x2* wl; const float* rl;
    __device__ __forceinline__ void operator()(AccRef acc, const Unit& u, int wr, int wc, int fr, int fq) const {
        float wv[2][4], rv[2][4];
#pragma unroll
        for (int ai = 0; ai < 2; ++ai)
#pragma unroll
            for (int m = 0; m < 4; ++m) { const int rit = ai * HALF + wr * 64 + m * 16 + fr; const f32x2 w2 = wl[(size_t)u.aux + rit]; wv[ai][m] = (u.pn < 4) ? w2.x : w2.y; rv[ai][m] = rl[(size_t)u.aux + rit]; }
#pragma unroll
        for (int ai = 0; ai < 2; ++ai)
#pragma unroll
            for (int m = 0; m < 4; ++m) { const int rit = ai * HALF + wr * 64 + m * 16 + fr;
                const float rs = rv[ai][m], wrs = wv[ai][m] * rs;
                bf16_t* rowp = HID + (size_t)(u.pm * BM + rit) * 1024 + (u.pn >> 2) * 512 + (u.pn & 3) * HALF + wc * 32 + fq * 8;
                f32x4 a, b;
#pragma unroll
                for (int j = 0; j < 4; ++j) { a[j] = siluf_(acc[ai][0][m][0][j] * rs) * acc[ai][1][m][0][j] * wrs; b[j] = siluf_(acc[ai][0][m][1][j] * rs) * acc[ai][1][m][1][j] * wrs; }
                *(u32x4*)rowp = pack8(a, b); }
    }
};
struct EpiG2 {
    bf16_t* HB; float* SS;
    __device__ __forceinline__ void operator()(AccRef acc, const Unit& u, int wr, int wc, int fr, int fq) const {
        int tk[2][4];
#pragma unroll
        for (int ai = 0; ai < 2; ++ai)
#pragma unroll
            for (int m = 0; m < 4; ++m) { const int rit = ai * HALF + wr * 64 + m * 16 + fr; tk[ai][m] = (rit < u.nv) ? u.lst[rit] : -1; }
#pragma unroll
        for (int ai = 0; ai < 2; ++ai) { u32x4 hv[4][2];
#pragma unroll
            for (int m = 0; m < 4; ++m) { const int tok = tk[ai][m]; const size_t ro = (size_t)(tok < 0 ? 0 : tok) * D;
#pragma unroll
                for (int bj = 0; bj < 2; ++bj) hv[m][bj] = *(const u32x4*)(HB + ro + EPI_COL(u, bj)); }
#pragma unroll
            for (int m = 0; m < 4; ++m) { const int tok = tk[ai][m]; const bool ok = tok >= 0; const size_t ro = (size_t)(ok ? tok : 0) * D; float part = 0.f;
#pragma unroll
                for (int bj = 0; bj < 2; ++bj) { const int c = EPI_COL(u, bj); f32x4 x0, x1; unpack8(hv[m][bj], x0, x1);
                    const f32x4 h0 = x0 + acc[ai][bj][m][0], h1 = x1 + acc[ai][bj][m][1];
                    if (ok) *(u32x4*)(HB + ro + c) = pack8(h0, h1);
                    part += sq8(h0, h1); }
                part += __shfl_xor(part, 16); part += __shfl_xor(part, 32);
                if (ok && fq == 0) SS[(size_t)tok * 16 + u.pn * 4 + wc] = part; }
            asm volatile("" ::: "memory"); }
    }
};
struct EpiPle {
    const bf16_t* HI; bf16_t* HO; const bf16_t* PP; const LAS float* RSL; float* sso;
    __device__ __forceinline__ void operator()(AccRef acc, const Unit& u, int wr, int wc, int fr, int fq) const {
#pragma unroll
        for (int ai = 0; ai < 2; ++ai) { u32x4 hv[4][2], pv[4][2];
#pragma unroll
            for (int m = 0; m < 4; ++m) { const size_t ro = (size_t)EPI_ROW(u, ai, m) * D;
#pragma unroll
                for (int bj = 0; bj < 2; ++bj) { const int c = EPI_COL(u, bj); hv[m][bj] = *(const u32x4*)(HI + ro + c); pv[m][bj] = *(const u32x4*)(PP + ro + c); } }
#pragma unroll
            for (int m = 0; m < 4; ++m) { const int row = EPI_ROW(u, ai, m); const size_t ro = (size_t)row * D; const float r_ = RSL[u.aux * 256 + ai * HALF + wr * 64 + m * 16 + fr]; float part = 0.f;
#pragma unroll
                for (int bj = 0; bj < 2; ++bj) { const int c = EPI_COL(u, bj);
                    f32x4 p0, p1, h0, h1; unpack8(pv[m][bj], p0, p1); unpack8(hv[m][bj], h0, h1);
#pragma unroll
                    for (int j = 0; j < 4; ++j) { h0[j] += sigmoidf_(acc[ai][bj][m][0][j] * r_) * p0[j]; h1[j] += sigmoidf_(acc[ai][bj][m][1][j] * r_) * p1[j]; }
                    *(u32x4*)(HO + ro + c) = pack8(h0, h1); part += sq8(h0, h1); }
                part += __shfl_xor(part, 16); part += __shfl_xor(part, 32);
                if (fq == 0) sso[(size_t)row * 16 + u.pn * 4 + wc] = part; }
            asm volatile("" ::: "memory"); }
    }
};
}

#define XB_TMO      128
#define XB_XCNT(j)  (256  + 64 * (j))
#define XB_XSUB(j)  (1280 + 64 * (j))
#define XB_XGEN(j)  (2304 + 64 * (j))
#define XB_TOP      3328
#define XB_TOPGEN   3392
#define XCD_BAR_WORDS 3456
#define XB_SPIN_CAP (1u << 18)
__device__ __forceinline__ unsigned xb_ld(unsigned* p)              { return __hip_atomic_load(p, __ATOMIC_RELAXED, __HIP_MEMORY_SCOPE_AGENT); }
__device__ __forceinline__ unsigned xb_add(unsigned* p, unsigned v) { return __hip_atomic_fetch_add(p, v, __ATOMIC_RELAXED, __HIP_MEMORY_SCOPE_AGENT); }
__device__ __forceinline__ unsigned xb_xcc_id() { return (unsigned)__builtin_amdgcn_s_getreg((3 << 11) | 20) & 0xFu; }
#define XB_SPIN(cond, bar) do { unsigned _sp = 0; while (cond) { __builtin_amdgcn_s_sleep(1); \
    if ((++_sp & 255u) == 0u) { if (xb_ld(&(bar)[XB_TMO])) break; if (_sp > XB_SPIN_CAP) { atomicAdd(&(bar)[XB_TMO], 1u); break; } } } } while (0)
struct XcdBarrier { unsigned* bar; unsigned x; volatile LAS unsigned* st; int w0; };
__device__ __forceinline__ bool xb_tid0(int w0) { (void)w0; return threadIdx.x == 0; }
__device__ __forceinline__ XcdBarrier xcd_barrier_post(unsigned* bar, volatile LAS unsigned* st, int w0) {
    XcdBarrier b; b.bar = bar; b.x = (unsigned)__builtin_amdgcn_readfirstlane((int)xb_xcc_id()); b.st = st; b.w0 = w0;
    if (xb_tid0(w0)) (void)xb_add(&bar[XB_XCNT(b.x)], 1u);
    return b;
}
__device__ __forceinline__ void xcd_barrier_complete(unsigned* bar, unsigned x, unsigned& nloc, unsigned& nx) {
    const unsigned G = gridDim.x * gridDim.y * gridDim.z;
    unsigned sum, cnt, mine, sp = 0u;
    for (;;) {
        sum = 0u; cnt = 0u; mine = 0u;
#pragma unroll
        for (unsigned j = 0; j < 16; ++j) { const unsigned c = xb_ld(&bar[XB_XCNT(j)]); sum += c; cnt += (c > 0u) ? 1u : 0u; mine = (j == x) ? c : mine; }
        if (sum == G) break;
        __builtin_amdgcn_s_sleep(1);
        if ((++sp & 255u) == 0u) { if (xb_ld(&bar[XB_TMO])) break; if (sp > XB_SPIN_CAP) { atomicAdd(&bar[XB_TMO], 1u); break; } }
    }
    nloc = mine > 0u ? mine : 1u; nx = cnt > 0u ? cnt : 1u;
}
__device__ __forceinline__ void xcd_barrier(const XcdBarrier& b) {
    asm volatile("s_waitcnt vmcnt(0)" ::: "memory");
    __syncthreads();
    if (xb_tid0(b.w0)) {
        unsigned* bar = b.bar; asm volatile("" : "+s"(bar));
        __builtin_amdgcn_s_waitcnt(0);
        unsigned nloc = b.st[0], nx = b.st[1];
        if (nloc == 0u) { xcd_barrier_complete(bar, b.x, nloc, nx); b.st[0] = nloc; b.st[1] = nx; }
        const unsigned old = xb_add(&bar[XB_XSUB(b.x)], 1u);
        const unsigned gen = old / nloc;
        if (old + 1u == (gen + 1u) * nloc) {
            __builtin_amdgcn_fence(__ATOMIC_RELEASE, "agent");
            asm volatile("s_waitcnt vmcnt(0)" ::: "memory");
            const unsigned og = xb_add(&bar[XB_TOP], 1u);
            const unsigned tg = og / nx;
            if (og + 1u == (tg + 1u) * nx) xb_add(&bar[XB_TOPGEN], 1u);
            else XB_SPIN(xb_ld(&bar[XB_TOPGEN]) == tg, bar);
            __builtin_amdgcn_fence(__ATOMIC_ACQUIRE, "agent");
            xb_add(&bar[XB_XGEN(b.x)], 1u);
            asm volatile("s_waitcnt vmcnt(0)" ::: "memory");
        } else {
            XB_SPIN(xb_ld(&bar[XB_XGEN(b.x)]) == gen, bar);
            __builtin_amdgcn_fence(__ATOMIC_ACQUIRE, "agent");
            asm volatile("s_waitcnt vmcnt(0)" ::: "memory");
        }
    }
    __syncthreads();
}

struct Args {
    const float* x; const float* p; const float* norm_mix; const float* norm_ffn; const float* norm_ple; const float* norm_final;
    const float* w_in_ab; const float* lb_logits; const float* hgrn_out_norm; const float* conv_w; const float* w_out_ab;
    const float* w_in_c; const float* b_in_c; const float* sinks; const float* w_out_c; const float* b_out_c;
    const float* w_router; const float* w_gate_e; const float* w_up_e; const float* w_down_e; const float* w_ple_gate; const float* w_ple_proj;
    float* out; unsigned char* ws; int ph_lo, ph_hi;
};
struct Frame { LAS unsigned char* lds; int tid, lane, wave, vcu, G; };

__device__ __forceinline__ void transpose_item(const float* W, int N, int src_n0, int k0, bf16_t* dst  , int ldk, const float* gs, LAS float* scr, int lane) {
#pragma unroll 8
    for (int i = 0; i < 32; ++i) { const int kk = 2 * i + (lane >> 5); scr[kk * 33 + (lane & 31)] = W[(size_t)(k0 + kk) * N + src_n0 + (lane & 31)]; }
    LDS_WAIT(); asm volatile("" ::: "memory");
    const int c = lane & 7;
    float g8[8];
#pragma unroll
    for (int q = 0; q < 8; ++q) g8[q] = gs ? gs[k0 + 8 * c + q] : 1.f;
#pragma unroll
    for (int j = 0; j < 4; ++j) { const int n = (lane >> 3) + 8 * j; const LAS float* s = scr + (8 * c) * 33 + n;
        u32x4 o; o.x = pk2(s[0 * 33] * g8[0], s[1 * 33] * g8[1]); o.y = pk2(s[2 * 33] * g8[2], s[3 * 33] * g8[3]); o.z = pk2(s[4 * 33] * g8[4], s[5 * 33] * g8[5]); o.w = pk2(s[6 * 33] * g8[6], s[7 * 33] * g8[7]);
        *(u32x4*)(dst + (size_t)n * ldk + k0 + 8 * c) = o; }
    LDS_WAIT(); asm volatile("" ::: "memory");
}
__device__ __forceinline__ void phase_prep(const Frame& F, const Args& a) {
    unsigned char* ws = a.ws;
    LAS float* scr = (LAS float*)(F.lds + F.wave * 16384);
    const int gw = F.vcu * NWAVES + F.wave, NGW = F.G * NWAVES;
    constexpr int I_INAB = 16 * (ABIN / 32), I_SQ = 16 * 32, I_INC = 16 * (CIN / 32), I_PP = 4 * 32, I_W1 = 16 * 32, I_W2 = 8 * 32;
    constexpr int T0 = I_INAB, T1 = T0 + I_SQ, T2 = T1 + I_INC, T3 = T2 + I_SQ, T4 = T3 + 2 * I_SQ, T5 = T4 + 2 * I_PP, T6 = T5 + 32 * I_W1, T7 = T6 + 32 * I_W2;
    for (int it = gw; it < T7; it += NGW) {
        if (it < T0) { const int kb = it / (ABIN / 32), nb = it % (ABIN / 32), n0 = nb * 32; int src;
            if (n0 < 2560) src = n0; else { const int q = (n0 - 2560) >> 8, r = (n0 - 2560) & 255; src = (r < 128) ? 2560 + q * 128 + r : 3072 + q * 128 + (r - 128); }
            transpose_item(a.w_in_ab, ABIN, src, kb * 64, (bf16_t*)(ws + WS_WINAB) + (size_t)n0 * D, D, a.norm_mix, scr, F.lane); }
        else if (it < T1) { const int r = it - T0, kb = r / 32, nb = r % 32; transpose_item(a.w_out_ab, D, nb * 32, kb * 64, (bf16_t*)(ws + WS_WOUTAB) + (size_t)nb * 32 * D, D, nullptr, scr, F.lane); }
        else if (it < T2) { const int r = it - T1, kb = r / (CIN / 32), nb = r % (CIN / 32); transpose_item(a.w_in_c, CIN, nb * 32, kb * 64, (bf16_t*)(ws + WS_WINC) + (size_t)nb * 32 * D, D, a.norm_mix + D, scr, F.lane); }
        else if (it < T3) { const int r = it - T2, kb = r / 32, nb = r % 32; transpose_item(a.w_out_c, D, nb * 32, kb * 64, (bf16_t*)(ws + WS_WOUTC) + (size_t)nb * 32 * D, D, nullptr, scr, F.lane); }
        else if (it < T4) { const int r = it - T3, l = r / I_SQ, q = r % I_SQ, kb = q / 32, nb = q % 32;
            transpose_item(a.w_ple_gate + (size_t)l * D * D, D, nb * 32, kb * 64, (bf16_t*)(ws + WS_WPG) + (size_t)l * D * D + (size_t)nb * 32 * D, D, a.norm_ple + l * D, scr, F.lane); }
        else if (it < T5) { const int r = it - T4, l = r / I_PP, q = r % I_PP, kb = q / 32, nb = q % 32;
            transpose_item(a.w_ple_proj + (size_t)l * PLE * D, D, nb * 32, kb * 64, (bf16_t*)(ws + WS_WPP) + (size_t)l * D * PLE + (size_t)nb * 32 * PLE, PLE, nullptr, scr, F.lane); }
        else if (it < T6) { const int r = it - T5, le = r / I_W1, q = r % I_W1, kb = q / 32, nb = q % 32, n0 = nb * 32, uq = n0 >> 8, rr = n0 & 255;
            const float* src = (rr < 128) ? a.w_gate_e + (size_t)le * D * DE : a.w_up_e + (size_t)le * D * DE; const int sn = uq * 128 + (rr & 127);
            transpose_item(src, DE, sn, kb * 64, (bf16_t*)(ws + WS_W1) + (size_t)le * D * D + (size_t)n0 * D, D, a.norm_ffn + (le >> 4) * D, scr, F.lane); }
        else { const int r = it - T6, le = r / I_W2, q = r % I_W2, kb = q / 32, nb = q % 32;
            transpose_item(a.w_down_e + (size_t)le * DE * D, D, nb * 32, kb * 64, (bf16_t*)(ws + WS_W2) + (size_t)le * D * DE + (size_t)nb * 32 * DE, DE, nullptr, scr, F.lane); }
    }
    const int gt = F.vcu * NTHR + F.tid, NGT = F.G * NTHR;
    if (gt < AW) { const float l0 = a.lb_logits[gt], l1 = a.lb_logits[AW + gt], l2 = a.lb_logits[2 * AW + gt]; const float mx = fmaxf(l0, fmaxf(l1, l2));
        const float e0 = __expf(l0 - mx), e1 = __expf(l1 - mx), e2 = __expf(l2 - mx); ((float*)(ws + WS_LB))[gt] = e0 / (e0 + e1 + e2); }
    { const f32x4* src = (const f32x4*)a.p; u32x4* dst = (u32x4*)(ws + WS_PB); const int n8 = 2 * NT * PLE / 8;
        for (int i = gt; i < n8; i += NGT) { const f32x4 v0 = src[2 * i], v1 = src[2 * i + 1]; u32x4 o; o.x = pk2(v0[0], v0[1]); o.y = pk2(v0[2], v0[3]); o.z = pk2(v1[0], v1[1]); o.w = pk2(v1[2], v1[3]); dst[i] = o; } }
    for (int m = gw; m < NT; m += NGW) { const f32x4* xr = (const f32x4*)(a.x + (size_t)m * D) + F.lane; f32x4 v[4]; float s = 0.f;
#pragma unroll
        for (int j = 0; j < 4; ++j) { v[j] = xr[64 * j]; s += (v[j][0] * v[j][0] + v[j][1] * v[j][1]) + (v[j][2] * v[j][2] + v[j][3] * v[j][3]); }
        const float rs = __builtin_amdgcn_rsqf(wave_sum(s) * (1.f / D) + EPS);
        u32x2* o8 = (u32x2*)((bf16_t*)(ws + WS_XA) + (size_t)m * D) + F.lane;
#pragma unroll
        for (int j = 0; j < 4; ++j) { u32x2 o; o.x = pk2(v[j][0] * rs, v[j][1] * rs); o.y = pk2(v[j][2] * rs, v[j][3] * rs); o8[64 * j] = o; } }
}

__device__ __forceinline__ void phase_hgrn_conv(const Frame& F, const Args& a) {
    unsigned char* ws = a.ws; const bf16_t* Z = (const bf16_t*)(ws + WS_Z); bf16_t* XA = (bf16_t*)(ws + WS_XA); const float* lbv = (const float*)(ws + WS_LB);
    LAS float* FG = (LAS float*)F.lds; LAS float* KK = FG + 4096; LAS float* QQ = KK + 4096; LAS float* VV = QQ + 4096; LAS float* OB = VV + 4096;
    const int tid = F.tid, lane = F.lane, w = F.wave;
    for (int it = F.vcu; it < NB * AH; it += F.G) {
        const int b = it >> 2, h = it & 3; const size_t row0 = (size_t)b * SEQ;
        const int vi = lane & 15, dq = lane >> 4, v = 16 * w + vi;
        float s[32];
#pragma unroll
        for (int i = 0; i < 32; ++i) s[i] = 0.f;
        const int ltt = tid >> 4, ldd = (tid & 15) * 8;
        float lb8[8], gn8[8];
#pragma unroll
        for (int j = 0; j < 8; ++j) { lb8[j] = lbv[h * ADK + ldd + j]; gn8[j] = a.hgrn_out_norm[ldd + j]; }
        for (int c = 0; c < SEQ / 32; ++c) {
            { const bf16_t* zr = Z + (row0 + c * 32 + ltt) * ZW + h * ADK + ldd;
                const u32x4 wq = *(const u32x4*)zr, wf = *(const u32x4*)(zr + 512), wv = *(const u32x4*)(zr + 1024);
                f32x4 q0, q1, f0, f1, v0, v1; pg8::unpack8(wq, q0, q1); pg8::unpack8(wf, f0, f1); pg8::unpack8(wv, v0, v1);
                f32x4 g0, g1, k0, k1;
#pragma unroll
                for (int j = 0; j < 4; ++j) { g0[j] = lb8[j] + (1.f - lb8[j]) * sigmoidf_(f0[j]); g1[j] = lb8[4 + j] + (1.f - lb8[4 + j]) * sigmoidf_(f1[j]); k0[j] = 1.f - g0[j]; k1[j] = 1.f - g1[j]; }
                const int o = ltt * 128 + ldd;
                *(LAS f32x4*)(FG + o) = g0; *(LAS f32x4*)(FG + o + 4) = g1; *(LAS f32x4*)(KK + o) = k0; *(LAS f32x4*)(KK + o + 4) = k1;
                *(LAS f32x4*)(QQ + o) = q0; *(LAS f32x4*)(QQ + o + 4) = q1; *(LAS f32x4*)(VV + o) = v0; *(LAS f32x4*)(VV + o + 4) = v1; }
            __syncthreads();
            for (int tt = 0; tt < 32; ++tt) {
                const float vt = VV[tt * 128 + v]; float acc = 0.f;
                const LAS f32x4* fg = (const LAS f32x4*)(FG + tt * 128 + dq * 32); const LAS f32x4* kk = (const LAS f32x4*)(KK + tt * 128 + dq * 32); const LAS f32x4* qq = (const LAS f32x4*)(QQ + tt * 128 + dq * 32);
#pragma unroll
                for (int d4 = 0; d4 < 8; ++d4) { const f32x4 f4 = fg[d4], k4 = kk[d4], q4 = qq[d4];
#pragma unroll
                    for (int j = 0; j < 4; ++j) { s[d4 * 4 + j] = f4[j] * s[d4 * 4 + j] + k4[j] * vt; acc += s[d4 * 4 + j] * q4[j]; } }
                acc += __shfl_xor(acc, 16); acc += __shfl_xor(acc, 32);
                if (dq == 0) OB[tt * 128 + v] = acc;
            }
            __syncthreads();
            { const f32x4 o0 = *(const LAS f32x4*)(OB + ltt * 128 + ldd), o1 = *(const LAS f32x4*)(OB + ltt * 128 + ldd + 4);
                float ss = pg8::sq8(o0, o1); ss += __shfl_xor(ss, 1); ss += __shfl_xor(ss, 2); ss += __shfl_xor(ss, 4); ss += __shfl_xor(ss, 8);
                const float rs = __builtin_amdgcn_rsqf(ss * (1.f / 128.f) + EPS);
                const size_t row = row0 + c * 32 + ltt; f32x4 g0, g1; pg8::unpack8(*(const u32x4*)(Z + row * ZW + 1536 + h * ADK + ldd), g0, g1);
                f32x4 r0, r1;
#pragma unroll
                for (int j = 0; j < 4; ++j) { r0[j] = o0[j] * rs * gn8[j] * sigmoidf_(g0[j]); r1[j] = o1[j] * rs * gn8[4 + j] * sigmoidf_(g1[j]); }
                u32x4 o; o.x = pk2(r0[0], r0[1]); o.y = pk2(r0[2], r0[3]); o.z = pk2(r1[0], r1[1]); o.w = pk2(r1[2], r1[3]);
                *(u32x4*)(XA + row * D + h * ADK + ldd) = o; }
        }
        __syncthreads();
    }
}

typedef short s16x4 __attribute__((ext_vector_type(4)));
constexpr int SEGT = 512, NSEG = SEQ / SEGT, NCH = SEGT / 32;
constexpr int HROW = 272, HL_TS = 32 * HROW;
constexpr int HL_LF = 0, HL_T = 16384, HL_DEC = 18432, HL_SUM = 18944, HL_QD = 20480, HL_KI = HL_QD + HL_TS, HL_KT = HL_KI + HL_TS, HL_VV = HL_KT + HL_TS, HL_OB = HL_VV + HL_TS;
__device__ __forceinline__ s16x4 lds_tr(const LAS unsigned char* p) { return __builtin_bit_cast(s16x4, __builtin_amdgcn_ds_read_tr16_b64_v4i16((LAS s16x4*)p)); }
__device__ __forceinline__ bf16x8 cat44(s16x4 a, s16x4 b) { return (bf16x8){a[0], a[1], a[2], a[3], b[0], b[1], b[2], b[3]}; }
__device__ __forceinline__ bf16x8 pk8(const f32x4& a, const f32x4& b) { return __builtin_bit_cast(bf16x8, pg8::pack8(a, b)); }
#define MFMA16(A, B, C) __builtin_amdgcn_mfma_f32_16x16x32_bf16(A, B, C, 0, 0, 0)
#ifndef HGRN_SELF
#define HGRN_SELF 0
#endif
#ifndef HGRN_CHECK
#define HGRN_CHECK 0
#endif
template <bool FULL>
__device__ __forceinline__ void hgrn_pass(const Frame& F, const Args& a) {
    unsigned char* ws = a.ws; const bf16_t* Z = (const bf16_t*)(ws + WS_Z); bf16_t* XA = (bf16_t*)(ws + WS_XA); const float* lbv = (const float*)(ws + WS_LB);
    float* HLg = (float*)(ws + WS_HL); float* HSg = (float*)(ws + WS_HSUM);
    LAS unsigned char* L = F.lds;
    LAS float* LF = (LAS float*)(L + HL_LF); LAS float* TT = (LAS float*)(L + HL_T); LAS float* DEC = (LAS float*)(L + HL_DEC); LAS float* SUM = (LAS float*)(L + HL_SUM); LAS float* OB = (LAS float*)(L + HL_OB);
    const LAS unsigned char* QD = L + HL_QD; const LAS unsigned char* KI = L + HL_KI; const LAS unsigned char* KT = L + HL_KT; const LAS unsigned char* VV = L + HL_VV;
    const int tid = F.tid, lane = F.lane, w = F.wave, r15 = lane & 15, g = lane >> 4, trq = r15 >> 2, trp = r15 & 3;
    const int tok = tid >> 4, d0 = (tid & 15) * 8, sd = tid & 127, tq = tid >> 7, Vw0 = 16 * w;
    for (int it = F.vcu; it < NB * AH * NSEG; it += F.G) {
        const int seg = it & (NSEG - 1), h = (it >> 3) & 3, b = it >> 5;
        if (!FULL && seg == NSEG - 1) continue;
        const size_t row0 = (size_t)b * SEQ + (size_t)seg * SEGT;
        float lb8[8], gn8[8];
#pragma unroll
        for (int e = 0; e < 8; ++e) { lb8[e] = lbv[h * ADK + d0 + e]; gn8[e] = a.hgrn_out_norm[d0 + e]; }
        f32x4 S[8];
#pragma unroll
        for (int mt = 0; mt < 8; ++mt) S[mt] = (f32x4){0.f, 0.f, 0.f, 0.f};
        const int pre = (FULL && (HGRN_SELF || HGRN_CHECK)) ? seg * NCH : 0;
        float chkbad = 0.f;
        if (FULL && seg > 0 && !HGRN_SELF) {
            const __amdgpu_buffer_rsrc_t rsL = __builtin_amdgcn_make_buffer_rsrc((void*)HLg, (short)0, 256 * 16384 * 4, 0x00020000);
            const __amdgpu_buffer_rsrc_t rsS = __builtin_amdgcn_make_buffer_rsrc((void*)HSg, (short)0, 256 * 128 * 4, 0x00020000);
            f32x4 cum[8];
#pragma unroll
            for (int mt = 0; mt < 8; ++mt) cum[mt] = (f32x4){0.f, 0.f, 0.f, 0.f};
            for (int sp = seg - 1; sp >= 0; --sp) { const int ip = it - seg + sp; const int lo = (ip * 16384 + (Vw0 + r15) * 128 + 4 * g) * 4, so = (ip * 128 + 4 * g) * 4;
#pragma unroll
                for (int mt = 0; mt < 8; ++mt) { const f32x4 l4 = __builtin_bit_cast(f32x4, __builtin_amdgcn_raw_buffer_load_b128(rsL, lo + mt * 64, 0, 16)), h4 = __builtin_bit_cast(f32x4, __builtin_amdgcn_raw_buffer_load_b128(rsS, so + mt * 64, 0, 16));
#pragma unroll
                    for (int r = 0; r < 4; ++r) { S[mt][r] += __expf(cum[mt][r]) * l4[r]; cum[mt][r] += h4[r]; } } }
        }
        if (FULL && HGRN_CHECK) { LAS f32x4* SA = (LAS f32x4*)(L + 73728) + tid * 4;
#pragma unroll
            for (int mt = 0; mt < 4; ++mt) { SA[mt] = S[mt]; }
#pragma unroll
            for (int mt = 0; mt < 8; ++mt) S[mt] = (f32x4){0.f, 0.f, 0.f, 0.f}; }
        if (tid < 128) SUM[tid] = 0.f;
        const bf16_t* zr = Z + (row0 - (size_t)pre * 32 + tok) * ZW + h * ADK + d0;
        u32x4 wq = (u32x4){0u, 0u, 0u, 0u}, wg = wq, wf = *(const u32x4*)(zr + 512), wv = *(const u32x4*)(zr + 1024);
        if (FULL) { wq = *(const u32x4*)zr; wg = *(const u32x4*)(zr + 1536); }
        for (int cc = 0; cc < pre + NCH; ++cc) { const int c = cc - pre; const bool outp = FULL && (c >= 0);
            if (FULL && HGRN_CHECK && c == 0 && seg > 0) { const LAS f32x4* SA = (const LAS f32x4*)(L + 73728) + tid * 4;
#pragma unroll
                for (int mt = 0; mt < 4; ++mt) { const f32x4 sa = SA[mt];
#pragma unroll
                    for (int r = 0; r < 4; ++r) if (!(fabsf(sa[r] - S[mt][r]) <= 1e-3f + 0.02f * fabsf(S[mt][r]))) chkbad = 1.f; } }
            if (FULL && HGRN_CHECK && chkbad != 0.f) { const unsigned long long t0 = __builtin_amdgcn_s_memrealtime(); while (__builtin_amdgcn_s_memrealtime() - t0 < 10000000000ull) __builtin_amdgcn_s_sleep(64); chkbad = 0.f; }
            float kk[8], qq[8];
            { f32x4 f0, f1, q0 = (f32x4){0.f, 0.f, 0.f, 0.f}, q1 = q0; pg8::unpack8(wf, f0, f1); if (FULL) pg8::unpack8(wq, q0, q1);
                f32x4 l0, l1;
#pragma unroll
                for (int e = 0; e < 4; ++e) { const float fa = lb8[e] + (1.f - lb8[e]) * sigmoidf_(f0[e]), fb = lb8[4 + e] + (1.f - lb8[4 + e]) * sigmoidf_(f1[e]);
                    kk[e] = 1.f - fa; kk[4 + e] = 1.f - fb; l0[e] = __logf(fa); l1[e] = __logf(fb); qq[e] = q0[e]; qq[4 + e] = q1[e]; }
                *(LAS f32x4*)(LF + tok * 128 + d0) = l0; *(LAS f32x4*)(LF + tok * 128 + d0 + 4) = l1;
                *(LAS u32x4*)(L + HL_VV + tok * HROW + d0 * 2) = wv; }
            const u32x4 cg = wg;
            if (c + 1 < NCH) { const bf16_t* zn = zr + (size_t)(cc + 1) * 32 * ZW; wf = *(const u32x4*)(zn + 512); wv = *(const u32x4*)(zn + 1024); if (FULL) { wq = *(const u32x4*)zn; wg = *(const u32x4*)(zn + 1536); } }
            __syncthreads();
            { float x[8];
#pragma unroll
                for (int e = 0; e < 8; ++e) x[e] = LF[(8 * tq + e) * 128 + sd];
#pragma unroll
                for (int e = 1; e < 8; ++e) x[e] += x[e - 1];
                TT[tq * 128 + sd] = x[7];
                __syncthreads();
                const float t0 = TT[sd], t1 = TT[128 + sd], t2 = TT[256 + sd];
                const float off = (tq > 0 ? t0 : 0.f) + (tq > 1 ? t1 : 0.f) + (tq > 2 ? t2 : 0.f);
#pragma unroll
                for (int e = 0; e < 8; ++e) LF[(8 * tq + e) * 128 + sd] = x[e] + off; }
            __syncthreads();
            { const f32x4 b0 = *(const LAS f32x4*)(LF + tok * 128 + d0), b1 = *(const LAS f32x4*)(LF + tok * 128 + d0 + 4), e0 = *(const LAS f32x4*)(LF + 31 * 128 + d0), e1 = *(const LAS f32x4*)(LF + 31 * 128 + d0 + 4);
                f32x4 t0, t1, qa, qb, ia, ib;
#pragma unroll
                for (int e = 0; e < 4; ++e) { t0[e] = kk[e] * __expf(e0[e] - b0[e]); t1[e] = kk[4 + e] * __expf(e1[e] - b1[e]);
                    if (FULL) { qa[e] = qq[e] * __expf(b0[e]); qb[e] = qq[4 + e] * __expf(b1[e]); ia[e] = kk[e] * __expf(-b0[e]); ib[e] = kk[4 + e] * __expf(-b1[e]); } }
                *(LAS u32x4*)(L + HL_KT + tok * HROW + d0 * 2) = pg8::pack8(t0, t1);
                if (FULL) { *(LAS u32x4*)(L + HL_QD + tok * HROW + d0 * 2) = pg8::pack8(qa, qb); *(LAS u32x4*)(L + HL_KI + tok * HROW + d0 * 2) = pg8::pack8(ia, ib); }
                if (tok == 31) {
#pragma unroll
                    for (int e = 0; e < 4; ++e) { DEC[d0 + e] = __expf(e0[e]); DEC[d0 + 4 + e] = __expf(e1[e]); if (!FULL) { SUM[d0 + e] += e0[e]; SUM[d0 + 4 + e] += e1[e]; } } } }
            __syncthreads();
            { const bf16x8 bV = cat44(lds_tr(VV + (4 * g + trq) * HROW + (Vw0 + 4 * trp) * 2), lds_tr(VV + (16 + 4 * g + trq) * HROW + (Vw0 + 4 * trp) * 2));
                if (outp) {
                    f32x4 pt00 = (f32x4){0.f, 0.f, 0.f, 0.f}, pt01 = pt00, pt11 = pt00, o0 = pt00, o1 = pt00;
#pragma unroll
                    for (int ks = 0; ks < 4; ++ks) { const int co = (32 * ks + 8 * g) * 2;
                        const bf16x8 aK0 = *(const LAS bf16x8*)(KI + r15 * HROW + co), aK1 = *(const LAS bf16x8*)(KI + (16 + r15) * HROW + co);
                        const bf16x8 bQ0 = *(const LAS bf16x8*)(QD + r15 * HROW + co), bQ1 = *(const LAS bf16x8*)(QD + (16 + r15) * HROW + co);
                        pt00 = MFMA16(aK0, bQ0, pt00); pt01 = MFMA16(aK0, bQ1, pt01); pt11 = MFMA16(aK1, bQ1, pt11); }
#pragma unroll
                    for (int r = 0; r < 4; ++r) if (4 * g + r > r15) { pt00[r] = 0.f; pt11[r] = 0.f; }
                    const bf16x8 pa0 = pk8(pt00, (f32x4){0.f, 0.f, 0.f, 0.f}), pa1 = pk8(pt01, pt11);
#pragma unroll
                    for (int ks = 0; ks < 4; ++ks) { const bf16x8 bS = pk8(S[2 * ks], S[2 * ks + 1]); const int c0 = (32 * ks + 4 * g) * 2;
                        const u32x2 x0 = *(const LAS u32x2*)(QD + r15 * HROW + c0), x1 = *(const LAS u32x2*)(QD + r15 * HROW + c0 + 32), y0 = *(const LAS u32x2*)(QD + (16 + r15) * HROW + c0), y1 = *(const LAS u32x2*)(QD + (16 + r15) * HROW + c0 + 32);
                        const bf16x8 aQ0 = __builtin_bit_cast(bf16x8, (u32x4){x0.x, x0.y, x1.x, x1.y}), aQ1 = __builtin_bit_cast(bf16x8, (u32x4){y0.x, y0.y, y1.x, y1.y});
                        o0 = MFMA16(aQ0, bS, o0); o1 = MFMA16(aQ1, bS, o1); }
                    o0 = MFMA16(pa0, bV, o0); o1 = MFMA16(pa1, bV, o1);
#pragma unroll
                    for (int r = 0; r < 4; ++r) { OB[(4 * g + r) * 128 + Vw0 + r15] = o0[r]; OB[(16 + 4 * g + r) * 128 + Vw0 + r15] = o1[r]; }
                }
#pragma unroll
                for (int mt = 0; mt < 8; ++mt) { const bf16x8 aKT = cat44(lds_tr(KT + (4 * g + trq) * HROW + (16 * mt + 4 * trp) * 2), lds_tr(KT + (16 + 4 * g + trq) * HROW + (16 * mt + 4 * trp) * 2));
                    const f32x4 dec4 = *(const LAS f32x4*)(DEC + 16 * mt + 4 * g);
                    S[mt] = MFMA16(aKT, bV, S[mt] * dec4); } }
            __syncthreads();
            if (outp) { const f32x4 o0 = *(const LAS f32x4*)(OB + tok * 128 + d0), o1 = *(const LAS f32x4*)(OB + tok * 128 + d0 + 4);
                float ss = pg8::sq8(o0, o1); ss += __shfl_xor(ss, 1); ss += __shfl_xor(ss, 2); ss += __shfl_xor(ss, 4); ss += __shfl_xor(ss, 8);
                const float rs = __builtin_amdgcn_rsqf(ss * (1.f / 128.f) + EPS);
                f32x4 g0, g1, r0, r1; pg8::unpack8(cg, g0, g1);
#pragma unroll
                for (int e = 0; e < 4; ++e) { r0[e] = o0[e] * rs * gn8[e] * sigmoidf_(g0[e]) + chkbad; r1[e] = o1[e] * rs * gn8[4 + e] * sigmoidf_(g1[e]); }
                *(u32x4*)(XA + (row0 + (size_t)c * 32 + tok) * D + h * ADK + d0) = pg8::pack8(r0, r1); }
        }
        if (!FULL) {
            const __amdgpu_buffer_rsrc_t rsL = __builtin_amdgcn_make_buffer_rsrc((void*)HLg, (short)0, 256 * 16384 * 4, 0x00020000);
            const __amdgpu_buffer_rsrc_t rsS = __builtin_amdgcn_make_buffer_rsrc((void*)HSg, (short)0, 256 * 128 * 4, 0x00020000);
            const int lo = (it * 16384 + (Vw0 + r15) * 128 + 4 * g) * 4;
#pragma unroll
            for (int mt = 0; mt < 8; ++mt) __builtin_amdgcn_raw_buffer_store_b128(__builtin_bit_cast(u32x4, S[mt]), rsL, lo + mt * 64, 0, 16);
            if (tid < 128) __builtin_amdgcn_raw_buffer_store_b32(__builtin_bit_cast(unsigned, SUM[tid]), rsS, (it * 128 + tid) * 4, 0, 16); }
        __syncthreads();
    }
}
__device__ __forceinline__ void phase_conv(const Frame& F, const Args& a) {
    unsigned char* ws = a.ws; const bf16_t* Z = (const bf16_t*)(ws + WS_Z); bf16_t* XA = (bf16_t*)(ws + WS_XA); const int tid = F.tid;
    const int gt = F.vcu * NTHR + tid, NGT = F.G * NTHR;
    for (int i = gt; i < NT * (512 / 8); i += NGT) {
        const int row = i >> 6, c0 = (i & 63) * 8, t = row & (SEQ - 1);
        const bf16_t* zr = Z + (size_t)row * ZW;
        f32x4 y0a, y0b, y1a = (f32x4){0.f, 0.f, 0.f, 0.f}, y1b = y1a, y2a = y1a, y2b = y1a, ga, gb;
        pg8::unpack8(*(const u32x4*)(zr + 2560 + c0), y0a, y0b); pg8::unpack8(*(const u32x4*)(zr + 2048 + c0), ga, gb);
        if (t >= 1) pg8::unpack8(*(const u32x4*)(zr - ZW + 2560 + c0), y1a, y1b);
        if (t >= 2) pg8::unpack8(*(const u32x4*)(zr - 2 * ZW + 2560 + c0), y2a, y2b);
        const f32x4 w0a = *(const f32x4*)(a.conv_w + c0), w0b = *(const f32x4*)(a.conv_w + c0 + 4), w1a = *(const f32x4*)(a.conv_w + 512 + c0), w1b = *(const f32x4*)(a.conv_w + 512 + c0 + 4),
                    w2a = *(const f32x4*)(a.conv_w + 1024 + c0), w2b = *(const f32x4*)(a.conv_w + 1024 + c0 + 4);
        const f32x4 ra = ga * (w0a * y2a + w1a * y1a + w2a * y0a), rb = gb * (w0b * y2b + w1b * y1b + w2b * y0b);
        u32x4 o; o.x = pk2(ra[0], ra[1]); o.y = pk2(ra[2], ra[3]); o.z = pk2(rb[0], rb[1]); o.w = pk2(rb[2], rb[3]);
        *(u32x4*)(XA + (size_t)row * D + 512 + c0) = o;
    }
}

__device__ __forceinline__ void phase_attn(const Frame& F, const Args& a) {
    const bf16_t* QKV = (const bf16_t*)(a.ws + WS_QKV); bf16_t* XA = (bf16_t*)(a.ws + WS_XA);
    const int gw = F.vcu * NWAVES + F.wave, NGW = F.G * NWAVES, lane = F.lane;
    for (int task = gw; task < NT * NQH; task += NGW) {
        const int m = task >> 4, hq = task & 15, kv = hq >> 3, t = m & (SEQ - 1);
        const bf16_t* qp = QKV + (size_t)m * CIN + hq * HD;
        float q[64];
#pragma unroll
        for (int i = 0; i < 8; ++i) { f32x4 x0, x1; pg8::unpack8(*(const u32x4*)(qp + 8 * i), x0, x1);
#pragma unroll
            for (int j = 0; j < 4; ++j) { q[8 * i + j] = x0[j]; q[8 * i + 4 + j] = x1[j]; } }
        float sc[2];
#pragma unroll
        for (int r = 0; r < 2; ++r) { const int j = lane + 64 * r, tk = t - 127 + j; float s = -INFINITY;
            if (tk >= 0) { const bf16_t* kp = QKV + (size_t)(m - 127 + j) * CIN + 1024 + kv * HD; float d = 0.f;
#pragma unroll
                for (int i = 0; i < 8; ++i) { f32x4 x0, x1; pg8::unpack8(*(const u32x4*)(kp + 8 * i), x0, x1);
#pragma unroll
                    for (int jj = 0; jj < 4; ++jj) d += q[8 * i + jj] * x0[jj] + q[8 * i + 4 + jj] * x1[jj]; }
                s = d * 0.125f; }
            sc[r] = s; }
        const float sink = a.sinks[hq];
        const float mx = fmaxf(wave_max(fmaxf(sc[0], sc[1])), sink);
        const float e0 = __expf(sc[0] - mx), e1 = __expf(sc[1] - mx);
        const float den = wave_sum(e0 + e1) + __expf(sink - mx);
        const float inv = 1.f / den; const float p0 = e0 * inv, p1 = e1 * inv;
        float o = 0.f;
        const int j0 = (t >= 127) ? 0 : 127 - t;
        for (int j = j0; j < 128; ++j) { const float pj = __shfl(j < 64 ? p0 : p1, j & 63); o += pj * bf1(QKV[(size_t)(m - 127 + j) * CIN + 1152 + kv * HD + lane]); }
        XA[(size_t)m * D + hq * HD + lane] = (bf16_t)f2bf(o);
    }
}

typedef float f32x16 __attribute__((ext_vector_type(16)));
#define MFMA32(A, B, C) __builtin_amdgcn_mfma_f32_32x32x16_bf16(A, B, C, 0, 0, 0)
constexpr int AT_ROW = 144, AT_K = 0, AT_V = 256 * AT_ROW;
__device__ __forceinline__ void phase_attn_fast(const Frame& F, const Args& a) {
    const bf16_t* QKV = (const bf16_t*)(a.ws + WS_QKV); bf16_t* XA = (bf16_t*)(a.ws + WS_XA);
    LAS unsigned char* L = F.lds;
    const int tid = F.tid, lane = F.lane, w = F.wave, c32 = lane & 31, hh = lane >> 5, i16 = lane & 15, trq = i16 >> 2, trp = i16 & 3, G1 = (lane >> 4) & 1;
    const float CS = 0.125f * 1.4426950408889634f;
    for (int unit = F.vcu; unit < NB * NKVH * (SEQ / 128); unit += F.G) {
        const int nb = unit & 31, kv = (unit >> 5) & 1, b = unit >> 6;
        const long rowk0 = (long)b * SEQ + 128 * nb - 128;
        __syncthreads();
#pragma unroll
        for (int i = 0; i < 4; ++i) { const int p = tid + NTHR * i, row = p >> 3, sg = p & 7; const bool ok = (nb > 0) || (row >= 128);
            u32x4 kx = (u32x4){0u, 0u, 0u, 0u}, vx = kx;
            if (ok) { const bf16_t* src = QKV + (size_t)(rowk0 + row) * CIN + 1024 + kv * HD + sg * 8; kx = *(const u32x4*)src; vx = *(const u32x4*)(src + 128); }
            *(LAS u32x4*)(L + AT_K + row * AT_ROW + sg * 16) = kx; *(LAS u32x4*)(L + AT_V + row * AT_ROW + sg * 16) = vx; }
        __syncthreads();
        const int hq = kv * 8 + w; const float sink2 = a.sinks[hq] * 1.4426950408889634f;
        for (int qt = 0; qt < 4; ++qt) {
            const size_t qrow = (size_t)b * SEQ + 128 * nb + 32 * qt + c32;
            const bf16_t* qp = QKV + qrow * CIN + hq * HD + 8 * hh;
            bf16x8 bQ[4];
#pragma unroll
            for (int ks = 0; ks < 4; ++ks) bQ[ks] = *(const bf16x8*)(qp + 16 * ks);
            f32x16 st[5]; float mx = sink2;
#pragma unroll
            for (int t = 0; t < 5; ++t) {
                const bool blk_ok = (nb > 0) || (qt + t >= 4);
#pragma unroll
                for (int r = 0; r < 16; ++r) st[t][r] = 0.f;
                if (blk_ok) {
#pragma unroll
                    for (int ks = 0; ks < 4; ++ks) { const bf16x8 aK = *(const LAS bf16x8*)(L + AT_K + (32 * (qt + t) + c32) * AT_ROW + (16 * ks + 8 * hh) * 2); st[t] = MFMA32(aK, bQ[ks], st[t]); } }
#pragma unroll
                for (int r = 0; r < 16; ++r) { const int kk = (r & 3) + 8 * (r >> 2) + 4 * hh;
                    bool ok = blk_ok; if (t == 0) ok = ok && (kk > c32); if (t == 4) ok = ok && (kk <= c32);
                    const float z = ok ? st[t][r] * CS : -INFINITY; st[t][r] = z; mx = fmaxf(mx, z); }
            }
            mx = fmaxf(mx, __shfl_xor(mx, 32));
            float sum = 0.f;
#pragma unroll
            for (int t = 0; t < 5; ++t)
#pragma unroll
                for (int r = 0; r < 16; ++r) { const float p = __builtin_amdgcn_exp2f(st[t][r] - mx); st[t][r] = p; sum += p; }
            sum += __shfl_xor(sum, 32);
            const float inv = 1.f / (sum + __builtin_amdgcn_exp2f(sink2 - mx));
            f32x16 o0, o1;
#pragma unroll
            for (int r = 0; r < 16; ++r) { o0[r] = 0.f; o1[r] = 0.f; }
#pragma unroll
            for (int t = 0; t < 5; ++t)
#pragma unroll
                for (int s2 = 0; s2 < 2; ++s2) {
                    const bf16x8 bP = pk8((f32x4){st[t][8 * s2], st[t][8 * s2 + 1], st[t][8 * s2 + 2], st[t][8 * s2 + 3]}, (f32x4){st[t][8 * s2 + 4], st[t][8 * s2 + 5], st[t][8 * s2 + 6], st[t][8 * s2 + 7]});
                    const LAS unsigned char* vb = L + AT_V + (32 * (qt + t) + 16 * s2 + 4 * hh + trq) * AT_ROW + (16 * G1 + 4 * trp) * 2;
                    const bf16x8 aV0 = cat44(lds_tr(vb), lds_tr(vb + 8 * AT_ROW)), aV1 = cat44(lds_tr(vb + 64), lds_tr(vb + 8 * AT_ROW + 64));
                    o0 = MFMA32(aV0, bP, o0); o1 = MFMA32(aV1, bP, o1); }
            bf16_t* op = XA + qrow * D + hq * HD + 4 * hh;
#pragma unroll
            for (int rg = 0; rg < 4; ++rg) { u32x2 x0, x1;
                x0.x = pg8::cvt_pk_bf16(o0[4 * rg] * inv, o0[4 * rg + 1] * inv); x0.y = pg8::cvt_pk_bf16(o0[4 * rg + 2] * inv, o0[4 * rg + 3] * inv);
                x1.x = pg8::cvt_pk_bf16(o1[4 * rg] * inv, o1[4 * rg + 1] * inv); x1.y = pg8::cvt_pk_bf16(o1[4 * rg + 2] * inv, o1[4 * rg + 3] * inv);
                *(u32x2*)(op + 8 * rg) = x0; *(u32x2*)(op + 32 + 8 * rg) = x1; }
        }
    }
}

constexpr int CNT_STRIDE = 64;
constexpr int RT_WROW = 2064;
constexpr int RT_WH = 0, RT_WL = 16 * RT_WROW, RT_LG = 2 * 16 * RT_WROW, RT_TC = RT_LG + 8 * 1088, RT_TW = RT_TC + 512, RT_LC = RT_TW + 2048, RT_GB = RT_LC + 128;
__device__ __forceinline__ void phase_route(const Frame& F, const Args& a, int l) {
    unsigned char* ws = a.ws; const bf16_t* HBs = (const bf16_t*)(ws + WS_XA2);
    gu32* cnt = (gu32*)(ws + WS_CTL) + CW_CNT + l * 32 * CNT_STRIDE; int* list = (int*)(ws + WS_LIST); f32x2* wlist = (f32x2*)(ws + WS_WLIST); float* rlist = (float*)(ws + WS_RLIST);
    LAS unsigned char* L = F.lds;
    LAS float* LG = (LAS float*)(L + RT_LG) + F.wave * 272; LAS int* TC = (LAS int*)(L + RT_TC); LAS f32x4* TW = (LAS f32x4*)(L + RT_TW); LAS int* LC = (LAS int*)(L + RT_LC); LAS int* GB = (LAS int*)(L + RT_GB);
    const float* gn = a.norm_ffn + l * D;
    for (int i = F.tid; i < D * NE; i += NTHR) { const int k = i >> 4, e = i & 15; const float wv = a.w_router[i] * gn[k]; const unsigned hi = f2bf(wv); const unsigned lo = f2bf(wv - bflo(hi));
        *(LAS bf16_t*)(L + RT_WH + e * RT_WROW + k * 2) = (bf16_t)hi; *(LAS bf16_t*)(L + RT_WL + e * RT_WROW + k * 2) = (bf16_t)lo; }
    if (F.tid < 32) LC[F.tid] = 0;
    __syncthreads();
    const int lane = F.lane, r15 = lane & 15, g = lane >> 4;
    for (int blk = F.vcu; blk < NT / 128; blk += F.G) {
        const int tl0 = F.wave * 16, m0 = blk * 128 + tl0;
        const u32x4* xr = (const u32x4*)(HBs + (size_t)(m0 + r15) * D + 8 * g);
        f32x4 acc = (f32x4){0.f, 0.f, 0.f, 0.f}; float ssq = 0.f;
        const LAS unsigned char* wh = L + RT_WH + r15 * RT_WROW + 16 * g; const LAS unsigned char* wl_ = L + RT_WL + r15 * RT_WROW + 16 * g;
#pragma unroll 1
        for (int k8 = 0; k8 < 2; ++k8) {
            u32x4 xv[16];
#pragma unroll
            for (int q = 0; q < 16; ++q) xv[q] = xr[(k8 * 16 + q) * 4];
#pragma unroll
            for (int q = 0; q < 16; ++q) { f32x4 x0, x1; pg8::unpack8(xv[q], x0, x1); ssq += pg8::sq8(x0, x1);
                const bf16x8 xh = __builtin_bit_cast(bf16x8, xv[q]);
                const bf16x8 bh = *(const LAS bf16x8*)(wh + (k8 * 16 + q) * 64), bl = *(const LAS bf16x8*)(wl_ + (k8 * 16 + q) * 64);
                acc = MFMA16(xh, bh, acc); acc = MFMA16(xh, bl, acc); }
        }
        ssq += __shfl_xor(ssq, 16); ssq += __shfl_xor(ssq, 32);
        const float rs = __builtin_amdgcn_rsqf(ssq * (1.f / D) + EPS);
#pragma unroll
        for (int r = 0; r < 4; ++r) LG[(4 * g + r) * 17 + r15] = acc[r];
        LDS_WAIT(); asm volatile("" ::: "memory");
        if (lane < 16) { float ex[16]; float mx = -INFINITY;
#pragma unroll
            for (int e = 0; e < 16; ++e) { ex[e] = LG[lane * 17 + e] * rs; mx = fmaxf(mx, ex[e]); }
#pragma unroll
            for (int e = 0; e < 16; ++e) ex[e] = __expf(ex[e] - mx);
            float gs[4], gv1[4], gv2[4]; int gi1[4], gi2[4];
#pragma unroll
            for (int gq = 0; gq < 4; ++gq) { float m1 = ex[4 * gq]; int i1 = 0;
#pragma unroll
                for (int i = 1; i < 4; ++i) if (ex[4 * gq + i] > m1) { m1 = ex[4 * gq + i]; i1 = i; }
                float m2 = -1.f; int i2 = 0;
#pragma unroll
                for (int i = 0; i < 4; ++i) if (i != i1 && ex[4 * gq + i] > m2) { m2 = ex[4 * gq + i]; i2 = i; }
                gs[gq] = m1 + m2; gv1[gq] = m1; gv2[gq] = m2; gi1[gq] = i1; gi2[gq] = i2; }
            int sel = 0; float best = gs[0], v1 = gv1[0], v2 = gv2[0]; int i1 = gi1[0], i2 = gi2[0];
#pragma unroll
            for (int gq = 1; gq < 4; ++gq) if (gs[gq] > best) { best = gs[gq]; sel = gq; v1 = gv1[gq]; v2 = gv2[gq]; i1 = gi1[gq]; i2 = gi2[gq]; }
            const float wsum = 1.f / (v1 + v2); const float w1 = v1 * wsum, w2 = v2 * wsum;
            const int ea = i1 < i2 ? i1 : i2, eb = i1 < i2 ? i2 : i1; const float wa = i1 < i2 ? w1 : w2, wb = i1 < i2 ? w2 : w1;
            const int pr = (ea == 0) ? eb - 1 : ((ea == 1) ? eb + 1 : 5);
            TC[tl0 + lane] = sel * 6 + pr; TW[tl0 + lane] = (f32x4){wa, wb, rs, 0.f}; }
        __syncthreads();
        int myc = 0, lp = 0;
        if (F.tid < 128) { myc = TC[F.tid]; lp = __hip_atomic_fetch_add(LC + myc, 1, __ATOMIC_RELAXED, __HIP_MEMORY_SCOPE_WORKGROUP); }
        __syncthreads();
        if (F.tid < NCLS) { const int n = LC[F.tid]; GB[F.tid] = n ? (int)__hip_atomic_fetch_add(cnt + F.tid * CNT_STRIDE, (unsigned)n, __ATOMIC_RELAXED, __HIP_MEMORY_SCOPE_AGENT) : 0; }
        __syncthreads();
        if (F.tid < 128) { const size_t pos = (size_t)myc * LCAP + GB[myc] + lp; const f32x4 tw = TW[F.tid]; list[pos] = blk * 128 + F.tid; wlist[pos] = (f32x2){tw[0], tw[1]}; rlist[pos] = tw[2]; }
        if (F.tid < 32) LC[F.tid] = 0;
        __syncthreads();
    }
}

constexpr int LX_UT = LX_OFF + 2048;
template <int NP>
__device__ __forceinline__ void moe_tables(const Frame& F, unsigned char* ws, int l) {
    const gu32* cnt = (const gu32*)(ws + WS_CTL) + CW_CNT + l * 32 * CNT_STRIDE;
    volatile LAS int* TB = (volatile LAS int*)(F.lds + LX_TB); volatile LAS int* CN = (volatile LAS int*)(F.lds + LX_CNT); volatile LAS int* CL = (volatile LAS int*)(F.lds + LX_CLS);
    volatile LAS unsigned long long* UT = (volatile LAS unsigned long long*)(F.lds + LX_UT);
    __syncthreads();
    if (F.tid < NCLS) CN[F.tid] = (int)__hip_atomic_load(cnt + F.tid * CNT_STRIDE, __ATOMIC_RELAXED, __HIP_MEMORY_SCOPE_AGENT);
    __syncthreads();
    if (F.tid == 0) { int tb = 0;
#pragma unroll 1
        for (int c = 0; c < NCLS; ++c) { TB[c] = tb; const int n = (CN[c] + 255) >> 8;
#pragma unroll 1
            for (int i = 0; i < n; ++i) CL[tb + i] = c;
            tb += n; }
        TB[NCLS] = tb; }
    __syncthreads();
    if (F.tid < 8) { const int i = F.tid; const int L = i * F.G + F.vcu; const int TT = TB[NCLS];
        unsigned long long w0 = ~0ull, w1 = 0, w2 = 0, w3 = 0, w4 = 0;
        if (L < TT * NP) { const int tau = L / NP, pn = L % NP; const int c = CL[tau]; const int ti = tau - TB[c], rem = CN[c] - ti * 256;
            const int g = c / 6, pr = c % 6; const int ea = pr < 3 ? 0 : (pr < 5 ? 1 : 2), eb = pr < 3 ? pr + 1 : (pr < 5 ? pr - 1 : 3);
            const int nv = rem < 256 ? rem : 256, aux = c * LCAP + ti * 256;
            const char *pA, *pB, *pB2;
            if (NP == 8) { const int e = g * 4 + (pn < 4 ? ea : eb); pA = (const char*)(ws + WS_XA2); pB = (const char*)(ws + WS_W1) + ((size_t)(l * NE + e) * D * D + (size_t)(pn & 3) * 256 * D) * 2; pB2 = pB; }
            else { pA = (const char*)(ws + WS_HID) + (size_t)tau * 256 * 1024 * 2; pB = (const char*)(ws + WS_W2) + ((size_t)(l * NE + g * 4 + ea) * D * DE + (size_t)pn * 256 * DE) * 2;
                pB2 = (const char*)(ws + WS_W2) + ((size_t)(l * NE + g * 4 + eb) * D * DE + (size_t)pn * 256 * DE) * 2; }
            w0 = (unsigned long long)(unsigned)tau | ((unsigned long long)(unsigned)pn << 32); w1 = (unsigned long long)pA; w2 = (unsigned long long)pB; w3 = (unsigned long long)pB2;
            w4 = (unsigned long long)(unsigned)nv | ((unsigned long long)(unsigned)aux << 32); }
        UT[i * 8 + 0] = w0; UT[i * 8 + 1] = w1; UT[i * 8 + 2] = w2; UT[i * 8 + 3] = w3; UT[i * 8 + 4] = w4; }
    __syncthreads();
}
__device__ __forceinline__ unsigned long long rfl64(unsigned long long v) { const unsigned lo = __builtin_amdgcn_readfirstlane((unsigned)v), hi = __builtin_amdgcn_readfirstlane((unsigned)(v >> 32)); return ((unsigned long long)hi << 32) | lo; }
struct MoeSched {
    const LAS unsigned long long* UT; const int* list;
    __device__ __forceinline__ bool next(int i, pg8::Unit& u) const {
        if (i >= 8) return false;
        const unsigned long long w0 = rfl64(UT[i * 8 + 0]); if ((int)(unsigned)w0 < 0) return false;
        const unsigned long long w1 = rfl64(UT[i * 8 + 1]), w2 = rfl64(UT[i * 8 + 2]), w3 = rfl64(UT[i * 8 + 3]), w4 = rfl64(UT[i * 8 + 4]);
        u.pm = (int)(unsigned)w0; u.pn = (int)(unsigned)(w0 >> 32); u.pA = (const char*)w1; u.pB = (const char*)w2; u.pB2 = (const char*)w3; u.nv = (int)(unsigned)w4; u.aux = (int)(unsigned)(w4 >> 32); u.lst = list + u.aux;
        return true;
    }
};

__device__ __forceinline__ void phase_final(const Frame& F, const Args& a) {
    const int gw = F.vcu * NWAVES + F.wave, NGW = F.G * NWAVES, lane = F.lane; const bf16_t* HBf = (const bf16_t*)(a.ws + WS_XA);
    f32x4 gv[4];
#pragma unroll
    for (int j = 0; j < 4; ++j) gv[j] = *((const f32x4*)a.norm_final + 2 * lane + 128 * (j >> 1) + (j & 1));
    for (int m = gw; m < NT; m += NGW) { const u32x4* hr = (const u32x4*)(HBf + (size_t)m * D) + lane; f32x4* xo = (f32x4*)(a.out + (size_t)m * D) + 2 * lane; f32x4 v[4]; float s = 0.f;
#pragma unroll
        for (int j = 0; j < 2; ++j) { pg8::unpack8(hr[64 * j], v[2 * j], v[2 * j + 1]); s += pg8::sq8(v[2 * j], v[2 * j + 1]); }
        const float rs = __builtin_amdgcn_rsqf(wave_sum(s) * (1.f / D) + EPS);
#pragma unroll
        for (int j = 0; j < 4; ++j) xo[128 * (j >> 1) + (j & 1)] = v[j] * rs * gv[j]; }
}

constexpr int N_PHASES = 18;
#ifndef HGRN_NAIVE
#define HGRN_NAIVE 0
#endif
#ifndef ATTN_NAIVE
#define ATTN_NAIVE 0
#endif
#if defined(__HIP_DEVICE_COMPILE__)
#define LOAD_ARGS(a) Args a; { const __attribute__((address_space(4))) char* _kp = (const __attribute__((address_space(4))) char*)__builtin_amdgcn_kernarg_segment_ptr(); asm volatile("" : "+s"(_kp)); a = *(const Args*)(const char*)_kp; } unsigned char* ws = a.ws
#else
#define LOAD_ARGS(a) Args a = args; unsigned char* ws = a.ws
#endif

#if !MK_PER_PHASE
#define GRID_BAR() xcd_barrier(bar)
#else
#define GRID_BAR() do { } while (0)
#endif
#ifndef PHMASK
#define PHMASK 0x3FFFF
#endif
#if MK_PER_PHASE
#define IN(k) (((PHMASK >> (k)) & 1) && lo <= (k) && (k) < hi)
#else
#define IN(k) ((PHMASK >> (k)) & 1)
#endif
#define BOTH(k) (IN(k) && IN((k) + 1))
#ifndef MBMASK
#define MBMASK 0
#endif
#define SITE_FRAME(Fp, PHK) Frame Fp; { int _w = wave0; asm volatile("" : "+s"(_w)); int _t = ((MBMASK >> (PHK)) & 1) ? _w * 64 + (int)__builtin_amdgcn_mbcnt_hi(~0u, __builtin_amdgcn_mbcnt_lo(~0u, 0u)) : (int)threadIdx.x; asm volatile("" : "+v"(_t)); unsigned _z = 0; asm volatile("" : "+s"(_z)); int _b = blockIdx.x; asm volatile("" : "+s"(_b)); int _G = gridDim.x; asm volatile("" : "+s"(_G)); Fp.tid = _t; Fp.lane = _t & 63; Fp.wave = __builtin_amdgcn_readfirstlane(_t >> 6); Fp.lds = (LAS unsigned char*)lds_raw + _z; Fp.G = _G; Fp.vcu = (_G % 8 == 0) ? (_b % 8) * (_G / 8) + _b / 8 : _b; } int bx = (int)blockIdx.x; asm volatile("" : "+s"(bx))
template <int l> __device__ __forceinline__ void layer_body(unsigned char* lds_raw, const Args& args, const XcdBarrier& bar, const int wave0, const int lo, const int hi) {
    (void)args; (void)bar; (void)lo; (void)hi;
        const int pb = 1 + 8 * l;
        if (IN(pb + 0)) { LOAD_ARGS(a); SITE_FRAME(Fp, pb + 0);
#ifndef NO_S1A
            if (l == 0) { pg8::DenseSched S; S.init(ws + WS_XA, ws + WS_WINAB, NT, ABIN, D, D, Fp.G, bx); pg8::EpiInAb E{(bf16_t*)(ws + WS_Z)};
                pg8::gemm_phase<pg8::EpiInAb, pg8::DenseSched, false, false>(Fp.lds, Fp.tid, D, D, D, S, E); }
#endif
#ifndef NO_S1B
            if (l == 1) { pg8::DenseSched S; S.init(a.out, ws + WS_WINC, NT, CIN, D, D, Fp.G, bx); pg8::rstd_table(Fp.lds, Fp.tid, S, (const float*)(ws + WS_SSB)); pg8::EpiQkv E{(bf16_t*)(ws + WS_QKV), a.b_in_c, (const LAS float*)(Fp.lds + pg8::RSL_OFF)};
                pg8::gemm_phase<pg8::EpiQkv, pg8::DenseSched, false, false>(Fp.lds, Fp.tid, D, D, D, S, E); }
#endif
#ifndef NO_S1C
            { pg8::DenseSched S; S.init(ws + WS_PB + (size_t)l * NT * PLE * 2, ws + WS_WPP + (size_t)l * D * PLE * 2, NT, D, PLE, PLE, Fp.G, bx); pg8::EpiBf16 E{(bf16_t*)(ws + WS_PP), D};
                pg8::gemm_phase<pg8::EpiBf16, pg8::DenseSched, false, false>(Fp.lds, Fp.tid, PLE, PLE, PLE, S, E); }
#endif
            if (BOTH(pb + 0)) GRID_BAR();
        }
#if HGRN_NAIVE
        if (IN(pb + 1)) { LOAD_ARGS(a); (void)ws; SITE_FRAME(Fp, pb + 1); if (l == 0) { phase_hgrn_conv(Fp, a); phase_conv(Fp, a); } else phase_attn(Fp, a); if (BOTH(pb + 1)) GRID_BAR(); }
#else
        if (IN(pb + 1)) { LOAD_ARGS(a); (void)ws; SITE_FRAME(Fp, pb + 1); if (l == 0) { hgrn_pass<false>(Fp, a); phase_conv(Fp, a); } else { if (ATTN_NAIVE) phase_attn(Fp, a); else phase_attn_fast(Fp, a); } if (BOTH(pb + 1)) GRID_BAR(); }
        if (IN(pb + 2) && l == 0) { LOAD_ARGS(a); (void)ws; SITE_FRAME(Fp, pb + 2); hgrn_pass<true>(Fp, a); if (BOTH(pb + 2)) GRID_BAR(); }
#endif
        if (IN(pb + 3)) { LOAD_ARGS(a); SITE_FRAME(Fp, pb + 3);
            pg8::DenseSched S; S.init(ws + WS_XA, ws + (l == 0 ? WS_WOUTAB : WS_WOUTC), NT, D, D, D, Fp.G, bx);
            if (l == 0) { pg8::EpiRes<true> E{a.x, nullptr, nullptr, (bf16_t*)(ws + WS_XA2)}; pg8::gemm_phase<pg8::EpiRes<true>, pg8::DenseSched, false, false>(Fp.lds, Fp.tid, D, D, D, S, E); }
            else { pg8::EpiRes<false> E{nullptr, (const bf16_t*)a.out, a.b_out_c, (bf16_t*)(ws + WS_XA2)}; pg8::gemm_phase<pg8::EpiRes<false>, pg8::DenseSched, false, false>(Fp.lds, Fp.tid, D, D, D, S, E); }
            if (BOTH(pb + 3)) GRID_BAR();
        }
        if (IN(pb + 4)) { LOAD_ARGS(a); (void)ws; SITE_FRAME(Fp, pb + 4); phase_route(Fp, a, l); if (BOTH(pb + 4)) GRID_BAR(); }
        if (IN(pb + 5)) { LOAD_ARGS(a); SITE_FRAME(Fp, pb + 5); moe_tables<8>(Fp, ws, l);
            MoeSched S{(const LAS unsigned long long*)(Fp.lds + LX_UT), (const int*)(ws + WS_LIST)};
            pg8::EpiG1 E{(bf16_t*)(ws + WS_HID), (const f32x2*)(ws + WS_WLIST), (const float*)(ws + WS_RLIST)};
            pg8::gemm_phase<pg8::EpiG1, MoeSched, true, false>(Fp.lds, Fp.tid, D, D, D, S, E);
            if (BOTH(pb + 5)) GRID_BAR(); }
        if (IN(pb + 6)) { LOAD_ARGS(a); SITE_FRAME(Fp, pb + 6); moe_tables<4>(Fp, ws, l);
            MoeSched S{(const LAS unsigned long long*)(Fp.lds + LX_UT), (const int*)(ws + WS_LIST)};
            pg8::EpiG2 E{(bf16_t*)(ws + WS_XA2), (float*)(ws + WS_SSA)};
            pg8::gemm_phase<pg8::EpiG2, MoeSched, false, true>(Fp.lds, Fp.tid, 1024, 1024, DE, S, E);
            if (BOTH(pb + 6)) GRID_BAR(); }
        if (IN(pb + 7)) { LOAD_ARGS(a); SITE_FRAME(Fp, pb + 7);
            pg8::DenseSched S; S.init(ws + WS_XA2, ws + WS_WPG + (size_t)l * D * D * 2, NT, D, D, D, Fp.G, bx);
            pg8::rstd_table(Fp.lds, Fp.tid, S, (const float*)(ws + WS_SSA));
            pg8::EpiPle E{(const bf16_t*)(ws + WS_XA2), l == 0 ? (bf16_t*)a.out : (bf16_t*)(ws + WS_XA), (const bf16_t*)(ws + WS_PP), (const LAS float*)(Fp.lds + pg8::RSL_OFF), (float*)(ws + WS_SSB)};
            pg8::gemm_phase<pg8::EpiPle, pg8::DenseSched, false, false>(Fp.lds, Fp.tid, D, D, D, S, E);
            if (BOTH(pb + 7)) GRID_BAR();
        }
}
__global__ void __launch_bounds__(NTHR, 2) mega_fwd(Args args) {
    extern __shared__ __attribute__((aligned(16))) unsigned char lds_raw[];
    Frame F; F.lds = (LAS unsigned char*)lds_raw; F.tid = threadIdx.x; F.lane = F.tid & 63; F.wave = __builtin_amdgcn_readfirstlane(F.tid >> 6);
    F.G = gridDim.x; { const int bx = blockIdx.x; F.vcu = (F.G % 8 == 0) ? (bx % 8) * (F.G / 8) + bx / 8 : bx; }
    for (int u = F.tid; u < (LDS_BYTES - LX_OFF) / 4; u += NTHR) ((LAS unsigned*)(F.lds + LX_OFF))[u] = 0u;
    __syncthreads();
#if !MK_PER_PHASE
    XcdBarrier bar = xcd_barrier_post((unsigned*)((gu32*)(args.ws + WS_CTL) + CW_BAR), (volatile LAS unsigned*)(F.lds + LX_BAR), __builtin_amdgcn_readfirstlane((int)threadIdx.x >> 6));
#else
    XcdBarrier bar; bar.bar = nullptr; bar.x = 0u; bar.st = nullptr; bar.w0 = 0;
#endif
    const int lo = args.ph_lo, hi = args.ph_hi; (void)lo; (void)hi;
    const int wave0 = __builtin_amdgcn_readfirstlane((int)threadIdx.x >> 6);

    if (IN(0)) { LOAD_ARGS(a); (void)ws; SITE_FRAME(Fp, 0); phase_prep(Fp, a); if (BOTH(0)) GRID_BAR(); }

    layer_body<0>(lds_raw, args, bar, wave0, lo, hi);
    layer_body<1>(lds_raw, args, bar, wave0, lo, hi);
    if (IN(17)) { LOAD_ARGS(a); (void)ws; SITE_FRAME(Fp, 17); phase_final(Fp, a); }
#undef IN
#undef BOTH
}

extern "C" void kernel_launch(void* const* d_in, const int* in_sizes, int n_in, void* d_out, int out_size, void* d_ws, size_t ws_size, hipStream_t stream) {
    static int grid = 0;
    if (grid == 0) {
        if (n_in != 22 || out_size != NT * D || ws_size < WS_END) { fprintf(stderr, "kernel_launch: unexpected shapes (n_in %d, out %d, ws %zu)\n", n_in, out_size, ws_size); grid = -1; return; }
        int dev = 0, cus = 0, per_cu = 0;
        if (hipGetDevice(&dev) != hipSuccess || hipDeviceGetAttribute(&cus, hipDeviceAttributeMultiprocessorCount, dev) != hipSuccess) { grid = -1; return; }
        if (hipFuncSetAttribute((const void*)mega_fwd, hipFuncAttributeMaxDynamicSharedMemorySize, LDS_BYTES) != hipSuccess) { fprintf(stderr, "kernel_launch: hipFuncSetAttribute failed\n"); grid = -1; return; }
        if (hipOccupancyMaxActiveBlocksPerMultiprocessor(&per_cu, (const void*)mega_fwd, NTHR, LDS_BYTES) != hipSuccess || per_cu < 1) fprintf(stderr, "kernel_launch: occupancy query says %d\n", per_cu);
        (void)hipGetLastError();
        grid = cus;
    }
    if (grid < 0) return;
    (void)hipMemsetAsync((char*)d_ws + WS_CTL, 0, CTL_ZERO_BYTES, stream);
    Args a{};
    a.x = (const float*)d_in[0]; a.p = (const float*)d_in[1]; a.norm_mix = (const float*)d_in[2]; a.norm_ffn = (const float*)d_in[3]; a.norm_ple = (const float*)d_in[4]; a.norm_final = (const float*)d_in[5];
    a.w_in_ab = (const float*)d_in[6]; a.lb_logits = (const float*)d_in[7]; a.hgrn_out_norm = (const float*)d_in[8]; a.conv_w = (const float*)d_in[9]; a.w_out_ab = (const float*)d_in[10];
    a.w_in_c = (const float*)d_in[11]; a.b_in_c = (const float*)d_in[12]; a.sinks = (const float*)d_in[13]; a.w_out_c = (const float*)d_in[14]; a.b_out_c = (const float*)d_in[15];
    a.w_router = (const float*)d_in[16]; a.w_gate_e = (const float*)d_in[17]; a.w_up_e = (const float*)d_in[18]; a.w_down_e = (const float*)d_in[19]; a.w_ple_gate = (const float*)d_in[20]; a.w_ple_proj = (const float*)d_in[21];
    a.out = (float*)d_out; a.ws = (unsigned char*)d_ws;
#if MK_PER_PHASE
#ifndef RP
#define RP (-1)
#define RN 0
#endif
    for (int ph = 0; ph < N_PHASES; ++ph) { a.ph_lo = ph; a.ph_hi = ph + 1; const int reps = (ph == RP) ? RN + 1 : 1;
        for (int r = 0; r < reps; ++r) { if (r > 0 && (ph == 5 || ph == 13)) (void)hipMemsetAsync((char*)d_ws + WS_CTL, 0, CTL_ZERO_BYTES, stream); hipLaunchKernelGGL(mega_fwd, dim3(grid), dim3(NTHR), LDS_BYTES, stream, a); } }
#else
    a.ph_lo = 0; a.ph_hi = N_PHASES; hipLaunchKernelGGL(mega_fwd, dim3(grid), dim3(NTHR), LDS_BYTES, stream, a);
#endif
}
```
